# Optimizing an MI355X kernel written in HIP

```python
import jax, jax.numpy as jnp
from jax import lax
import numpy as np

D_MODEL = 4096
BATCH = 2
SEQ = 4096
DEPTH = 2

N_A_LAYERS = DEPTH // 2
N_B_LAYERS = DEPTH - N_A_LAYERS
HEAD_DIM = 128
A_HEADS = D_MODEL // HEAD_DIM
A_WIDTH = A_HEADS * HEAD_DIM
B_Q_HEADS = D_MODEL // HEAD_DIM
B_KV_HEADS = 4
B_GROUP = B_Q_HEADS // B_KV_HEADS
B_WIDTH = B_Q_HEADS * HEAD_DIM
KV_WIDTH = B_KV_HEADS * HEAD_DIM
WINDOW = 128
BLOCK = 128
ROPE_THETA = 10000.0
EPS = 1e-6

kernel_name = "yoco_fox_swa_sink_adaln_hybrid"


def rms_norm(x, g):
    xf = x.astype(jnp.float32)
    y = xf * lax.rsqrt(jnp.mean(xf * xf, axis=-1, keepdims=True) + EPS)
    return (y * g.astype(jnp.float32)).astype(x.dtype)


def rope(x, pos):
    half = HEAD_DIM // 2
    inv = ROPE_THETA ** (-jnp.arange(half, dtype=jnp.float32) / half)
    ang = pos.astype(jnp.float32)[:, None] * inv[None, :]
    cos = jnp.cos(ang)[None, :, None, :]
    sin = jnp.sin(ang)[None, :, None, :]
    xf = x.astype(jnp.float32)
    x1, x2 = xf[..., :half], xf[..., half:]
    return jnp.concatenate([x1 * cos - x2 * sin, x2 * cos + x1 * sin], axis=-1).astype(x.dtype)


def adaln(c, w_ada, b_ada):
    mod = jax.nn.silu(c) @ w_ada + b_ada
    shift, scale, gate = jnp.split(mod, 3, axis=-1)
    return shift[:, None, :], scale[:, None, :], gate[:, None, :]


def forgetting_attention(q, k, v, log_f):
    B, H, S, d = q.shape
    n_blocks = S // BLOCK
    F = jnp.cumsum(log_f, axis=-1)
    key_pos = jnp.arange(S)
    scale = HEAD_DIM ** -0.5

    def one_block(i):
        start = i * BLOCK
        qb = lax.dynamic_slice_in_dim(q, start, BLOCK, axis=2)
        Fq = lax.dynamic_slice_in_dim(F, start, BLOCK, axis=2)
        s = jnp.einsum('bhqd,bhkd->bhqk', qb, k).astype(jnp.float32) * scale
        s = s + (Fq[..., :, None] - F[..., None, :])
        q_pos = start + jnp.arange(BLOCK)
        causal = key_pos[None, :] <= q_pos[:, None]
        s = jnp.where(causal[None, None], s, -jnp.inf)
        p = jax.nn.softmax(s, axis=-1).astype(v.dtype)
        return jnp.einsum('bhqk,bhkd->bhqd', p, v)

    out = lax.map(one_block, jnp.arange(n_blocks))
    return out.transpose(1, 2, 0, 3, 4).reshape(B, H, S, d)


def sliding_window_sink_attention(q, k, v, sinks):
    B, S = q.shape[0], q.shape[1]
    nb = S // BLOCK
    qb = q.reshape(B, nb, BLOCK, B_KV_HEADS, B_GROUP, HEAD_DIM)

    def band(t):
        tb = t.reshape(B, nb, BLOCK, B_KV_HEADS, HEAD_DIM)
        prev = jnp.pad(tb[:, :-1], ((0, 0), (1, 0), (0, 0), (0, 0), (0, 0)))
        return jnp.concatenate([prev, tb], axis=2)

    kb, vb = band(k), band(v)
    s = jnp.einsum('bnqkgd,bnskd->bnkgqs', qb, kb).astype(jnp.float32) * (HEAD_DIM ** -0.5)
    qi = jnp.arange(BLOCK)[:, None]
    sj = jnp.arange(2 * BLOCK)[None, :]
    diff = qi + BLOCK - sj
    in_window = (diff >= 0) & (diff < WINDOW)
    key_abs = jnp.arange(nb)[:, None] * BLOCK + jnp.arange(2 * BLOCK)[None, :] - BLOCK
    valid = in_window[None] & (key_abs >= 0)[:, None, :]
    s = jnp.where(valid[None, :, None, None], s, -jnp.inf)
    sink = jnp.broadcast_to(
        sinks.astype(jnp.float32).reshape(B_KV_HEADS, B_GROUP)[None, None, :, :, None, None],
        s.shape[:-1] + (1,))
    p = jax.nn.softmax(jnp.concatenate([s, sink], axis=-1), axis=-1)[..., :-1].astype(v.dtype)
    o = jnp.einsum('bnkgqs,bnskd->bnqkgd', p, vb)
    return o.reshape(B, S, B_Q_HEADS, HEAD_DIM)


def fox_layer(x, c, g, w_ada, b_ada, w_in, b_f, w_out):
    B, S, _ = x.shape
    shift, scale, gate = adaln(c, w_ada, b_ada)
    h = rms_norm(x, g) * (1 + scale) + shift
    proj = h @ w_in
    q, k, v, z, f = jnp.split(proj, [A_WIDTH, 2 * A_WIDTH, 3 * A_WIDTH, 4 * A_WIDTH], axis=-1)
    heads = lambda t: t.reshape(B, S, A_HEADS, HEAD_DIM).transpose(0, 2, 1, 3)
    log_f = jax.nn.log_sigmoid(f.astype(jnp.float32) + b_f.astype(jnp.float32)).transpose(0, 2, 1)
    o = forgetting_attention(heads(q), heads(k), heads(v), log_f)
    o = o.transpose(0, 2, 1, 3).reshape(B, S, A_WIDTH)
    y = (o * jax.nn.silu(z)) @ w_out
    return x + gate * y


def shared_kv(h, g_kv, w_kv, pos):
    B, S, _ = h.shape
    kv = rms_norm(h, g_kv) @ w_kv
    k, v = jnp.split(kv, 2, axis=-1)
    k = rope(k.reshape(B, S, B_KV_HEADS, HEAD_DIM), pos)
    v = v.reshape(B, S, B_KV_HEADS, HEAD_DIM)
    return k, v


def swa_layer(x, c, g, w_ada, b_ada, w_in, sinks, w_out, k, v, pos):
    B, S, _ = x.shape
    shift, scale, gate = adaln(c, w_ada, b_ada)
    h = rms_norm(x, g) * (1 + scale) + shift
    proj = h @ w_in
    q, z = jnp.split(proj, 2, axis=-1)
    q = rope(q.reshape(B, S, B_Q_HEADS, HEAD_DIM), pos)
    o = sliding_window_sink_attention(q, k, v, sinks).reshape(B, S, B_WIDTH)
    y = (o * jax.nn.silu(z)) @ w_out
    return x + gate * y


def setup_inputs(seed: int = 0) -> dict:
    key = jax.random.key(seed)
    ks = jax.random.split(key, 14)
    f32 = jnp.float32
    nrm = lambda k, shape, s: jax.random.normal(k, shape, f32) * s
    d_in_a = 4 * A_WIDTH + A_HEADS
    return {
        "x": nrm(ks[0], (BATCH, SEQ, D_MODEL), 1.0),
        "c": nrm(ks[1], (BATCH, D_MODEL), 1.0),
        "norm_g": 1.0 + nrm(ks[2], (DEPTH, D_MODEL), 0.02),
        "ada_w": nrm(ks[3], (DEPTH, D_MODEL, 3 * D_MODEL), 0.5 * D_MODEL ** -0.5),
        "ada_b": nrm(ks[4], (DEPTH, 3 * D_MODEL), 0.02),
        "a_w_in": nrm(ks[5], (N_A_LAYERS, D_MODEL, d_in_a), D_MODEL ** -0.5),
        "a_b_f": jax.random.uniform(ks[6], (N_A_LAYERS, A_HEADS), f32, 1.0, 4.0),
        "a_w_out": nrm(ks[7], (N_A_LAYERS, A_WIDTH, D_MODEL), A_WIDTH ** -0.5),
        "kv_norm_g": 1.0 + nrm(ks[8], (D_MODEL,), 0.02),
        "kv_w": nrm(ks[9], (D_MODEL, 2 * KV_WIDTH), D_MODEL ** -0.5),
        "b_w_in": nrm(ks[10], (N_B_LAYERS, D_MODEL, 2 * B_WIDTH), D_MODEL ** -0.5),
        "b_sinks": nrm(ks[11], (N_B_LAYERS, B_Q_HEADS), 0.5),
        "b_w_out": nrm(ks[12], (N_B_LAYERS, B_WIDTH, D_MODEL), B_WIDTH ** -0.5),
        "final_norm_g": 1.0 + nrm(ks[13], (D_MODEL,), 0.02),
    }


def reference(x, c, norm_g, ada_w, ada_b, a_w_in, a_b_f, a_w_out, kv_norm_g, kv_w,
              b_w_in, b_sinks, b_w_out, final_norm_g):
    pos = jnp.arange(x.shape[1])
    h = x
    k = v = None
    for layer in range(DEPTH):
        if layer < N_A_LAYERS:
            h = fox_layer(h, c, norm_g[layer], ada_w[layer], ada_b[layer],
                          a_w_in[layer], a_b_f[layer], a_w_out[layer])
        else:
            if layer == N_A_LAYERS:
                k, v = shared_kv(h, kv_norm_g, kv_w, pos)
            j = layer - N_A_LAYERS
            h = swa_layer(h, c, norm_g[layer], ada_w[layer], ada_b[layer],
                          b_w_in[j], b_sinks[j], b_w_out[j], k, v, pos)
    return rms_norm(h, final_norm_g)
```

```cpp
#include <hip/hip_runtime.h>
#include <cstdio>
#include <cstdint>

#ifndef MK_N_LAUNCHES
#define MK_N_LAUNCHES 1
#endif
#define NT_OUT 1
#ifndef WSKIP_ON
#define WSKIP_ON 0
#endif
#ifndef NAIVE_GEMM
#define NAIVE_GEMM 0
#endif
#ifndef NAIVE_FOX
#define NAIVE_FOX 0
#endif
#ifndef NAIVE_SWA
#define NAIVE_SWA 0
#endif

#define GAS __attribute__((address_space(1)))
#define LAS __attribute__((address_space(3)))
typedef float f32x16 __attribute__((ext_vector_type(16)));
typedef short s16x4 __attribute__((ext_vector_type(4)));
typedef unsigned u32x2 __attribute__((ext_vector_type(2)));

constexpr int DM = 4096, BATCH = 2, SEQ = 4096, M = BATCH * SEQ;
constexpr int NH = 32, HD = 128, NKV = 4, KVW = NKV * HD;
constexpr int N1 = 4 * DM;
constexpr int N1F = N1 + NH;
constexpr int N3 = 2 * DM, NKV2 = 2 * KVW;
constexpr int MOD = 3 * DM;
constexpr float EPS = 1e-6f;
constexpr float LOG2E = 1.4426950408889634f;
constexpr float SQRT_HD = 11.313708498984761f;

typedef unsigned short bf16_t;
typedef short bf16x8 __attribute__((ext_vector_type(8)));
typedef float f32x4 __attribute__((ext_vector_type(4)));
typedef unsigned u32x4 __attribute__((ext_vector_type(4)));

namespace pg8 {
#define PG8_LAS __attribute__((address_space(3)))
typedef unsigned short bf16_t;
typedef short bf16x8 __attribute__((ext_vector_type(8)));
typedef float f32x4 __attribute__((ext_vector_type(4)));
typedef unsigned u32x4 __attribute__((ext_vector_type(4)));
constexpr int BM = 256, BK = 64, HALF = 128, HTB = HALF * BK * 2  , STAGE_BYTES = 8 * HTB, NXCD = 8, WGM = 8;

__host__ __device__ __forceinline__ int lds_byte(int r, int c) { const int st = (r >> 4) * 2 + (c >> 5), rr = r & 15, cc = c & 31, ob = rr * 64 + cc * 2; return st * 1024 + (ob ^ (((ob >> 9) & 1) << 5)); }
__host__ __device__ __forceinline__ void stage_rc(int b, int& R, int& C) { const int st = b / 1024, sb = b % 1024, swz = sb ^ (((sb >> 9) & 1) << 5); R = (st >> 1) * 16 + swz / 64; C = (st & 1) * 32 + (swz % 64) / 2; }
__host__ __device__ __forceinline__ int perm32(int rho) { const int n = rho >> 4, i = rho & 15; return 8 * (i >> 2) + 4 * n + (i & 3); }

struct Unit { int pm, pn; };
struct Gemm { const bf16_t* A; const bf16_t* Bt; int M, N, K; };

struct StaticOrder {
    int nM, nN, nwg, G, c;
    __host__ __device__ void init(int M, int N, int G_, int c_) { nM = M / BM; nN = N / BM; nwg = nM * nN; G = G_; c = c_; }
    __host__ __device__ bool next(int i, Unit& u) const {
        const long L = (long)i * G + c; if (L >= nwg) return false;
        int wgid = (int)L; { const int q = nwg / NXCD, r = nwg % NXCD, xcd = wgid % NXCD, off = wgid / NXCD; wgid = (xcd < r ? xcd * (q + 1) : r * (q + 1) + (xcd - r) * q) + off; }
        const int nig = WGM * nN, gid = wgid / nig, fm = gid * WGM, gsz = (nM - fm) < WGM ? (nM - fm) : WGM;
        u.pm = fm + ((wgid % nig) % gsz); u.pn = (wgid % nig) / gsz; return true;
    }
    __device__ __forceinline__ void a_ready(const Unit&) const {}
    __device__ __forceinline__ void done(const Unit&) const {}
};

__device__ __forceinline__ unsigned cvt_pk_bf16(float lo, float hi) { unsigned r; asm volatile("v_cvt_pk_bf16_f32 %0, %1, %2" : "=v"(r) : "v"(lo), "v"(hi)); return r; }
__device__ __forceinline__ float silu_f(float v) { return v * __builtin_amdgcn_rcpf(1.0f + __builtin_amdgcn_exp2f(-1.4426950408889634f * v)); }
__device__ __forceinline__ f32x4 silu4(f32x4 v) { return (f32x4){silu_f(v[0]), silu_f(v[1]), silu_f(v[2]), silu_f(v[3])}; }

struct Dest { bf16_t* p; int ld; int mode; };

struct EpiQKVZ {
    static constexpr bool PERM = true, AFTER_DRAIN = false;
    bf16_t* O; size_t split_stride;
    __device__ __forceinline__ Dest dest(const Unit& u) const { const int colt = u.pn * BM, t = colt >> 12; Dest d; d.p = O + (size_t)t * split_stride + (colt & 4095); d.ld = 4096; d.mode = (t == 3) ? 1 : 0; return d; }
    __device__ __forceinline__ int row_of(const Unit& u) const { return u.pm * BM; }
};
struct EpiQZKV {
    static constexpr bool PERM = true, AFTER_DRAIN = false;
    bf16_t* Q1; bf16_t* Z1; bf16_t* KV1;
    __device__ __forceinline__ Dest dest(const Unit& u) const {
        Dest d;
        if (u.pn < 32) { const int colt = u.pn * BM; if (colt < 4096) { d.p = Q1 + colt; d.mode = 2; } else { d.p = Z1 + (colt - 4096); d.mode = 1; } d.ld = 4096; }
        else { const int colt = (u.pn - 32) * BM; d.p = KV1 + colt; d.ld = 1024; d.mode = (colt < 512) ? 2 : 0; }
        return d;
    }
    __device__ __forceinline__ int row_of(const Unit& u) const { return (u.pn < 32 ? u.pm : u.pm - 32) * BM; }
};
template <class E> struct EpiStoreBf16 {
    static constexpr bool PERM = true, AFTER_DRAIN = false;
    E e; const float* cs; const float* sn; unsigned* nrm;
    __device__ __forceinline__ void operator()(const f32x4 (&acc)[2][2][4][2], const Unit& u, int wr, int wc, int fr, int fq) const {
        const Dest d = e.dest(u); const int row0 = e.row_of(u) + wr * 64 + fr; const int col0 = wc * 32 + 8 * fq;
        const int g4 = (4 * wc + fq) * 4;
        float nmax[2] = {0.f, 0.f};
#pragma unroll
        for (int ai = 0; ai < 2; ++ai)
#pragma unroll
            for (int m = 0; m < 4; ++m) { const int row = row0 + ai * HALF + m * 16; bf16_t* rowp = d.p + (size_t)row * d.ld + col0;
                f32x4 c4 = (f32x4){1.f, 1.f, 1.f, 1.f}, s4 = (f32x4){0.f, 0.f, 0.f, 0.f};
                if (d.mode == 2) { const int pos = row & 4095; c4 = *(const f32x4*)(cs + pos * 64 + g4); s4 = *(const f32x4*)(sn + pos * 64 + g4); }
#pragma unroll
                for (int bj = 0; bj < 2; ++bj) { f32x4 v0 = acc[ai][bj][m][0], v1 = acc[ai][bj][m][1];
                    if (d.mode == 1) { v0 = silu4(v0); v1 = silu4(v1); }
                    if (d.mode == 2) { const f32x4 y1 = v0 * c4 - v1 * s4, y2 = v1 * c4 + v0 * s4; v0 = y1; v1 = y2; }
                    if (nrm) { float ss = (v0[0] * v0[0] + v0[1] * v0[1]) + (v0[2] * v0[2] + v0[3] * v0[3]) + (v1[0] * v1[0] + v1[1] * v1[1]) + (v1[2] * v1[2] + v1[3] * v1[3]);
                        ss += __shfl_xor(ss, 16); ss += __shfl_xor(ss, 32); nmax[bj] = fmaxf(nmax[bj], ss); }
                    u32x4 w; w.x = cvt_pk_bf16(v0[0], v0[1]); w.y = cvt_pk_bf16(v0[2], v0[3]); w.z = cvt_pk_bf16(v1[0], v1[1]); w.w = cvt_pk_bf16(v1[2], v1[3]);
#if defined(NT_OUT)
                    __builtin_nontemporal_store(w, (u32x4*)(rowp + bj * HALF)); } }
#else
                    *(u32x4*)(rowp + bj * HALF) = w; } }
#endif
        if (nrm) { const int colt = u.pn * BM, t = colt >> 12;
            if (t < 2) {
#pragma unroll
                for (int bj = 0; bj < 2; ++bj) { float mx = nmax[bj];
#pragma unroll
                    for (int o = 1; o < 16; o <<= 1) mx = fmaxf(mx, __shfl_xor(mx, o));
                    if (fr == 0 && fq == 0) atomicMax(nrm + ((((t * 2 + ((u.pm * BM) >> 12)) * 32) + ((colt & 4095) >> 7) + bj) * 4 + wc), __float_as_uint(mx)); } } }
    }
};
struct EpiResGate {
    static constexpr bool PERM = false, AFTER_DRAIN = false;
    const float* base; float* out; const float* gate; int gate_ld;
    __device__ __forceinline__ void operator()(const f32x4 (&acc)[2][2][4][2], const Unit& u, int wr, int wc, int fr, int fq) const {
        const int row0 = u.pm * BM + wr * 64 + fr, col0 = u.pn * BM + wc * 32 + 4 * fq; const float* gp = gate + (size_t)((u.pm * BM) >> 12) * gate_ld + col0;
        f32x4 gv[2][2];
#pragma unroll
        for (int bj = 0; bj < 2; ++bj)
#pragma unroll
            for (int n = 0; n < 2; ++n) gv[bj][n] = *(const f32x4*)(gp + bj * HALF + n * 16);
#pragma unroll
        for (int ai = 0; ai < 2; ++ai)
#pragma unroll
            for (int m = 0; m < 4; ++m) { const size_t off = (size_t)(row0 + ai * HALF + m * 16) * 4096 + col0;
#pragma unroll
                for (int bj = 0; bj < 2; ++bj)
#pragma unroll
                    for (int n = 0; n < 2; ++n) { const f32x4 bs = *(const f32x4*)(base + off + bj * HALF + n * 16); *(f32x4*)(out + off + bj * HALF + n * 16) = bs + gv[bj][n] * acc[ai][bj][m][n]; } }
    }
};
struct EpiNull {
    static constexpr bool PERM = true, AFTER_DRAIN = false;
    __device__ __forceinline__ void operator()(const f32x4 (&acc)[2][2][4][2], const Unit&, int, int, int, int) const {
#pragma unroll
        for (int ai = 0; ai < 2; ++ai)
#pragma unroll
            for (int bj = 0; bj < 2; ++bj)
#pragma unroll
                for (int m = 0; m < 4; ++m) asm volatile("" :: "v"(acc[ai][bj][m][0]), "v"(acc[ai][bj][m][1]));
    }
};
struct OrderQZKV {
    StaticOrder so; int G, c;
    __device__ void init(int G_, int c_) { so.init(8192, 8192, G_, c_); G = G_; c = c_; }
    __device__ bool next(int i, Unit& u) const {
        if (so.next(i, u)) return true;
        const long L = (long)i * G + c - 1024; if (L < 0 || L >= 128) return false;
        u.pm = 32 + (int)(L >> 2); u.pn = 32 + (int)(L & 3); return true;
    }
    __device__ __forceinline__ void a_ready(const Unit&) const {}
    __device__ __forceinline__ void done(const Unit&) const {}
};

template <class Epi, class Sched, bool ALIGN_EPI = false, bool SP2 = false>
__device__ __forceinline__ void gemm_phase(PG8_LAS unsigned char* lds, const Gemm g, const Sched& S, const Epi& E) {
    const int tid = threadIdx.x, wid = __builtin_amdgcn_readfirstlane(tid >> 6), lane = tid & 63, wr = wid >> 2, wc = wid & 3, fr = lane & 15, fq = lane >> 4;
    const int K = g.K, nt = K / BK;
    unsigned voffA[2], voffB[2];
#pragma unroll
    for (int i = 0; i < 2; ++i) { int R, C; stage_rc(tid * 16 + i * 8192, R, C); const int Rb = Epi::PERM ? ((R & ~31) + perm32(R & 31)) : R;
        voffA[i] = (unsigned)(R * K + C) * 2u; voffB[i] = (unsigned)(Rb * K + C) * 2u; }
    const size_t kstep = (size_t)(BK * 2);
    const size_t hstep = (size_t)HALF * K * 2;
    const size_t tstep = 2 * hstep;
    const unsigned ldsw = (unsigned)wid * 1024u;
    const int aoff = lds_byte(wr * 64 + fr, fq * 8), boff = lds_byte(wc * 32 + fr, fq * 8);
#define PG8_SA(b, h) (((b) * 2 + (h)) * HTB)
#define PG8_SB(b, h) ((4 + (b) * 2 + (h)) * HTB)
#define PG8_STAGE(bufoff, gbase, voff) do { _Pragma("unroll") for (int _i = 0; _i < 2; ++_i) \
        __builtin_amdgcn_global_load_lds((const unsigned*)((const char*)(gbase) + (voff)[_i]), (PG8_LAS unsigned*)(lds + (bufoff) + ldsw + _i * 8192), 16, 0, 0); } while (0)
#define PG8_LDA(dst, b, h) do { _Pragma("unroll") for (int m = 0; m < 4; ++m) _Pragma("unroll") for (int k = 0; k < 2; ++k) dst[m][k] = *(const PG8_LAS bf16x8*)(lds + PG8_SA(b, h) + aoff + m * 2048 + k * 1024); } while (0)
#define PG8_LDB(dst, b, h) do { _Pragma("unroll") for (int n = 0; n < 2; ++n) _Pragma("unroll") for (int k = 0; k < 2; ++k) dst[n][k] = *(const PG8_LAS bf16x8*)(lds + PG8_SB(b, h) + boff + n * 2048 + k * 1024); } while (0)
#define PG8_MMA(ai, bj, At, Bt) do { __builtin_amdgcn_s_setprio(1); _Pragma("unroll") for (int m = 0; m < 4; ++m) _Pragma("unroll") for (int n = 0; n < 2; ++n) _Pragma("unroll") for (int k = 0; k < 2; ++k) \
        acc[ai][bj][m][n] = __builtin_amdgcn_mfma_f32_16x16x32_bf16(Bt[n][k], At[m][k], acc[ai][bj][m][n], 0, 0, 0); __builtin_amdgcn_s_setprio(0); } while (0)
#define PG8_WAIT_V(n) asm volatile("s_waitcnt vmcnt(" #n ")" ::: "memory")
#define PG8_WAIT_L(n) asm volatile("s_waitcnt lgkmcnt(" #n ")" ::: "memory")
#define PG8_BAR __builtin_amdgcn_s_barrier()
#define PG8_SCHED __builtin_amdgcn_sched_barrier(0)
    Unit cur, nxt; int ui = 0;
    if (!S.next(0, cur)) return;
    f32x4 acc[2][2][4][2];
#pragma unroll
    for (int a = 0; a < 2; ++a)
#pragma unroll
        for (int b = 0; b < 2; ++b)
#pragma unroll
            for (int m = 0; m < 4; ++m)
#pragma unroll
                for (int n = 0; n < 2; ++n) acc[a][b][m][n] = (f32x4){0.f, 0.f, 0.f, 0.f};
    bf16x8 At[4][2], B0[2][2], B1[2][2];
    const char* cA = (const char*)g.A + (size_t)cur.pm * tstep; const char* cB = (const char*)g.Bt + (size_t)cur.pn * tstep;
    S.a_ready(cur);
    if constexpr (SP2) {
        PG8_STAGE(PG8_SB(0, 0), cB, voffB); PG8_STAGE(PG8_SB(0, 1), cB + hstep, voffB); PG8_STAGE(PG8_SA(0, 0), cA, voffA); PG8_STAGE(PG8_SA(0, 1), cA + hstep, voffA);
        if (wr == 1) PG8_BAR;
        PG8_WAIT_V(2); PG8_BAR;
        PG8_STAGE(PG8_SB(1, 0), cB + kstep, voffB); PG8_STAGE(PG8_SA(1, 0), cA + kstep, voffA); PG8_STAGE(PG8_SB(1, 1), cB + hstep + kstep, voffB);
        PG8_WAIT_V(6); PG8_BAR;
    } else {
        PG8_STAGE(PG8_SB(0, 0), cB, voffB); PG8_STAGE(PG8_SA(0, 0), cA, voffA); PG8_STAGE(PG8_SB(0, 1), cB + hstep, voffB); PG8_STAGE(PG8_SA(0, 1), cA + hstep, voffA);
        if (wr == 1) PG8_BAR;
        PG8_WAIT_V(4); PG8_BAR;
        PG8_STAGE(PG8_SB(1, 0), cB + kstep, voffB); PG8_STAGE(PG8_SA(1, 0), cA + kstep, voffA); PG8_STAGE(PG8_SB(1, 1), cB + hstep + kstep, voffB);
        PG8_WAIT_V(6); PG8_BAR;
    }
    for (;;) {
        const bool has_next = S.next(ui + 1, nxt);
        const char* nA = has_next ? (const char*)g.A + (size_t)nxt.pm * tstep : cA; const char* nB = has_next ? (const char*)g.Bt + (size_t)nxt.pn * tstep : cB;
        for (int t = 0; t < nt; t += 2) {
            const bool last = (t == nt - 2);
            const char* a1 = cA + (size_t)(t + 1) * kstep;
            const char* a2 = last ? nA : cA + (size_t)(t + 2) * kstep; const char* b2 = last ? nB : cB + (size_t)(t + 2) * kstep;
            const char* a3 = a2 + kstep; const char* b3 = b2 + kstep;
            if (last && has_next) S.a_ready(nxt);
            if constexpr (SP2) {
            PG8_LDB(B0, 0, 0); PG8_LDB(B1, 0, 1); PG8_SCHED; PG8_LDA(At, 0, 0); PG8_STAGE(PG8_SA(1, 1), a1 + hstep, voffA);
            PG8_WAIT_V(8); PG8_WAIT_L(0); PG8_BAR; PG8_MMA(0, 0, At, B0); PG8_MMA(0, 1, At, B1); PG8_BAR; PG8_SCHED;
            PG8_LDA(At, 0, 1); PG8_STAGE(PG8_SB(0, 0), b2, voffB); PG8_STAGE(PG8_SB(0, 1), b2 + hstep, voffB); PG8_STAGE(PG8_SA(0, 0), a2, voffA);
            PG8_WAIT_V(8); PG8_WAIT_L(0); PG8_BAR; PG8_MMA(1, 0, At, B0); PG8_MMA(1, 1, At, B1); PG8_BAR; PG8_SCHED;
            PG8_LDB(B0, 1, 0); PG8_LDB(B1, 1, 1); PG8_SCHED; PG8_LDA(At, 1, 0); PG8_STAGE(PG8_SA(0, 1), a2 + hstep, voffA);
            PG8_WAIT_V(8); PG8_WAIT_L(0); PG8_BAR; PG8_MMA(0, 0, At, B0); PG8_MMA(0, 1, At, B1); PG8_BAR; PG8_SCHED;
            PG8_LDA(At, 1, 1); PG8_STAGE(PG8_SB(1, 0), b3, voffB); PG8_STAGE(PG8_SB(1, 1), b3 + hstep, voffB); PG8_STAGE(PG8_SA(1, 0), a3, voffA);
            PG8_WAIT_V(8); PG8_WAIT_L(0); PG8_BAR; PG8_MMA(1, 0, At, B0); PG8_MMA(1, 1, At, B1); PG8_BAR; PG8_SCHED;
            } else {
            PG8_LDB(B0, 0, 0); PG8_SCHED; PG8_LDA(At, 0, 0); PG8_STAGE(PG8_SA(1, 1), a1 + hstep, voffA);
            PG8_WAIT_L(8); PG8_BAR; PG8_WAIT_L(0); PG8_MMA(0, 0, At, B0); PG8_BAR; PG8_SCHED;
            PG8_LDB(B1, 0, 1); PG8_STAGE(PG8_SB(0, 0), b2, voffB);
            PG8_BAR; PG8_WAIT_L(0); PG8_MMA(0, 1, At, B1); PG8_BAR;
            PG8_LDA(At, 0, 1); PG8_STAGE(PG8_SA(0, 0), a2, voffA);
            PG8_BAR; PG8_WAIT_L(0); PG8_MMA(1, 0, At, B0); PG8_BAR; PG8_SCHED;
            PG8_STAGE(PG8_SB(0, 1), b2 + hstep, voffB);
            PG8_WAIT_V(6); PG8_BAR; PG8_MMA(1, 1, At, B1); PG8_BAR;
            PG8_LDB(B0, 1, 0); PG8_SCHED; PG8_LDA(At, 1, 0); PG8_STAGE(PG8_SA(0, 1), a2 + hstep, voffA);
            PG8_WAIT_L(8); PG8_BAR; PG8_WAIT_L(0); PG8_MMA(0, 0, At, B0); PG8_BAR; PG8_SCHED;
            PG8_LDB(B1, 1, 1); PG8_STAGE(PG8_SB(1, 0), b3, voffB);
            PG8_BAR; PG8_WAIT_L(0); PG8_MMA(0, 1, At, B1); PG8_BAR;
            PG8_LDA(At, 1, 1); PG8_STAGE(PG8_SA(1, 0), a3, voffA);
            PG8_BAR; PG8_WAIT_L(0); PG8_MMA(1, 0, At, B0); PG8_BAR; PG8_SCHED;
            PG8_STAGE(PG8_SB(1, 1), b3 + hstep, voffB);
            PG8_WAIT_V(6); PG8_BAR; PG8_MMA(1, 1, At, B1); PG8_BAR;
            }
        }
        if constexpr (ALIGN_EPI) { if (wr == 0) PG8_BAR; }
#if defined(EPI_TWICE)
        if constexpr (!Epi::AFTER_DRAIN) { _Pragma("unroll 1") for (int rep_ = 0; rep_ < 2; ++rep_) { E(acc, cur, wr, wc, fr, fq); asm volatile("" ::: "memory"); } S.done(cur); }
#else
        if constexpr (!Epi::AFTER_DRAIN) { E(acc, cur, wr, wc, fr, fq); S.done(cur); }
#endif
        if (!has_next) break;
#pragma unroll
        for (int a = 0; a < 2; ++a)
#pragma unroll
            for (int b = 0; b < 2; ++b)
#pragma unroll
                for (int m = 0; m < 4; ++m)
#pragma unroll
                    for (int n = 0; n < 2; ++n) acc[a][b][m][n] = (f32x4){0.f, 0.f, 0.f, 0.f};
        cur = nxt; cA = nA; cB = nB; ++ui;
        if constexpr (ALIGN_EPI) { if (wr == 1) PG8_BAR; }
    }
    PG8_WAIT_V(0);
    if constexpr (!ALIGN_EPI) { if (wr == 0) PG8_BAR; }
    PG8_BAR;
    if constexpr (Epi::AFTER_DRAIN) { E.fused(acc, cur, wr, wc, fr, fq, lds, wid, lane); S.done(cur); }
#undef PG8_SA
#undef PG8_SB
#undef PG8_STAGE
#undef PG8_LDA
#undef PG8_LDB
#undef PG8_MMA
#undef PG8_WAIT_V
#undef PG8_WAIT_L
#undef PG8_BAR
#undef PG8_SCHED
}
}

namespace att {
typedef unsigned short bf16;
typedef short bf16x8 __attribute__((ext_vector_type(8)));
constexpr int D = 128, NW = 8, QBLK = 32, KVBLK = 64, QB = NW * QBLK;
constexpr int SHM_V = KVBLK * D * 2, SHM_K = KVBLK * D * 2;
constexpr int LDS_WS = 2 * SHM_V + 2 * SHM_K;
constexpr int LDS_F = LDS_WS + NW * 64 * 4;
constexpr int LDS_OST = LDS_F + 4096 * 4;
constexpr int LDS_BYTES = LDS_OST + NW * 32 * 64 * 4;
constexpr float SCALE = 0.08838834764831845f;
constexpr float THR = 8.f;

#define KSWZ(row, colB) ((row) * 256 + ((colB) ^ (((row) & 7) << 4)))
#define SBAR() __builtin_amdgcn_sched_barrier(0)
__device__ __forceinline__ int v_st(int k, int c) { const int kk = (k & ~0xC) | ((k & 4) << 1) | ((k & 8) >> 1); return ((kk >> 3) * 4 + (c >> 5)) * 512 + ((kk & 7) * 32 + (c & 31)) * 2; }
__device__ __forceinline__ int v_rd_base(int lane) { return ((lane & 3) << 3) | (((lane >> 2) & 3) << 6) | (((lane >> 4) & 1) << 5) | (((lane >> 5) & 1) << 8); }
constexpr int v_rd_off(int d0, int ks, int half) { return d0 * 512 + ks * 4096 + half * 2048; }
__device__ __forceinline__ int crow(int r, int hi) { return (r & 3) + 8 * (r >> 2) + 4 * hi; }
__device__ __forceinline__ unsigned cvtpk(float lo, float hi) { unsigned r; asm volatile("v_cvt_pk_bf16_f32 %0, %1, %2" : "=v"(r) : "v"(lo), "v"(hi)); return r; }
__device__ __forceinline__ bf16x8 load8(const bf16* p) { return *reinterpret_cast<const bf16x8*>(p); }
__device__ __forceinline__ void mask_tile(f32x16& p0, f32x16& p1, int dq, unsigned W) {
    const float NEG = -__builtin_inff();
#pragma unroll
    for (int r = 0; r < 16; ++r) {
        const int c = (r & 3) + 8 * (r >> 2);
        if ((unsigned)(dq - c) >= W) p0[r] = NEG;
        if ((unsigned)(dq - c - 32) >= W) p1[r] = NEG;
    }
}
__device__ __forceinline__ void partialSM(f32x16& p0, f32x16& p1, float& m_reg, float& mn, float& alpha) {
    float pmax = p0[0]; for (int r = 1; r < 16; ++r) pmax = fmaxf(pmax, p0[r]); for (int r = 0; r < 16; ++r) pmax = fmaxf(pmax, p1[r]);
    { auto rr = __builtin_amdgcn_permlane32_swap(__float_as_uint(pmax), __float_as_uint(pmax), false, false);
      pmax = fmaxf(__uint_as_float(rr[0]), __uint_as_float(rr[1])); }
    constexpr float C2 = 1.4426950408889634f * SCALE;
    if (__builtin_expect(__all((pmax - m_reg) * SCALE <= THR), 1)) { mn = m_reg; alpha = 1.f; }
    else { mn = fmaxf(m_reg, pmax); alpha = __builtin_amdgcn_exp2f((m_reg - mn) * C2); m_reg = mn; }
    const float mnL = -mn * C2;
    for (int r = 0; r < 16; ++r) p0[r] = fmaf(p0[r], C2, mnL); for (int r = 0; r < 16; ++r) p1[r] = fmaf(p1[r], C2, mnL);
    for (int r = 0; r < 16; ++r) p0[r] = __builtin_amdgcn_exp2f(p0[r]);
}
__device__ __forceinline__ void finishSM(f32x16& p0, f32x16& p1, float alpha, float& l_reg, bf16x8& pa0, bf16x8& pa1, bf16x8& pa2, bf16x8& pa3) {
    for (int r = 0; r < 16; ++r) p1[r] = __builtin_amdgcn_exp2f(p1[r]);
    float ps = 0; for (int r = 0; r < 16; ++r) ps += p0[r]; for (int r = 0; r < 16; ++r) ps += p1[r];
    { auto rr = __builtin_amdgcn_permlane32_swap(__float_as_uint(ps), __float_as_uint(ps), false, false);
      ps = __uint_as_float(rr[0]) + __uint_as_float(rr[1]); }
    l_reg = l_reg * alpha + ps;
#define PK4(P, B_, OUT) do { unsigned a0 = cvtpk(P[B_+0], P[B_+1]), a1 = cvtpk(P[B_+2], P[B_+3]);                          \
        unsigned b0 = cvtpk(P[B_+4], P[B_+5]), b1 = cvtpk(P[B_+6], P[B_+7]);                                             \
        auto r0 = __builtin_amdgcn_permlane32_swap(a0, b0, false, false); auto r1 = __builtin_amdgcn_permlane32_swap(a1, b1, false, false); \
        u32x4 w = {r0[0], r1[0], r0[1], r1[1]}; OUT = *reinterpret_cast<bf16x8*>(&w); } while (0)
    PK4(p0, 0, pa0); PK4(p0, 8, pa1); PK4(p1, 0, pa2); PK4(p1, 8, pa3);
#undef PK4
}
template <int KB, bool SK, bool FOX>
__device__ __forceinline__ void qkt(f32x16& p0, f32x16& p1, const LAS char* K_lds, int r32, int hi, const bf16x8* qr, bool act, const LAS float* fs  ) {
    if (SK && !act) { const float NEG = -__builtin_inff();
#pragma unroll
        for (int r = 0; r < 16; ++r) { p0[r] = NEG; p1[r] = NEG; } return; }
    if constexpr (FOX) {
#pragma unroll
        for (int g = 0; g < 4; ++g) { const f32x4 a = *(const LAS f32x4*)(fs + 8 * g), b = *(const LAS f32x4*)(fs + 32 + 8 * g);
            p0[4 * g] = a[0]; p0[4 * g + 1] = a[1]; p0[4 * g + 2] = a[2]; p0[4 * g + 3] = a[3];
            p1[4 * g] = b[0]; p1[4 * g + 1] = b[1]; p1[4 * g + 2] = b[2]; p1[4 * g + 3] = b[3]; }
    } else { p0 = f32x16{}; p1 = f32x16{}; }
    const LAS char* kb[4];
#pragma unroll
    for (int dd = 0; dd < 4; ++dd) kb[dd] = K_lds + KB * SHM_K + KSWZ(r32, (dd * 16 + hi * 8) * 2);
#pragma unroll
    for (int d0 = 0; d0 < 8; ++d0) { const LAS char* a = kb[d0 & 3] + (d0 >> 2) * 128;
        bf16x8 b0 = *(const LAS bf16x8*)(a);
        bf16x8 b1 = *(const LAS bf16x8*)(a + 32 * 256);
        p0 = __builtin_amdgcn_mfma_f32_32x32x16_bf16(b0, qr[d0], p0, 0, 0, 0);
        p1 = __builtin_amdgcn_mfma_f32_32x32x16_bf16(b1, qr[d0], p1, 0, 0, 0); }
}
template <int VB, bool SK>
__device__ __forceinline__ void pv_tile(f32x16* o, int vb0, bf16x8 pa0, bf16x8 pa1, bf16x8 pa2, bf16x8 pa3, bool act) {
    if (SK && !act) return;
#define TRRD(dst, off) asm volatile("ds_read_b64_tr_b16 %0, %1 offset:%2" : "=&v"(dst) : "v"(vb0), "i"(off) : "memory")
#define PV_D0(d0) do { s16x4 l0, l1, l2, l3, h0, h1, h2, h3; constexpr int b_ = VB * SHM_V + v_rd_off(d0, 0, 0);   \
        TRRD(l0, b_); TRRD(h0, b_ + 2048); TRRD(l1, b_ + 4096); TRRD(h1, b_ + 6144); TRRD(l2, b_ + 8192); TRRD(h2, b_ + 10240); TRRD(l3, b_ + 12288); TRRD(h3, b_ + 14336); \
        asm volatile("s_waitcnt lgkmcnt(0)" ::: "memory"); SBAR();   \
        o[d0] = __builtin_amdgcn_mfma_f32_32x32x16_bf16(pa0, (bf16x8){l0[0], l0[1], l0[2], l0[3], h0[0], h0[1], h0[2], h0[3]}, o[d0], 0, 0, 0);   \
        o[d0] = __builtin_amdgcn_mfma_f32_32x32x16_bf16(pa1, (bf16x8){l1[0], l1[1], l1[2], l1[3], h1[0], h1[1], h1[2], h1[3]}, o[d0], 0, 0, 0);   \
        o[d0] = __builtin_amdgcn_mfma_f32_32x32x16_bf16(pa2, (bf16x8){l2[0], l2[1], l2[2], l2[3], h2[0], h2[1], h2[2], h2[3]}, o[d0], 0, 0, 0);   \
        o[d0] = __builtin_amdgcn_mfma_f32_32x32x16_bf16(pa3, (bf16x8){l3[0], l3[1], l3[2], l3[3], h3[0], h3[1], h3[2], h3[3]}, o[d0], 0, 0, 0); } while (0)
    PV_D0(0); PV_D0(1); PV_D0(2); PV_D0(3);
#undef PV_D0
#undef TRRD
}

template <size_t OQ, size_t OK, size_t OV, size_t OZ, size_t OO> struct Bases { const unsigned char* ws;
    __device__ __forceinline__ const bf16* Q() const { return (const bf16*)(ws + OQ); } __device__ __forceinline__ const bf16* K() const { return (const bf16*)(ws + OK); }
    __device__ __forceinline__ const bf16* V() const { return (const bf16*)(ws + OV); } __device__ __forceinline__ const bf16* Z() const { return (const bf16*)(ws + OZ); }
    __device__ __forceinline__ bf16* O() const { return (bf16*)(ws + OO); } };
struct BlockRef { unsigned qoff; unsigned kvoff; int P0; int jlo; float sink_l2; float qk; };
struct Seam { bf16x8 qr[8]; bf16x8 st_v0, st_v1, st_k0, st_k1; };
__device__ __forceinline__ int swa_jlo(int P0, int W) { const int lowk = P0 - W + 1; return lowk > 0 ? lowk / KVBLK : 0; }
#define UROW(p, k0) ((const char*)(p) + (size_t)((k0) + wid * 4) * (LDKV * 2))
#define VMW() asm volatile("s_waitcnt vmcnt(0)" ::: "memory")
#define VMWN(n) asm volatile("s_waitcnt vmcnt(%0)" :: "i"(n) : "memory")
#define SLOAD_H(Kp, Vp, k0) do { const char* vu_ = UROW(Vp, k0); const char* ku_ = UROW(Kp, k0);                                   \
                         S.st_v0 = *(const bf16x8*)(vu_ + kvlane); S.st_v1 = *(const bf16x8*)(vu_ + 32 * LDKV * 2 + kvlane);              \
                         S.st_k0 = *(const bf16x8*)(ku_ + kvlane); S.st_k1 = *(const bf16x8*)(ku_ + 32 * LDKV * 2 + kvlane); } while (0)
#define SWRITE_HK(bf) do { *(LAS bf16x8*)(K_lds + (bf) * SHM_K + kws) = S.st_k0; *(LAS bf16x8*)(K_lds + (bf) * SHM_K + kws + 32 * 256) = S.st_k1; } while (0)
#define SWRITE_HV(bf) do { *(LAS bf16x8*)(V_lds + (bf) * SHM_V + vst0) = S.st_v0; *(LAS bf16x8*)(V_lds + (bf) * SHM_V + vst1) = S.st_v1; } while (0)
#define SWRITE_H(bf) do { SWRITE_HV(bf); SWRITE_HK(bf); } while (0)
template <bool FOX, int LDQ, int LDKV, class BasesT>
__device__ __forceinline__ void attn_prime(const BasesT& T, const BlockRef& cur, int W, LAS char* lds, Seam& S) {
    const int tid = threadIdx.x, wid = __builtin_amdgcn_readfirstlane(tid >> 6), lane = tid & 63, r32 = lane & 31, hi = lane >> 5;
    const int sr = tid >> 4, sc = (tid & 15) * 8, kws = KSWZ(sr, sc * 2); LAS char* K_lds = lds + 2 * SHM_V;
    const unsigned kvlane = (unsigned)((lane >> 4) * LDKV + sc) * 2u, qlane = (unsigned)(r32 * LDQ + hi * 8) * 2u;
    const int kb0 = FOX ? ((cur.P0 + QB - 1) / KVBLK) * KVBLK : swa_jlo(cur.P0, W) * KVBLK;
    { const char* qu = (const char*)(T.Q() + cur.qoff) + (size_t)wid * (QBLK * LDQ * 2);
      for (int d0 = 0; d0 < 8; ++d0) S.qr[d0] = *(const bf16x8*)(qu + d0 * 32 + qlane); }
    SLOAD_H(T.K() + cur.kvoff, T.V() + cur.kvoff, kb0); VMW(); SWRITE_HK(0);
    __syncthreads();
}
template <bool FOX, int LDQ, int LDKV, int LDO, class BasesT>
__device__ __forceinline__ void attn_block(const BasesT& T, const BlockRef& cur, const BlockRef& nxt, int skv, int W, LAS char* lds, Seam& S) {
    constexpr bool SK = WSKIP_ON && !FOX;
    const int tid = threadIdx.x, wid = __builtin_amdgcn_readfirstlane(tid >> 6), lane = tid & 63, r32 = lane & 31, hi = lane >> 5;
    const int j_lo = FOX ? cur.jlo : swa_jlo(cur.P0, W);
    int j_hi = (cur.P0 + QB - 1) / KVBLK + 1; if (j_hi > skv / KVBLK) j_hi = skv / KVBLK;
    int NT = j_hi - j_lo;
    const int kbn = FOX ? ((nxt.P0 + QB - 1) / KVBLK) * KVBLK : swa_jlo(nxt.P0, W) * KVBLK;
    const int qlo = cur.P0 + wid * QBLK, qm = qlo + r32 - 4 * hi;
    LAS char* V_lds = lds; LAS char* K_lds = lds + 2 * SHM_V;
    LAS float* ws = (LAS float*)(lds + LDS_WS) + wid * 64; LAS float* li_l = ws; LAS float* al_l = ws + 32;
    const LAS float* Fs = (const LAS float*)(lds + LDS_F) + 4 * hi;
    float m_reg = -1e30f, l_reg = 0; f32x16 o[4] = {};
    const int sr = tid >> 4, sc = (tid & 15) * 8, vst0 = v_st(sr, sc), vst1 = v_st(32 + sr, sc), kws = KSWZ(sr, sc * 2);
    const unsigned kvlane = (unsigned)((lane >> 4) * LDKV + sc) * 2u, qlane = (unsigned)(r32 * LDQ + hi * 8) * 2u;
    const int vb0 = (int)(uintptr_t)V_lds + v_rd_base(lane);
    const unsigned kvo = cur.kvoff;
#define Kh (T.K() + kvo)
#define Vh (T.V() + kvo)
#define RESC(a) do { if (__any((a) < 1.f)) { if (hi == 0) al_l[r32] = (a); asm volatile("s_waitcnt lgkmcnt(0)" ::: "memory");              \
                     for (int d_ = 0; d_ < 4; ++d_) for (int r = 0; r < 16; ++r) o[d_][r] *= al_l[crow(r, hi)]; } } while (0)
#define KBASE(t) ((FOX ? (j_hi - 1 - (t)) : (j_lo + (t))) * KVBLK)
#define ACT(t) (KBASE(t) <= qlo + QBLK - 1 && KBASE(t) + KVBLK - 1 >= qlo - W + 1)
#define MASKT(P0_, P1_, t) do { const int kb_ = KBASE(t); if ((!SK || ACT(t)) && (kb_ + KVBLK - 1 > qlo || kb_ <= qlo + QBLK - 1 - W)) mask_tile(P0_, P1_, qm - kb_, (unsigned)W); } while (0)
    constexpr int NQL = 8;
#define SEAM_K0() do { VMWN(NQL); SWRITE_HK(0); SBAR(); } while (0)
    f32x16 pA0, pA1, pB0, pB1; float mnA, mnB, alA, alB; bf16x8 pa0, pa1, pa2, pa3;
    SWRITE_HV(0); SBAR();
    if (NT > 1) { SLOAD_H(Kh, Vh, KBASE(1)); }
    SBAR(); qkt<0, SK, FOX>(pA0, pA1, K_lds, r32, hi, S.qr, ACT(0), Fs + KBASE(0));
    MASKT(pA0, pA1, 0); partialSM(pA0, pA1, m_reg, mnA, alA);
    if (NT > 1) { VMW(); SWRITE_H(1); }
    __syncthreads();
#define HALF_STEP(PX0, PX1, mnX, alX, PY0, PY1, alY, t, KB, VB, SB) do {                                                      \
        SBAR(); qkt<KB, SK, FOX>(PX0, PX1, K_lds, r32, hi, S.qr, ACT(t), Fs + KBASE(t));                                     \
        finishSM(PY0, PY1, alY, l_reg, pa0, pa1, pa2, pa3); SBAR();                                                           \
        if ((t) + 1 < NT) { SLOAD_H(Kh, Vh, KBASE((t) + 1)); SBAR(); }                                                        \
        pv_tile<VB, SK>(o, vb0, pa0, pa1, pa2, pa3, ACT((t) - 1)); MASKT(PX0, PX1, (t)); partialSM(PX0, PX1, m_reg, mnX, alX);  \
        __syncthreads();                                                                                                      \
        if ((t) + 1 < NT) { VMW(); SWRITE_H(SB); }                                                                            \
        RESC(alX); __syncthreads(); } while (0)
    for (int t = 1; t + 1 < NT; t += 2) {
        HALF_STEP(pB0, pB1, mnB, alB, pA0, pA1, alA, t, 1, 0, 0);
        HALF_STEP(pA0, pA1, mnA, alA, pB0, pB1, alB, t + 1, 0, 1, 1);
        if constexpr (FOX) { if (t == 3 && NT > 6) {
            float mw = m_reg;
#pragma unroll
            for (int o_ = 1; o_ < 32; o_ <<= 1) mw = fminf(mw, __shfl_xor(mw, o_));
            if (lane == 0) li_l[0] = mw;
            asm volatile("s_waitcnt lgkmcnt(0)" ::: "memory"); __syncthreads();
            const LAS float* slot = (const LAS float*)(lds + LDS_WS); float mb = slot[0];
#pragma unroll
            for (int w_ = 1; w_ < NW; ++w_) mb = fminf(mb, slot[w_ * 64]);
            const LAS float* Fb = (const LAS float*)(lds + LDS_F);
            const unsigned long long alive = __ballot(Fb[64 * lane + 63] + cur.qk > mb - (40.0f / (1.4426950408889634f * SCALE) + 16.0f));
            int jd = alive ? (int)__builtin_ctzll(alive) : 63; if (jd < j_lo) jd = j_lo;
            int nt2 = j_hi - jd; if (nt2 < 6) nt2 = 6;
            if (nt2 < NT) NT = nt2;
        } }
    }
    const bool even = (NT & 1) == 0;
    if (even) { SBAR(); qkt<1, SK, FOX>(pB0, pB1, K_lds, r32, hi, S.qr, ACT(NT - 1), Fs + KBASE(NT - 1)); SBAR(); }
    SLOAD_H(T.K() + nxt.kvoff, T.V() + nxt.kvoff, kbn); SBAR();
    { const char* qu = (const char*)(T.Q() + nxt.qoff) + (size_t)wid * (QBLK * LDQ * 2);
#pragma unroll
      for (int d0 = 0; d0 < 8; ++d0) S.qr[d0] = *(const bf16x8*)(qu + d0 * 32 + qlane); }
    SBAR();
    finishSM(pA0, pA1, alA, l_reg, pa0, pa1, pa2, pa3); SBAR();
    pv_tile<0, SK>(o, vb0, pa0, pa1, pa2, pa3, ACT(even ? NT - 2 : NT - 1));
    if (even) { MASKT(pB0, pB1, NT - 1); partialSM(pB0, pB1, m_reg, mnB, alB); __syncthreads(); RESC(alB);
        finishSM(pB0, pB1, alB, l_reg, pa0, pa1, pa2, pa3); SBAR(); pv_tile<1, SK>(o, vb0, pa0, pa1, pa2, pa3, ACT(NT - 1)); }
    SBAR(); SEAM_K0();
    const int c8 = lane & 7, rr = lane >> 3;
    u32x4 zq[2][4];
    { const char* Zu = (const char*)(T.Z() + cur.qoff) + (size_t)wid * (QBLK * LDO * 2) + (unsigned)(rr * LDO + c8 * 8) * 2u;
#pragma unroll
      for (int h2 = 0; h2 < 2; ++h2)
#pragma unroll
          for (int j = 0; j < 4; ++j) zq[h2][j] = *(const u32x4*)(Zu + j * (8 * LDO * 2) + h2 * 128); }
    if constexpr (!FOX) l_reg += __builtin_amdgcn_exp2f(cur.sink_l2 - m_reg * (1.4426950408889634f * SCALE));
    if (hi == 0) li_l[r32] = l_reg; asm volatile("s_waitcnt lgkmcnt(0)" ::: "memory");
    float rli[16];
#pragma unroll
    for (int r = 0; r < 16; ++r) rli[r] = __builtin_amdgcn_rcpf(li_l[crow(r, hi)]);
    LAS float* ost = (LAS float*)(lds + LDS_OST) + wid * (32 * 64);
    char* Ou = (char*)(T.O() + cur.qoff) + (size_t)wid * (QBLK * LDO * 2) + (unsigned)(rr * LDO + c8 * 8) * 2u;
#pragma unroll
    for (int h2 = 0; h2 < 2; ++h2) {
#pragma unroll
        for (int r = 0; r < 16; ++r) { const int row = crow(r, hi); ost[row * 64 + r32] = o[2 * h2][r] * rli[r]; ost[row * 64 + 32 + r32] = o[2 * h2 + 1][r] * rli[r]; }
        asm volatile("s_waitcnt lgkmcnt(0)" ::: "memory");
#pragma unroll
        for (int j = 0; j < 4; ++j) { const LAS float* sp = ost + (rr + 8 * j) * 64 + c8 * 8; const f32x4 a = *(const LAS f32x4*)sp, bq = *(const LAS f32x4*)(sp + 4); const u32x4 z = zq[h2][j];
            u32x4 w; w.x = cvtpk(a[0] * __uint_as_float(z.x << 16), a[1] * __uint_as_float(z.x & 0xffff0000u)); w.y = cvtpk(a[2] * __uint_as_float(z.y << 16), a[3] * __uint_as_float(z.y & 0xffff0000u));
            w.z = cvtpk(bq[0] * __uint_as_float(z.z << 16), bq[1] * __uint_as_float(z.z & 0xffff0000u)); w.w = cvtpk(bq[2] * __uint_as_float(z.w << 16), bq[3] * __uint_as_float(z.w & 0xffff0000u));
            *(u32x4*)(Ou + j * (8 * LDO * 2) + h2 * 128) = w; }
        asm volatile("s_waitcnt lgkmcnt(0)" ::: "memory");
    }
    __syncthreads();
#undef Kh
#undef Vh
#undef RESC
#undef KBASE
#undef ACT
#undef MASKT
#undef SEAM_K0
#undef HALF_STEP
}
#undef UROW
#undef VMW
#undef VMWN
#undef SLOAD_H
#undef SWRITE_HK
#undef SWRITE_HV
#undef SWRITE_H
#undef SBAR
#undef KSWZ
}

#define XB_TMO      128
#define XB_XCNT(j)  (256  + 64 * (j))
#define XB_XSUB(j)  (1280 + 64 * (j))
#define XB_XGEN(j)  (2304 + 64 * (j))
#define XB_TOP      3328
#define XB_TOPGEN   3392
#define XCD_BAR_WORDS 3456
#define XB_SPIN_CAP (1u << 18)

__device__ __forceinline__ unsigned xb_ld(unsigned* p)              { return __hip_atomic_load(p, __ATOMIC_RELAXED, __HIP_MEMORY_SCOPE_AGENT); }
__device__ __forceinline__ unsigned xb_add(unsigned* p, unsigned v) { return __hip_atomic_fetch_add(p, v, __ATOMIC_RELAXED, __HIP_MEMORY_SCOPE_AGENT); }
__device__ __forceinline__ unsigned xb_xcc_id() { return (unsigned)__builtin_amdgcn_s_getreg((3 << 11) | 20) & 0xFu; }
#define XB_SPIN(cond, bar) do { unsigned _sp = 0; while (cond) { __builtin_amdgcn_s_sleep(1); \
    if ((++_sp & 255u) == 0u) { if (xb_ld(&(bar)[XB_TMO])) break; if (_sp > XB_SPIN_CAP) { atomicAdd(&(bar)[XB_TMO], 1u); break; } } } } while (0)

struct XcdBarrier {
    unsigned* bar; unsigned x;
    volatile LAS unsigned* st;
};

__device__ __forceinline__ XcdBarrier xcd_barrier_post(unsigned* bar, volatile LAS unsigned* st) {
    XcdBarrier b; b.bar = bar; b.x = xb_xcc_id(); b.st = st;
    if (threadIdx.x == 0) (void)xb_add(&bar[XB_XCNT(b.x)], 1u);
    return b;
}
__device__ __forceinline__ void xcd_barrier_complete(unsigned* bar, unsigned x, unsigned& nloc, unsigned& nx) {
    const unsigned G = gridDim.x * gridDim.y * gridDim.z;
    unsigned sum, cnt, mine, sp = 0u;
    for (;;) {
        sum = 0u; cnt = 0u; mine = 0u;
#pragma unroll
        for (unsigned j = 0; j < 16; ++j) { const unsigned c = xb_ld(&bar[XB_XCNT(j)]); sum += c; cnt += (c > 0u) ? 1u : 0u; mine = (j == x) ? c : mine; }
        if (sum == G) break;
        __builtin_amdgcn_s_sleep(1);
        if ((++sp & 255u) == 0u) { if (xb_ld(&bar[XB_TMO])) break; if (sp > XB_SPIN_CAP) { atomicAdd(&bar[XB_TMO], 1u); break; } }
    }
    nloc = mine > 0u ? mine : 1u; nx = cnt > 0u ? cnt : 1u;
}

__device__ __forceinline__ void xcd_barrier(const XcdBarrier& b) {
    asm volatile("s_waitcnt vmcnt(0)" ::: "memory");
    __syncthreads();
    if (threadIdx.x == 0) {
        unsigned* bar = b.bar;
        __builtin_amdgcn_s_waitcnt(0);
        unsigned nloc = b.st[0], nx = b.st[1];
        if (nloc == 0u) { xcd_barrier_complete(bar, b.x, nloc, nx); b.st[0] = nloc; b.st[1] = nx; }
        const unsigned old = xb_add(&bar[XB_XSUB(b.x)], 1u);
        const unsigned gen = old / nloc;
        if (old + 1u == (gen + 1u) * nloc) {
            __builtin_amdgcn_fence(__ATOMIC_RELEASE, "agent");
            asm volatile("s_waitcnt vmcnt(0)" ::: "memory");
            const unsigned og = xb_add(&bar[XB_TOP], 1u);
            const unsigned tg = og / nx;
            if (og + 1u == (tg + 1u) * nx) xb_add(&bar[XB_TOPGEN], 1u);
            else XB_SPIN(xb_ld(&bar[XB_TOPGEN]) == tg, bar);
            __builtin_amdgcn_fence(__ATOMIC_ACQUIRE, "agent");
            xb_add(&bar[XB_XGEN(b.x)], 1u);
            asm volatile("s_waitcnt vmcnt(0)" ::: "memory");
        } else {
            XB_SPIN(xb_ld(&bar[XB_XGEN(b.x)]) == gen, bar);
            __builtin_amdgcn_fence(__ATOMIC_ACQUIRE, "agent");
            asm volatile("s_waitcnt vmcnt(0)" ::: "memory");
        }
    }
    __syncthreads();
}


constexpr size_t MiB = 1u << 20;
constexpr size_t WS_CTL = 0, CTL_ZERO_BYTES = 1 * MiB;
constexpr size_t WS_SLAB = 1 * MiB;
constexpr size_t WS_MOD = 3 * MiB;
constexpr size_t WS_ROPE = 4 * MiB;
constexpr size_t WS_LOGF = 6 * MiB;
constexpr size_t WS_WFT = 7 * MiB;
constexpr size_t WS_W1T = 8 * MiB;
constexpr size_t WS_W2T = 136 * MiB;
constexpr size_t WS_W3T = 168 * MiB;
constexpr size_t WS_WKVT = 232 * MiB;
constexpr size_t WS_W4T = 240 * MiB;
constexpr size_t WS_HB = 272 * MiB;
constexpr size_t WS_KVN = 336 * MiB;
constexpr size_t WS_Q = 400 * MiB, WS_K = 464 * MiB, WS_V = 528 * MiB, WS_Z = 592 * MiB;
constexpr size_t WS_OG = 656 * MiB;
constexpr size_t WS_H1 = 720 * MiB;
constexpr size_t WS_KV1 = 848 * MiB;
constexpr size_t WS_FDBG = 864 * MiB;
constexpr size_t WS_END = 866 * MiB;
constexpr int CW_BAR = 4096;
constexpr int CW_QUEUE = 8192;
constexpr int CW_NORM = 8448;

constexpr int LDS_BYTES = 155648;
constexpr int MISC_OFF = LDS_BYTES - 256;
constexpr int NWAVES = 8, NTHR = 512;
static_assert(att::LDS_BYTES <= MISC_OFF && 131072 <= MISC_OFF, "LDS map");

struct Params { const float* in[14]; float* out; unsigned char* ws; int ph_lo, ph_hi; };
enum { I_X = 0, I_C, I_NORMG, I_ADAW, I_ADAB, I_AWIN, I_ABF, I_AWOUT, I_KVG, I_KVW, I_BWIN, I_SINK, I_BWOUT, I_FING };

struct Frame { LAS unsigned char* lds; int tid, lane, wave, vcu, G; };

__device__ __forceinline__ float wave_sum(float v) {
#pragma unroll
    for (int o = 1; o < 64; o <<= 1) v += __shfl_xor(v, o);
    return v;
}
__device__ __forceinline__ unsigned f2bf(float f) { unsigned u = __builtin_bit_cast(unsigned, f); return (u + 0x7fffu + ((u >> 16) & 1u)) >> 16; }
__device__ __forceinline__ unsigned pk2(float lo, float hi) { return f2bf(lo) | (f2bf(hi) << 16); }
__device__ __forceinline__ float bf2f(unsigned short b) { return __uint_as_float((unsigned)b << 16); }

#if defined(TR128)
template <class RowMap>
__device__ __forceinline__ void transpose_item(const float* W, int ldw, int K, int k0, int c0, bf16_t* WT, RowMap rowmap, LAS float* scr, int lane) {
    const int kk = lane >> 3, nn = (lane & 7) * 4;
    f32x4 v[16];
#pragma unroll
    for (int i = 0; i < 16; ++i) v[i] = *(const GAS f32x4*)(W + (size_t)(k0 + 8 * i + kk) * ldw + c0 + nn);
#pragma unroll
    for (int i = 0; i < 16; ++i) { LAS float* s = scr + (8 * i + kk) * 33 + nn; s[0] = v[i][0]; s[1] = v[i][1]; s[2] = v[i][2]; s[3] = v[i][3]; }
    asm volatile("s_waitcnt lgkmcnt(0)" ::: "memory");
    const int c = lane & 15, nr = lane >> 4;
#pragma unroll
    for (int j = 0; j < 8; ++j) { const int n = nr + 4 * j; const LAS float* s = scr + (8 * c) * 33 + n;
        u32x4 o; o.x = pk2(s[0 * 33], s[1 * 33]); o.y = pk2(s[2 * 33], s[3 * 33]); o.z = pk2(s[4 * 33], s[5 * 33]); o.w = pk2(s[6 * 33], s[7 * 33]);
        *(GAS u32x4*)(WT + (size_t)rowmap(c0 + n) * K + k0 + 8 * c) = o; }
    asm volatile("s_waitcnt lgkmcnt(0)" ::: "memory");
}
#define TR_KB 128
#define TR_NB 32
#define TR_SCR (128 * 33)
#else
template <class RowMap>
__device__ __forceinline__ void transpose_item(const float* W, int ldw, int K, int k0, int c0, bf16_t* WT, RowMap rowmap, LAS float* scr, int lane) {
    const int kk = lane >> 4, nn = (lane & 15) * 4;
    f32x4 v[16];
#pragma unroll
    for (int i = 0; i < 16; ++i) v[i] = *(const GAS f32x4*)(W + (size_t)(k0 + 4 * i + kk) * ldw + c0 + nn);
#pragma unroll
    for (int i = 0; i < 16; ++i) { LAS float* s = scr + (4 * i + kk) * 65 + nn; s[0] = v[i][0]; s[1] = v[i][1]; s[2] = v[i][2]; s[3] = v[i][3]; }
    asm volatile("s_waitcnt lgkmcnt(0)" ::: "memory");
    const int c = lane & 7, nr = lane >> 3;
#pragma unroll
    for (int j = 0; j < 8; ++j) { const int n = nr + 8 * j; const LAS float* s = scr + (8 * c) * 65 + n;
        u32x4 o; o.x = pk2(s[0 * 65], s[1 * 65]); o.y = pk2(s[2 * 65], s[3 * 65]); o.z = pk2(s[4 * 65], s[5 * 65]); o.w = pk2(s[6 * 65], s[7 * 65]);
        *(GAS u32x4*)(WT + (size_t)rowmap(c0 + n) * K + k0 + 8 * c) = o; }
    asm volatile("s_waitcnt lgkmcnt(0)" ::: "memory");
}
#define TR_KB 64
#define TR_NB 64
#define TR_SCR (64 * 65)
#endif
struct RowId { __device__ __forceinline__ int operator()(int c) const { return c; } };
struct RowRope { int lim; __device__ __forceinline__ int operator()(int c) const { if (c >= lim) return c; const int j = c & 127, jj = j & 63; return (c & ~127) + 8 * (jj >> 2) + ((j >> 6) << 2) + (jj & 3); } };

__device__ __forceinline__ void p0_prologue(const Frame& F, const Params& P) {
    unsigned char* ws = P.ws;
#ifndef P0A_REP
#define P0A_REP 1
#endif
    _Pragma("unroll 1") for (int repa_ = 0; repa_ < P0A_REP; ++repa_)
    {
        LAS float* sc = (LAS float*)F.lds;
        LAS float* red = (LAS float*)(F.lds + 32768);
        const float* c = P.in[I_C];
        for (int i = F.tid; i < 2 * DM; i += NTHR) { const float v = c[i]; sc[i] = v / (1.0f + __expf(-v)); }
        __syncthreads();
        float* slab = (float*)(ws + WS_SLAB);
        for (int t = F.vcu; t < 768; t += F.G) {
            const int cg = t % 96, ks = t / 96, l = cg / 48, n0 = (cg % 48) * 256;
            const float* Wp = P.in[I_ADAW] + (size_t)l * DM * MOD + (size_t)(ks * 512 + F.wave * 64) * MOD + n0 + 4 * F.lane;
            const LAS float* s0 = sc + ks * 512 + F.wave * 64; const LAS float* s1 = s0 + DM;
            f32x4 a0 = (f32x4){0.f, 0.f, 0.f, 0.f}, a1 = a0;
#pragma unroll 16
            for (int kk = 0; kk < 64; ++kk) { const f32x4 w = *(const GAS f32x4*)(Wp + (size_t)kk * MOD); a0 += w * s0[kk]; a1 += w * s1[kk]; }
            *(LAS f32x4*)(red + (F.wave * 2 + 0) * 256 + 4 * F.lane) = a0; *(LAS f32x4*)(red + (F.wave * 2 + 1) * 256 + 4 * F.lane) = a1;
            __syncthreads();
            { const int b = F.tid >> 8, col = F.tid & 255; float s = 0.f;
#pragma unroll
              for (int w = 0; w < 8; ++w) s += red[(w * 2 + b) * 256 + col];
              slab[(size_t)((ks * 2 + l) * 2 + b) * MOD + n0 + col] = s; }
            __syncthreads();
        }
    }
    {
        LAS float* scr = (LAS float*)F.lds + F.wave * TR_SCR;
        const int gw = F.vcu * NWAVES + F.wave, NGW = F.G * NWAVES;
        constexpr int KBL = DM / TR_KB;
        constexpr int I1 = KBL * (N1 / TR_NB), I2 = KBL * (DM / TR_NB), IKV = KBL * (NKV2 / TR_NB), I3 = KBL * (N3 / TR_NB), I4 = I2;
        constexpr int NIT = I1 + I2 + IKV + I3 + I4;
        for (int it = gw; it < NIT; it += NGW) {
            int r = it;
            if (r < I2) { transpose_item(P.in[I_AWOUT], DM, DM, (r % KBL) * TR_KB, (r / KBL) * TR_NB, (bf16_t*)(ws + WS_W2T), RowId{}, scr, F.lane); continue; } r -= I2;
            if (r < IKV) { transpose_item(P.in[I_KVW], NKV2, DM, (r % KBL) * TR_KB, (r / KBL) * TR_NB, (bf16_t*)(ws + WS_WKVT), RowRope{KVW}, scr, F.lane); continue; } r -= IKV;
            if (r < I3) { transpose_item(P.in[I_BWIN], N3, DM, (r % KBL) * TR_KB, (r / KBL) * TR_NB, (bf16_t*)(ws + WS_W3T), RowRope{DM}, scr, F.lane); continue; } r -= I3;
            if (r < I4) { transpose_item(P.in[I_BWOUT], DM, DM, (r % KBL) * TR_KB, (r / KBL) * TR_NB, (bf16_t*)(ws + WS_W4T), RowId{}, scr, F.lane); continue; } r -= I4;
            transpose_item(P.in[I_AWIN], N1F, DM, (r % KBL) * TR_KB, (r / KBL) * TR_NB, (bf16_t*)(ws + WS_W1T), RowId{}, scr, F.lane);
        }
    }
    {
        const int gt = F.vcu * NTHR + F.tid, NGT = F.G * NTHR;
        bf16_t* wft = (bf16_t*)(ws + WS_WFT); const float* W = P.in[I_AWIN];
        for (int i = gt; i < NH * DM; i += NGT) { const int k = i >> 5, n = i & 31; wft[(size_t)n * DM + k] = (bf16_t)f2bf(W[(size_t)k * N1F + N1 + n]); }
        float* cs = (float*)(ws + WS_ROPE); float* sn = cs + SEQ * 64;
        for (int i = gt; i < SEQ * 64; i += NGT) {
            const int pos = i >> 6, j = i & 63;
            double th = 1.0; for (int q = 0; q < j; ++q) th *= 0.8659643233600653523531691834202299819398;
            const double t2 = th * th; double cc = 1.0, ss = th, tc = 1.0, ts = th;
#pragma unroll
            for (int q = 1; q <= 11; ++q) { tc *= t2 * (-1.0 / (double)((2 * q - 1) * (2 * q))); ts *= t2 * (-1.0 / (double)((2 * q) * (2 * q + 1))); cc += tc; ss += ts; }
            double rc = 1.0, rs = 0.0;
            for (int mbit = 0; mbit < 12; ++mbit) {
                if ((pos >> mbit) & 1) { const double nc = rc * cc - rs * ss, ns = rs * cc + rc * ss; rc = nc; rs = ns; }
                const double c2 = cc * cc - ss * ss, s2 = 2.0 * ss * cc; cc = c2; ss = s2;
            }
            cs[i] = (float)rc; sn[i] = (float)rs;
        }
    }
}

__device__ __forceinline__ void p1_norm0(const Frame& F, const Params& P) {
    unsigned char* ws = P.ws;
    const float* slab = (const float*)(ws + WS_SLAB); float* mod = (float*)(ws + WS_MOD);
    for (int i = F.vcu * NTHR + F.tid; i < 2 * 2 * MOD; i += F.G * NTHR) {
        const int n = i % MOD, lb = i / MOD, l = lb >> 1; float s = P.in[I_ADAB][l * MOD + n];
#pragma unroll
        for (int ks = 0; ks < 8; ++ks) s += slab[(size_t)(ks * 4 + lb) * MOD + n];
        mod[i] = s;
    }
    LAS float* gs = (LAS float*)F.lds; LAS float* sh = gs + DM;
    LAS float* red = sh + DM;
    bf16_t* h0 = (bf16_t*)(ws + WS_HB); const bf16_t* wft = (const bf16_t*)(ws + WS_WFT); float* logf = (float*)(ws + WS_LOGF);
    for (int rb = F.vcu; rb < M / 32; rb += F.G) {
        const int row0 = rb * 32, b = row0 / SEQ;
        __syncthreads();
        for (int k = F.tid; k < DM; k += NTHR) {
            float s_sh = P.in[I_ADAB][k], s_sc = P.in[I_ADAB][DM + k];
#pragma unroll
            for (int ks = 0; ks < 8; ++ks) { const float* sl = slab + (size_t)(ks * 4 + b) * MOD; s_sh += sl[k]; s_sc += sl[DM + k]; }
            gs[k] = P.in[I_NORMG][k] * (1.0f + s_sc); sh[k] = s_sh;
        }
        __syncthreads();
#pragma unroll 1
        for (int rr = 0; rr < 4; ++rr) {
            const int row = row0 + F.wave * 4 + rr;
            const GAS f32x4* xr = (const GAS f32x4*)(P.in[I_X] + (size_t)row * DM) + F.lane;
            f32x4 v[16]; float ss = 0.f;
#pragma unroll
            for (int j = 0; j < 16; ++j) { v[j] = __builtin_nontemporal_load(xr + 64 * j); ss += (v[j].x * v[j].x + v[j].y * v[j].y) + (v[j].z * v[j].z + v[j].w * v[j].w); }
            const float rstd = 1.0f / sqrtf(wave_sum(ss) * (1.0f / DM) + EPS);
            GAS u32x2* o8 = (GAS u32x2*)(h0 + (size_t)row * DM) + F.lane;
#pragma unroll
            for (int j = 0; j < 16; ++j) { const f32x4 g = *(const LAS f32x4*)(gs + 256 * j + 4 * F.lane), s = *(const LAS f32x4*)(sh + 256 * j + 4 * F.lane);
                const f32x4 y = v[j] * rstd * g + s; u32x2 w; w.x = pk2(y.x, y.y); w.y = pk2(y.z, y.w); o8[64 * j] = w; }
        }
        asm volatile("s_waitcnt vmcnt(0)" ::: "memory");
        __syncthreads();
        {
            const int r = F.lane & 31, hh = F.lane >> 5;
            const bf16_t* ap = wft + (size_t)r * DM + F.wave * 512 + 8 * hh;
            const bf16_t* bp = h0 + (size_t)(row0 + r) * DM + F.wave * 512 + 8 * hh;
            f32x16 acc = {};
#pragma unroll 8
            for (int k = 0; k < 512; k += 16) { const bf16x8 a = *(const GAS bf16x8*)(ap + k), bb = *(const GAS bf16x8*)(bp + k); acc = __builtin_amdgcn_mfma_f32_32x32x16_bf16(a, bb, acc, 0, 0, 0); }
#pragma unroll
            for (int q = 0; q < 16; ++q) red[(F.wave * 16 + q) * 64 + F.lane] = acc[q];
            __syncthreads();
#pragma unroll
            for (int qq = 0; qq < 2; ++qq) { const int q = 2 * F.wave + qq; float s = 0.f;
#pragma unroll
                for (int w = 0; w < 8; ++w) s += red[(w * 16 + q) * 64 + F.lane];
                const int n = (q & 3) + 8 * (q >> 2) + 4 * hh;
                const float xg = s + P.in[I_ABF][n];
                const float lf = fminf(xg, 0.f) - log1pf(__expf(-fabsf(xg)));
                logf[(size_t)(b * NH + n) * SEQ + (row0 % SEQ) + r] = lf; }
        }
    }
}

template <class DstPtr>
__device__ __forceinline__ void scan_logf(const Frame& F, const float* lf, DstPtr dst, float scale, LAS float* wsum) {
    unsigned lo_ = 32u * (unsigned)F.tid; asm volatile("" : "+v"(lo_));
    const f32x4 a = *(const GAS f32x4*)((const char*)lf + lo_), b = *(const GAS f32x4*)((const char*)lf + lo_ + 16);
    float v[8] = {a.x, a.y, a.z, a.w, b.x, b.y, b.z, b.w};
#pragma unroll
    for (int e = 1; e < 8; ++e) v[e] += v[e - 1];
    const float total = v[7]; float incl = total; int ln_ = (int)(lo_ >> 5) & 63;
#pragma unroll
    for (int o = 1; o < 64; o <<= 1) { const float n = __int_as_float(__builtin_amdgcn_ds_bpermute((ln_ - o) << 2, __float_as_int(incl))); if (ln_ >= o) incl += n; }
    if (ln_ == 63) wsum[F.wave] = incl;
    __syncthreads();
    float off = incl - total;
    for (int w = 0; w < F.wave; ++w) off += wsum[w];
#pragma unroll
    for (int e = 0; e < 8; ++e) dst[8 * F.tid + e] = scale * (off + v[e]);
    __syncthreads();
}

__device__ __forceinline__ att::BlockRef fox_ref(int n, int jlo, float qk) {
    const int qb = 15 - (n >> 6), bh = n & 63, b = bh >> 5, h = bh & 31; att::BlockRef r;
    r.kvoff = (unsigned)b * (SEQ * DM) + h * HD; r.qoff = r.kvoff + (unsigned)qb * (256u * DM); r.P0 = qb * 256; r.jlo = jlo; r.sink_l2 = 0.f; r.qk = qk; return r;
}
__device__ __forceinline__ int fox_jlo(const Frame& F, int n, const unsigned* nrm, float& qk) {
    const int qb = 15 - (n >> 6), bh = n & 63, b = bh >> 5, h = bh & 31;
    const float* nq = (const float*)nrm + ((0 * 2 + b) * 32 + h) * 4; const float* nk = (const float*)nrm + ((1 * 2 + b) * 32 + h) * 4;
    const float q2 = (nq[0] + nq[1]) + (nq[2] + nq[3]), k2 = (nk[0] + nk[1]) + (nk[2] + nk[3]);
    qk = 1.03f * sqrtf(q2 * k2);
    const float X = 40.0f / (LOG2E * att::SCALE) + att::THR / att::SCALE + 2.0f * qk + 16.0f;
#if defined(PROBE_X)
    const float Xp = (float)(PROBE_X);
#define X Xp
#endif
    const LAS float* Fs = (const LAS float*)(F.lds + att::LDS_F);
    const float thresh = Fs[qb * 256] - X;
    const unsigned long long m = __ballot(Fs[64 * F.lane + 63] > thresh);
    return m ? __builtin_ctzll(m) : 63;
#if defined(PROBE_X)
#undef X
#endif
}
__device__ __forceinline__ void p3_fox(const Frame& F, const Params& P, LAS char* lds, volatile LAS unsigned* MISC) {
    unsigned char* ws = P.ws;
#define logf ((const float*)(ws + WS_LOGF))
#define qhead ((unsigned*)(ws + WS_CTL) + CW_QUEUE)
#define nrm ((const unsigned*)(ws + WS_CTL) + CW_NORM)
    att::Bases<WS_Q, WS_K, WS_V, WS_Z, WS_OG> T; T.ws = ws;
    int n_cur = F.vcu;
    if (F.tid == 0) MISC[16] = 256u + __hip_atomic_fetch_add(qhead, 1u, __ATOMIC_RELAXED, __HIP_MEMORY_SCOPE_AGENT);
    scan_logf(F, logf + (size_t)(n_cur & 63) * SEQ, (LAS float*)(F.lds + att::LDS_F), -SQRT_HD, (LAS float*)(F.lds + att::LDS_WS));
    int n_nxt = (int)MISC[16];
    att::Seam S;
    float qk_ = 0.f; const int jl0_ = fox_jlo(F, n_cur, nrm, qk_);
    att::BlockRef cur = fox_ref(n_cur, jl0_, qk_);
    att::attn_prime<true, DM, DM>(T, cur, 1 << 28, lds, S);
#pragma unroll 1
    for (;;) {
        const bool has_next = n_nxt < 1024;
        unsigned n_nn = 0u;
        if (F.tid == 0) n_nn = 256u + __hip_atomic_fetch_add(qhead, 1u, __ATOMIC_RELAXED, __HIP_MEMORY_SCOPE_AGENT);
        const att::BlockRef nxt = has_next ? fox_ref(n_nxt, 0, 0.f) : cur;
        att::attn_block<true, DM, DM, DM>(T, cur, nxt, SEQ, 1 << 28, lds, S);
        if (!has_next) break;
        if (F.tid == 0) MISC[16] = n_nn;
        if ((n_nxt & 63) != (n_cur & 63)) scan_logf(F, logf + (size_t)(n_nxt & 63) * SEQ, (LAS float*)(F.lds + att::LDS_F), -SQRT_HD, (LAS float*)(F.lds + att::LDS_WS));
        else __syncthreads();
        { float qk2_ = 0.f; const int jl_ = fox_jlo(F, n_nxt, nrm, qk2_); cur = fox_ref(n_nxt, jl_, qk2_); }
        n_cur = n_nxt; n_nxt = (int)MISC[16];
        __syncthreads();
    }
#undef logf
#undef qhead
#undef nrm
}
__device__ __forceinline__ att::BlockRef swa_ref(int idx, int b, int kvh, const float* sinks) {
    const int h = kvh * 8 + (idx >> 4), qb = idx & 15; att::BlockRef r; r.qoff = ((unsigned)b * SEQ + (unsigned)qb * 256u) * DM + h * HD; r.kvoff = (unsigned)b * (SEQ * NKV2) + kvh * HD; r.P0 = qb * 256; r.jlo = 0; r.qk = 0.f; r.sink_l2 = sinks[h] * LOG2E; return r;
}
__device__ __forceinline__ void p7_swa(const Frame& F, const Params& P, LAS char* lds) {
    unsigned char* ws = P.ws;
    { const int it = F.vcu;
        const int g8 = it >> 5, b = g8 >> 2, kvh = g8 & 3, i0 = (it & 31) * 4;
        att::Bases<WS_Q, WS_KV1, WS_KV1 + (size_t)KVW * 2, WS_Z, WS_OG> T; T.ws = ws;
        att::Seam S;
        att::BlockRef cur = swa_ref(i0, b, kvh, P.in[I_SINK]);
        att::attn_prime<false, DM, NKV2>(T, cur, 128, lds, S);
#pragma unroll 1
        for (int t = 0; t < 4; ++t) { const att::BlockRef nxt = (t < 3) ? swa_ref(i0 + t + 1, b, kvh, P.in[I_SINK]) : cur; att::attn_block<false, DM, NKV2, DM>(T, cur, nxt, SEQ, 128, lds, S); cur = nxt; }
    }
}

__device__ __forceinline__ void p5_norm1(const Frame& F, const Params& P) {
    unsigned char* ws = P.ws;
    const float* mod = (const float*)(ws + WS_MOD); const float* h1 = (const float*)(ws + WS_H1);
    bf16_t* hb = (bf16_t*)(ws + WS_HB); bf16_t* kvn = (bf16_t*)(ws + WS_KVN);
    LAS float* gs = (LAS float*)F.lds; LAS float* sh = gs + DM; LAS float* gk = sh + DM;
    for (int rb = F.vcu; rb < M / 32; rb += F.G) {
        const int row0 = rb * 32, b = row0 / SEQ;
        __syncthreads();
        for (int k = F.tid; k < DM; k += NTHR) { const float* m1 = mod + (size_t)(2 + b) * MOD; gs[k] = P.in[I_NORMG][DM + k] * (1.0f + m1[DM + k]); sh[k] = m1[k]; gk[k] = P.in[I_KVG][k]; }
        __syncthreads();
#pragma unroll 1
        for (int rr = 0; rr < 4; ++rr) {
            const int row = row0 + F.wave * 4 + rr;
            const GAS f32x4* xr = (const GAS f32x4*)(h1 + (size_t)row * DM) + F.lane;
            f32x4 v[16]; float ss = 0.f;
#pragma unroll
            for (int j = 0; j < 16; ++j) { v[j] = xr[64 * j]; ss += (v[j].x * v[j].x + v[j].y * v[j].y) + (v[j].z * v[j].z + v[j].w * v[j].w); }
            const float rstd = 1.0f / sqrtf(wave_sum(ss) * (1.0f / DM) + EPS);
            GAS u32x2* o1 = (GAS u32x2*)(hb + (size_t)row * DM) + F.lane; GAS u32x2* o2 = (GAS u32x2*)(kvn + (size_t)row * DM) + F.lane;
#pragma unroll
            for (int j = 0; j < 16; ++j) { const int kx = 256 * j + 4 * F.lane; const f32x4 g = *(const LAS f32x4*)(gs + kx), s = *(const LAS f32x4*)(sh + kx), k4 = *(const LAS f32x4*)(gk + kx);
                const f32x4 xn = v[j] * rstd, y = xn * g + s, z = xn * k4; u32x2 w; w.x = pk2(y.x, y.y); w.y = pk2(y.z, y.w); o1[64 * j] = w; w.x = pk2(z.x, z.y); w.y = pk2(z.z, z.w); o2[64 * j] = w;
                asm volatile("" ::: "memory"); }
        }
    }
}
__device__ __forceinline__ void p9_final(const Frame& F, const Params& P) {
    LAS float* gf = (LAS float*)F.lds;
    __syncthreads();
    for (int k = F.tid; k < DM; k += NTHR) gf[k] = P.in[I_FING][k];
    __syncthreads();
    const int gw = F.vcu * NWAVES + F.wave, NGW = F.G * NWAVES;
    for (int row = gw; row < M; row += NGW) {
        GAS f32x4* xr = (GAS f32x4*)(P.out + (size_t)row * DM) + F.lane;
        f32x4 v[16]; float ss = 0.f;
#pragma unroll
        for (int j = 0; j < 16; ++j) { v[j] = xr[64 * j]; ss += (v[j].x * v[j].x + v[j].y * v[j].y) + (v[j].z * v[j].z + v[j].w * v[j].w); }
        const float rstd = 1.0f / sqrtf(wave_sum(ss) * (1.0f / DM) + EPS);
#pragma unroll
        for (int j = 0; j < 16; ++j) xr[64 * j] = v[j] * rstd * *(const LAS f32x4*)(gf + 256 * j + 4 * F.lane);
    }
}


template <class E, class Sched>
__device__ __forceinline__ void naive_gemm_bf16(const Frame& F, const bf16_t* A, const bf16_t* Bt, int K, const Sched& S, const E& e, const float* cs, const float* sn) {
    const int r = F.lane & 31, hh = F.lane >> 5; pg8::Unit u;
    for (int i = 0; S.next(i, u); ++i) {
        const pg8::Dest d = e.dest(u); const int rowu = e.row_of(u);
        for (int t = F.wave; t < 64; t += NWAVES) {
            const int tr = t >> 3, tc = t & 7;
            const bf16_t* ap = A + ((size_t)u.pm * 256 + tr * 32 + r) * K + 8 * hh; const bf16_t* bp = Bt + ((size_t)u.pn * 256 + tc * 32 + r) * K + 8 * hh;
            f32x16 acc = {};
#pragma unroll 4
            for (int k = 0; k < K; k += 16) { const bf16x8 a = *(const GAS bf16x8*)(ap + k), b = *(const GAS bf16x8*)(bp + k); acc = __builtin_amdgcn_mfma_f32_32x32x16_bf16(a, b, acc, 0, 0, 0); }
#pragma unroll
            for (int q = 0; q < 16; ++q) {
                const int row = rowu + tr * 32 + (q & 3) + 8 * (q >> 2) + 4 * hh, p = tc * 32 + r; float v = acc[q];
                if (d.mode == 1) v = pg8::silu_f(v);
                const float partner = __shfl_xor(v, 4);
                if (d.mode == 2) { const int pos = row & 4095, j = 4 * ((p & 127) >> 3) + (p & 3); const float c = cs[pos * 64 + j], s = sn[pos * 64 + j]; v = (p & 4) ? (v * c + partner * s) : (v * c - partner * s); }
                d.p[(size_t)row * d.ld + p] = (bf16_t)f2bf(v);
            }
        }
    }
}
template <class Sched>
__device__ __forceinline__ void naive_gemm_resgate(const Frame& F, const bf16_t* A, const bf16_t* Bt, int K, const Sched& S, const pg8::EpiResGate& e) {
    const int r = F.lane & 31, hh = F.lane >> 5; pg8::Unit u;
    for (int i = 0; S.next(i, u); ++i)
        for (int t = F.wave; t < 64; t += NWAVES) {
            const int tr = t >> 3, tc = t & 7;
            const bf16_t* ap = A + ((size_t)u.pm * 256 + tr * 32 + r) * K + 8 * hh; const bf16_t* bp = Bt + ((size_t)u.pn * 256 + tc * 32 + r) * K + 8 * hh;
            f32x16 acc = {};
#pragma unroll 4
            for (int k = 0; k < K; k += 16) { const bf16x8 a = *(const GAS bf16x8*)(ap + k), b = *(const GAS bf16x8*)(bp + k); acc = __builtin_amdgcn_mfma_f32_32x32x16_bf16(a, b, acc, 0, 0, 0); }
#pragma unroll
            for (int q = 0; q < 16; ++q) { const int row = u.pm * 256 + tr * 32 + (q & 3) + 8 * (q >> 2) + 4 * hh, col = u.pn * 256 + tc * 32 + r; const size_t off = (size_t)row * 4096 + col;
                e.out[off] = e.base[off] + e.gate[(size_t)(row >> 12) * e.gate_ld + col] * acc[q]; }
        }
}
template <bool FOX>
__device__ __forceinline__ void naive_attn(const Frame& F, const Params& P) {
    unsigned char* ws = P.ws;
    const bf16_t* Q = (const bf16_t*)(ws + WS_Q); const bf16_t* Z = (const bf16_t*)(ws + WS_Z); bf16_t* OG = (bf16_t*)(ws + WS_OG);
    LAS float* Fl = (LAS float*)F.lds; LAS float* qs = Fl + 4096 + F.wave * 128; LAS float* wsum = Fl + 4096 + 8 * 128;
    for (int it = F.vcu; it < 256; it += F.G) {
        const int bh = it >> 2, s4 = it & 3, b = bh >> 5, h = bh & 31;
        __syncthreads();
        if (FOX) scan_logf(F, (const float*)(ws + WS_LOGF) + (size_t)bh * SEQ, Fl, 1.0f, wsum);
        const bf16_t* Kp; const bf16_t* Vp; int ldkv;
        if (FOX) { Kp = (const bf16_t*)(ws + WS_K) + (size_t)b * SEQ * DM + h * HD; Vp = (const bf16_t*)(ws + WS_V) + (size_t)b * SEQ * DM + h * HD; ldkv = DM; }
        else { Kp = (const bf16_t*)(ws + WS_KV1) + (size_t)b * SEQ * NKV2 + (h >> 3) * HD; Vp = Kp + KVW; ldkv = NKV2; }
        const float sink = FOX ? 0.f : P.in[I_SINK][h];
        for (int t = F.wave; t < SEQ / 4; t += NWAVES) {
            const int i = 4 * t + s4; const size_t qo = ((size_t)b * SEQ + i) * DM + h * HD;
            { const unsigned qq = *(const GAS unsigned*)(Q + qo + 2 * F.lane); qs[2 * F.lane] = __uint_as_float(qq << 16) * att::SCALE; qs[2 * F.lane + 1] = __uint_as_float(qq & 0xffff0000u) * att::SCALE; }
            asm volatile("s_waitcnt lgkmcnt(0)" ::: "memory");
            float m = -1e30f, l = 0.f, o0 = 0.f, o1 = 0.f;
            const int jst = FOX ? 0 : (i > 127 ? i - 127 : 0);
            for (int jc = jst; jc <= i; jc += 64) {
                const int j = jc + F.lane; const bool valid = j <= i; const int jl = valid ? j : i;
                const bf16_t* kr = Kp + (size_t)jl * ldkv; float dot = 0.f;
#pragma unroll 4
                for (int d = 0; d < 128; d += 8) { const u32x4 kk = *(const GAS u32x4*)(kr + d); const LAS float* qd = qs + d;
                    dot += __uint_as_float(kk.x << 16) * qd[0] + __uint_as_float(kk.x & 0xffff0000u) * qd[1] + __uint_as_float(kk.y << 16) * qd[2] + __uint_as_float(kk.y & 0xffff0000u) * qd[3]
                         + __uint_as_float(kk.z << 16) * qd[4] + __uint_as_float(kk.z & 0xffff0000u) * qd[5] + __uint_as_float(kk.w << 16) * qd[6] + __uint_as_float(kk.w & 0xffff0000u) * qd[7]; }
                float sv = dot; if (FOX) sv += Fl[i] - Fl[jl];
                if (!valid) sv = -__builtin_inff();
                float cm = sv;
#pragma unroll
                for (int o = 1; o < 64; o <<= 1) cm = fmaxf(cm, __shfl_xor(cm, o));
                const float mn = fmaxf(m, cm), alpha = __expf(m - mn), p = valid ? __expf(sv - mn) : 0.f;
                l = l * alpha + wave_sum(p); o0 *= alpha; o1 *= alpha; m = mn;
                const int nj = (i - jc + 1) < 64 ? (i - jc + 1) : 64;
                for (int jj = 0; jj < nj; ++jj) { const float pj = __shfl(p, jj); const bf16_t* vr = Vp + (size_t)(jc + jj) * ldkv; o0 += pj * bf2f(vr[F.lane]); o1 += pj * bf2f(vr[F.lane + 64]); }
            }
            if (!FOX) l += __expf(sink - m);
            const float rl = 1.0f / l;
            OG[qo + F.lane] = (bf16_t)f2bf(o0 * rl * bf2f(Z[qo + F.lane])); OG[qo + F.lane + 64] = (bf16_t)f2bf(o1 * rl * bf2f(Z[qo + F.lane + 64]));
        }
    }
}

constexpr int NPHASE = 10;
__global__ void __launch_bounds__(NTHR, 2) fwd(Params P) {
    extern __shared__ __attribute__((aligned(16))) unsigned char lds[];
#define MAKE_FRAME() Frame F; { unsigned t_ = threadIdx.x; asm volatile("" : "+v"(t_)); F.lds = (LAS unsigned char*)lds; F.tid = (int)t_; F.lane = F.tid & 63; F.wave = __builtin_amdgcn_readfirstlane(F.tid >> 6); \
        F.G = gridDim.x; const int bx_ = blockIdx.x; F.vcu = (F.G % 8 == 0) ? (bx_ % 8) * (F.G / 8) + bx_ / 8 : bx_; }
    volatile LAS unsigned* MISC = (volatile LAS unsigned*)((LAS unsigned char*)lds + MISC_OFF);
    for (int u = threadIdx.x; u < (LDS_BYTES - MISC_OFF) / 4; u += NTHR) MISC[u] = 0u;
    __syncthreads();
    unsigned char* ws = P.ws;
    const int lo = P.ph_lo, hi = P.ph_hi;
    if (hi - lo > 1) (void)xcd_barrier_post((unsigned*)(ws + WS_CTL) + CW_BAR, MISC + 8);
#ifndef PH_MASK
#define PH_MASK 0x3ff
#endif
#define IN(k) (((PH_MASK >> (k)) & 1) && lo <= (k) && (k) < hi)
#ifndef SEAM_TWICE
#define SEAM_TWICE 0
#endif
#define SEAM(k) do { if (IN(k) && IN((k) + 1)) { XcdBarrier bar_; bar_.bar = (unsigned*)(ws + WS_CTL) + CW_BAR; bar_.x = xb_xcc_id(); bar_.st = MISC + 8; xcd_barrier(bar_); if (SEAM_TWICE) xcd_barrier(bar_); } } while (0)
#ifndef REP_MASK
#define REP_MASK 0
#endif
#define REPS(k) _Pragma("unroll 1") for (int rep_ = 0; rep_ < (((REP_MASK >> (k)) & 1) ? 2 : 1); ++rep_)
#define cs ((const float*)(ws + WS_ROPE))
#define sn ((const float*)(ws + WS_ROPE) + SEQ * 64)
#define mod ((const float*)(ws + WS_MOD))

    if (IN(0)) { MAKE_FRAME(); REPS(0) { p0_prologue(F, P); } SEAM(0); }
    if (IN(1)) { MAKE_FRAME(); REPS(1) { p1_norm0(F, P); } SEAM(1); }
    if (IN(2)) { MAKE_FRAME();
        REPS(2) {
        pg8::StaticOrder S; S.init(M, N1, F.G, (int)blockIdx.x);
        pg8::EpiStoreBf16<pg8::EpiQKVZ> E{{(bf16_t*)(ws + WS_Q), (WS_K - WS_Q) / 2}, cs, sn, (unsigned*)(ws + WS_CTL) + CW_NORM};
#if NAIVE_GEMM
        naive_gemm_bf16(F, (const bf16_t*)(ws + WS_HB), (const bf16_t*)(ws + WS_W1T), DM, S, E.e, cs, sn);
        if (blockIdx.x == 0) for (int i = F.tid; i < 512; i += NTHR) E.nrm[i] = __float_as_uint(1e12f);
#else
        pg8::Gemm g{(const bf16_t*)(ws + WS_HB), (const bf16_t*)(ws + WS_W1T), M, N1, DM};
#if defined(PROBE_NULL_EPI)
        { pg8::EpiNull EN; pg8::gemm_phase<pg8::EpiNull, pg8::StaticOrder, true, true>(F.lds, g, S, EN); }
#endif
        pg8::gemm_phase<pg8::EpiStoreBf16<pg8::EpiQKVZ>, pg8::StaticOrder, true, true>(F.lds, g, S, E);
#endif
        }
        SEAM(2);
    }
    if (IN(3)) { MAKE_FRAME();
        REPS(3) {
#if NAIVE_FOX
        naive_attn<true>(F, P);
#else
        p3_fox(F, P, (LAS char*)F.lds, MISC);
#endif
        }
        SEAM(3);
    }
    if (IN(4)) { MAKE_FRAME();
        REPS(4) {
        pg8::StaticOrder S; S.init(M, DM, F.G, (int)blockIdx.x);
        pg8::EpiResGate E{P.in[I_X], (float*)(ws + WS_H1), mod + 2 * DM, MOD};
#if NAIVE_GEMM
        naive_gemm_resgate(F, (const bf16_t*)(ws + WS_OG), (const bf16_t*)(ws + WS_W2T), DM, S, E);
#else
        pg8::Gemm g{(const bf16_t*)(ws + WS_OG), (const bf16_t*)(ws + WS_W2T), M, DM, DM};
        pg8::gemm_phase<pg8::EpiResGate, pg8::StaticOrder, true, true>(F.lds, g, S, E);
#endif
        }
        SEAM(4);
    }
    if (IN(5)) { MAKE_FRAME(); REPS(5) { p5_norm1(F, P); } SEAM(5); }
    if (IN(6)) { MAKE_FRAME();
        REPS(6) {
        pg8::OrderQZKV S; S.init(F.G, (int)blockIdx.x);
        pg8::EpiStoreBf16<pg8::EpiQZKV> E{{(bf16_t*)(ws + WS_Q), (bf16_t*)(ws + WS_Z), (bf16_t*)(ws + WS_KV1)}, cs, sn, nullptr};
#if NAIVE_GEMM
        naive_gemm_bf16(F, (const bf16_t*)(ws + WS_HB), (const bf16_t*)(ws + WS_W3T), DM, S, E.e, cs, sn);
#else
        pg8::Gemm g{(const bf16_t*)(ws + WS_HB), (const bf16_t*)(ws + WS_W3T), 2 * M, N3 + NKV2, DM};
        pg8::gemm_phase<pg8::EpiStoreBf16<pg8::EpiQZKV>, pg8::OrderQZKV, true, true>(F.lds, g, S, E);
#endif
        }
        SEAM(6);
    }
    if (IN(7)) { MAKE_FRAME();
        REPS(7) {
#if NAIVE_SWA
        naive_attn<false>(F, P);
#else
        p7_swa(F, P, (LAS char*)F.lds);
#endif
        }
        SEAM(7);
    }
    if (IN(8)) { MAKE_FRAME();
        REPS(8) {
        pg8::StaticOrder S; S.init(M, DM, F.G, (int)blockIdx.x);
        pg8::EpiResGate E{(const float*)(ws + WS_H1), P.out, mod + 2 * MOD + 2 * DM, MOD};
#if NAIVE_GEMM
        naive_gemm_resgate(F, (const bf16_t*)(ws + WS_OG), (const bf16_t*)(ws + WS_W4T), DM, S, E);
#else
        pg8::Gemm g{(const bf16_t*)(ws + WS_OG), (const bf16_t*)(ws + WS_W4T), M, DM, DM};
        pg8::gemm_phase<pg8::EpiResGate, pg8::StaticOrder, true, true>(F.lds, g, S, E);
#endif
        }
        SEAM(8);
    }
    if (IN(9)) { MAKE_FRAME(); p9_final(F, P); }
#undef IN
#undef SEAM
#undef cs
#undef sn
#undef mod
}

extern "C" void kernel_launch(void* const* d_in, const int* in_sizes, int n_in, void* d_out, int out_size, void* d_ws, size_t ws_size, hipStream_t stream) {
    static int grid = 0;
    if (grid == 0) {
        if (n_in != 14 || out_size != M * DM || ws_size < WS_END) { fprintf(stderr, "kernel_launch: unexpected shapes (n_in %d, out %d, ws %zu)\n", n_in, out_size, ws_size); grid = -1; return; }
        int dev = 0, cus = 0, per_cu = 0;
        if (hipGetDevice(&dev) != hipSuccess || hipDeviceGetAttribute(&cus, hipDeviceAttributeMultiprocessorCount, dev) != hipSuccess) { grid = -1; return; }
        if (hipFuncSetAttribute((const void*)fwd, hipFuncAttributeMaxDynamicSharedMemorySize, LDS_BYTES) != hipSuccess) { fprintf(stderr, "kernel_launch: hipFuncSetAttribute failed\n"); grid = -1; return; }
        if (hipOccupancyMaxActiveBlocksPerMultiprocessor(&per_cu, (const void*)fwd, NTHR, LDS_BYTES) != hipSuccess || per_cu < 1) fprintf(stderr, "kernel_launch: occupancy query reports %d workgroups per CU\n", per_cu);
        (void)hipGetLastError();
        grid = cus;
        if (grid > 256) grid = 256;
    }
    if (grid < 0) return;
    (void)hipMemsetAsync((char*)d_ws + WS_CTL, 0, CTL_ZERO_BYTES, stream);
    Params p{};
    for (int i = 0; i < 14; ++i) p.in[i] = (const float*)d_in[i];
    p.out = (float*)d_out; p.ws = (unsigned char*)d_ws;
#if MK_N_LAUNCHES == 1
    p.ph_lo = 0; p.ph_hi = NPHASE;
    hipLaunchKernelGGL(fwd, dim3(grid), dim3(NTHR), LDS_BYTES, stream, p);
#else
    for (int k = 0; k < NPHASE; ++k) { p.ph_lo = k; p.ph_hi = k + 1; hipLaunchKernelGGL(fwd, dim3(grid), dim3(NTHR), LDS_BYTES, stream, p); }
#endif
    const hipError_t le = hipPeekAtLastError();
    if (le != hipSuccess) fprintf(stderr, "kernel_launch: launch failed: %s\n", hipGetErrorName(le));
}
```

```cpp
#include <hip/hip_runtime.h>
#include <cstdio>
#include <cstdint>

#ifndef MK_N_LAUNCHES
#define MK_N_LAUNCHES 1
#endif
#define NT_OUT 1
#ifndef WSKIP_ON
#define WSKIP_ON 0
#endif
#ifndef NAIVE_GEMM
#define NAIVE_GEMM 0
#endif
#ifndef NAIVE_FOX
#define NAIVE_FOX 0
#endif
#ifndef NAIVE_SWA
#define NAIVE_SWA 0
#endif

#define GAS __attribute__((address_space(1)))
#define LAS __attribute__((address_space(3)))
typedef float f32x16 __attribute__((ext_vector_type(16)));
typedef short s16x4 __attribute__((ext_vector_type(4)));
typedef unsigned u32x2 __attribute__((ext_vector_type(2)));

constexpr int DM = 4096, BATCH = 2, SEQ = 4096, M = BATCH * SEQ;
constexpr int NH = 32, HD = 128, NKV = 4, KVW = NKV * HD;
constexpr int N1 = 4 * DM;
constexpr int N1F = N1 + NH;
constexpr int N3 = 2 * DM, NKV2 = 2 * KVW;
constexpr int MOD = 3 * DM;
constexpr float EPS = 1e-6f;
constexpr float LOG2E = 1.4426950408889634f;
constexpr float SQRT_HD = 11.313708498984761f;

typedef unsigned short bf16_t;
typedef short bf16x8 __attribute__((ext_vector_type(8)));
typedef float f32x4 __attribute__((ext_vector_type(4)));
typedef unsigned u32x4 __attribute__((ext_vector_type(4)));

namespace pg8 {
#define PG8_LAS __attribute__((address_space(3)))
typedef unsigned short bf16_t;
typedef short bf16x8 __attribute__((ext_vector_type(8)));
typedef float f32x4 __attribute__((ext_vector_type(4)));
typedef unsigned u32x4 __attribute__((ext_vector_type(4)));
constexpr int BM = 256, BK = 64, HALF = 128, HTB = HALF * BK * 2  , STAGE_BYTES = 8 * HTB, NXCD = 8, WGM = 8;

__host__ __device__ __forceinline__ int lds_byte(int r, int c) { const int st = (r >> 4) * 2 + (c >> 5), rr = r & 15, cc = c & 31, ob = rr * 64 + cc * 2; return st * 1024 + (ob ^ (((ob >> 9) & 1) << 5)); }
__host__ __device__ __forceinline__ void stage_rc(int b, int& R, int& C) { const int st = b / 1024, sb = b % 1024, swz = sb ^ (((sb >> 9) & 1) << 5); R = (st >> 1) * 16 + swz / 64; C = (st & 1) * 32 + (swz % 64) / 2; }
__host__ __device__ __forceinline__ int perm32(int rho) { const int n = rho >> 4, i = rho & 15; return 8 * (i >> 2) + 4 * n + (i & 3); }

struct Unit { int pm, pn; };
struct Gemm { const bf16_t* A; const bf16_t* Bt; int M, N, K; };

struct StaticOrder {
    int nM, nN, nwg, G, c, wgm;
    __host__ __device__ void init(int M, int N, int G_, int c_, int wgm_ = WGM) { nM = M / BM; nN = N / BM; nwg = nM * nN; G = G_; c = c_; wgm = wgm_; }
    __host__ __device__ bool next(int i, Unit& u) const {
        const long L = (long)i * G + c; if (L >= nwg) return false;
        int wgid = (int)L; { const int q = nwg / NXCD, r = nwg % NXCD, xcd = wgid % NXCD, off = wgid / NXCD; wgid = (xcd < r ? xcd * (q + 1) : r * (q + 1) + (xcd - r) * q) + off; }
        const int nig = wgm * nN, gid = wgid / nig, fm = gid * wgm, gsz = (nM - fm) < wgm ? (nM - fm) : wgm;
        u.pm = fm + ((wgid % nig) % gsz); u.pn = (wgid % nig) / gsz; return true;
    }
    __device__ __forceinline__ void a_ready(const Unit&) const {}
    __device__ __forceinline__ void done(const Unit&) const {}
};

__device__ __forceinline__ unsigned cvt_pk_bf16(float lo, float hi) { unsigned r; asm volatile("v_cvt_pk_bf16_f32 %0, %1, %2" : "=v"(r) : "v"(lo), "v"(hi)); return r; }
__device__ __forceinline__ float silu_f(float v) { return v * __builtin_amdgcn_rcpf(1.0f + __builtin_amdgcn_exp2f(-1.4426950408889634f * v)); }
__device__ __forceinline__ f32x4 silu4(f32x4 v) { return (f32x4){silu_f(v[0]), silu_f(v[1]), silu_f(v[2]), silu_f(v[3])}; }

struct Dest { bf16_t* p; int ld; int mode; };

struct EpiQKVZ {
    static constexpr bool PERM = true, AFTER_DRAIN = false;
    bf16_t* O; size_t split_stride;
    __device__ __forceinline__ Dest dest(const Unit& u) const { const int colt = u.pn * BM, t = colt >> 12; Dest d; d.p = O + (size_t)t * split_stride + (colt & 4095); d.ld = 4096; d.mode = (t == 3) ? 1 : 0; return d; }
    __device__ __forceinline__ int row_of(const Unit& u) const { return u.pm * BM; }
};
struct EpiQZKV {
    static constexpr bool PERM = true, AFTER_DRAIN = false;
    bf16_t* Q1; bf16_t* Z1; bf16_t* KV1;
    __device__ __forceinline__ Dest dest(const Unit& u) const {
        Dest d;
        if (u.pn < 32) { const int colt = u.pn * BM; if (colt < 4096) { d.p = Q1 + colt; d.mode = 2; } else { d.p = Z1 + (colt - 4096); d.mode = 1; } d.ld = 4096; }
        else { const int colt = (u.pn - 32) * BM; d.p = KV1 + colt; d.ld = 1024; d.mode = (colt < 512) ? 2 : 0; }
        return d;
    }
    __device__ __forceinline__ int row_of(const Unit& u) const { return (u.pn < 32 ? u.pm : u.pm - 32) * BM; }
};
template <class E> struct EpiStoreBf16 {
    static constexpr bool PERM = true, AFTER_DRAIN = false;
    E e; const float* cs; const float* sn; unsigned* nrm;
    __device__ __forceinline__ void operator()(const f32x4 (&acc)[2][2][4][2], const Unit& u, int wr, int wc, int fr, int fq) const {
        const Dest d = e.dest(u); const int row0 = e.row_of(u) + wr * 64 + fr; const int col0 = wc * 32 + 8 * fq;
        const int g4 = (4 * wc + fq) * 4;
        float nmax[2] = {0.f, 0.f};
#pragma unroll
        for (int ai = 0; ai < 2; ++ai)
#pragma unroll
            for (int m = 0; m < 4; ++m) { const int row = row0 + ai * HALF + m * 16; bf16_t* rowp = d.p + (size_t)row * d.ld + col0;
                f32x4 c4 = (f32x4){1.f, 1.f, 1.f, 1.f}, s4 = (f32x4){0.f, 0.f, 0.f, 0.f};
                if (d.mode == 2) { const int pos = row & 4095; c4 = *(const f32x4*)(cs + pos * 64 + g4); s4 = *(const f32x4*)(sn + pos * 64 + g4); }
#pragma unroll
                for (int bj = 0; bj < 2; ++bj) { f32x4 v0 = acc[ai][bj][m][0], v1 = acc[ai][bj][m][1];
                    if (d.mode == 1) { v0 = silu4(v0); v1 = silu4(v1); }
                    if (d.mode == 2) { const f32x4 y1 = v0 * c4 - v1 * s4, y2 = v1 * c4 + v0 * s4; v0 = y1; v1 = y2; }
                    if (nrm) { float ss = (v0[0] * v0[0] + v0[1] * v0[1]) + (v0[2] * v0[2] + v0[3] * v0[3]) + (v1[0] * v1[0] + v1[1] * v1[1]) + (v1[2] * v1[2] + v1[3] * v1[3]);
                        ss += __shfl_xor(ss, 16); ss += __shfl_xor(ss, 32); nmax[bj] = fmaxf(nmax[bj], ss); }
                    u32x4 w; w.x = cvt_pk_bf16(v0[0], v0[1]); w.y = cvt_pk_bf16(v0[2], v0[3]); w.z = cvt_pk_bf16(v1[0], v1[1]); w.w = cvt_pk_bf16(v1[2], v1[3]);
#if defined(NT_OUT)
                    __builtin_nontemporal_store(w, (u32x4*)(rowp + bj * HALF)); } }
#else
                    *(u32x4*)(rowp + bj * HALF) = w; } }
#endif
        if (nrm) { const int colt = u.pn * BM, t = colt >> 12;
            if (t < 2) {
#pragma unroll
                for (int bj = 0; bj < 2; ++bj) { float mx = nmax[bj];
#pragma unroll
                    for (int o = 1; o < 16; o <<= 1) mx = fmaxf(mx, __shfl_xor(mx, o));
                    if (fr == 0 && fq == 0) atomicMax(nrm + ((((t * 2 + ((u.pm * BM) >> 12)) * 32) + ((colt & 4095) >> 7) + bj) * 4 + wc), __float_as_uint(mx)); } } }
    }
};
struct EpiResGate {
    static constexpr bool PERM = false, AFTER_DRAIN = false;
    const float* base; float* out; const float* gate; int gate_ld;
    __device__ __forceinline__ void operator()(const f32x4 (&acc)[2][2][4][2], const Unit& u, int wr, int wc, int fr, int fq) const {
        const int row0 = u.pm * BM + wr * 64 + fr, col0 = u.pn * BM + wc * 32 + 4 * fq; const float* gp = gate + (size_t)((u.pm * BM) >> 12) * gate_ld + col0;
        f32x4 gv[2][2];
#pragma unroll
        for (int bj = 0; bj < 2; ++bj)
#pragma unroll
            for (int n = 0; n < 2; ++n) gv[bj][n] = *(const f32x4*)(gp + bj * HALF + n * 16);
#pragma unroll
        for (int ai = 0; ai < 2; ++ai)
#pragma unroll
            for (int m = 0; m < 4; ++m) { const size_t off = (size_t)(row0 + ai * HALF + m * 16) * 4096 + col0;
#pragma unroll
                for (int bj = 0; bj < 2; ++bj)
#pragma unroll
                    for (int n = 0; n < 2; ++n) { const f32x4 bs = *(const f32x4*)(base + off + bj * HALF + n * 16); *(f32x4*)(out + off + bj * HALF + n * 16) = bs + gv[bj][n] * acc[ai][bj][m][n]; } }
    }
};
struct EpiNull {
    static constexpr bool PERM = true, AFTER_DRAIN = false;
    __device__ __forceinline__ void operator()(const f32x4 (&acc)[2][2][4][2], const Unit&, int, int, int, int) const {
#pragma unroll
        for (int ai = 0; ai < 2; ++ai)
#pragma unroll
            for (int bj = 0; bj < 2; ++bj)
#pragma unroll
                for (int m = 0; m < 4; ++m) asm volatile("" :: "v"(acc[ai][bj][m][0]), "v"(acc[ai][bj][m][1]));
    }
};
struct OrderQZKV {
    StaticOrder so; int G, c;
    __device__ void init(int G_, int c_, int wgm_) { so.init(8192, 8192, G_, c_, wgm_); G = G_; c = c_; }
    __device__ bool next(int i, Unit& u) const {
        if (so.next(i, u)) return true;
        const long L = (long)i * G + c - 1024; if (L < 0 || L >= 128) return false;
        u.pm = 32 + (int)(L >> 2); u.pn = 32 + (int)(L & 3); return true;
    }
    __device__ __forceinline__ void a_ready(const Unit&) const {}
    __device__ __forceinline__ void done(const Unit&) const {}
};

template <class Epi, class Sched, bool ALIGN_EPI = false, bool SP2 = false>
__device__ __forceinline__ void gemm_phase(PG8_LAS unsigned char* lds, const Gemm g, const Sched& S, const Epi& E) {
    const int tid = threadIdx.x, wid = __builtin_amdgcn_readfirstlane(tid >> 6), lane = tid & 63, wr = wid >> 2, wc = wid & 3, fr = lane & 15, fq = lane >> 4;
    const int K = g.K, nt = K / BK;
    unsigned voffA[2], voffB[2];
#pragma unroll
    for (int i = 0; i < 2; ++i) { int R, C; stage_rc(tid * 16 + i * 8192, R, C); const int Rb = Epi::PERM ? ((R & ~31) + perm32(R & 31)) : R;
        voffA[i] = (unsigned)(R * K + C) * 2u; voffB[i] = (unsigned)(Rb * K + C) * 2u; }
    const size_t kstep = (size_t)(BK * 2);
    const size_t hstep = (size_t)HALF * K * 2;
    const size_t tstep = 2 * hstep;
    const unsigned ldsw = (unsigned)wid * 1024u;
    const int aoff = lds_byte(wr * 64 + fr, fq * 8), boff = lds_byte(wc * 32 + fr, fq * 8);
#define PG8_SA(b, h) (((b) * 2 + (h)) * HTB)
#define PG8_SB(b, h) ((4 + (b) * 2 + (h)) * HTB)
#define PG8_STAGE(bufoff, gbase, voff) do { _Pragma("unroll") for (int _i = 0; _i < 2; ++_i) \
        __builtin_amdgcn_global_load_lds((const unsigned*)((const char*)(gbase) + (voff)[_i]), (PG8_LAS unsigned*)(lds + (bufoff) + ldsw + _i * 8192), 16, 0, 0); } while (0)
#define PG8_LDA(dst, b, h) do { _Pragma("unroll") for (int m = 0; m < 4; ++m) _Pragma("unroll") for (int k = 0; k < 2; ++k) dst[m][k] = *(const PG8_LAS bf16x8*)(lds + PG8_SA(b, h) + aoff + m * 2048 + k * 1024); } while (0)
#define PG8_LDB(dst, b, h) do { _Pragma("unroll") for (int n = 0; n < 2; ++n) _Pragma("unroll") for (int k = 0; k < 2; ++k) dst[n][k] = *(const PG8_LAS bf16x8*)(lds + PG8_SB(b, h) + boff + n * 2048 + k * 1024); } while (0)
#define PG8_MMA(ai, bj, At, Bt) do { __builtin_amdgcn_s_setprio(1); _Pragma("unroll") for (int m = 0; m < 4; ++m) _Pragma("unroll") for (int n = 0; n < 2; ++n) _Pragma("unroll") for (int k = 0; k < 2; ++k) \
        acc[ai][bj][m][n] = __builtin_amdgcn_mfma_f32_16x16x32_bf16(Bt[n][k], At[m][k], acc[ai][bj][m][n], 0, 0, 0); __builtin_amdgcn_s_setprio(0); } while (0)
#define PG8_WAIT_V(n) asm volatile("s_waitcnt vmcnt(" #n ")" ::: "memory")
#define PG8_WAIT_L(n) asm volatile("s_waitcnt lgkmcnt(" #n ")" ::: "memory")
#define PG8_BAR __builtin_amdgcn_s_barrier()
#define PG8_SCHED __builtin_amdgcn_sched_barrier(0)
    Unit cur, nxt; int ui = 0;
    if (!S.next(0, cur)) return;
    f32x4 acc[2][2][4][2];
#pragma unroll
    for (int a = 0; a < 2; ++a)
#pragma unroll
        for (int b = 0; b < 2; ++b)
#pragma unroll
            for (int m = 0; m < 4; ++m)
#pragma unroll
                for (int n = 0; n < 2; ++n) acc[a][b][m][n] = (f32x4){0.f, 0.f, 0.f, 0.f};
    bf16x8 At[4][2], B0[2][2], B1[2][2];
    const char* cA = (const char*)g.A + (size_t)cur.pm * tstep; const char* cB = (const char*)g.Bt + (size_t)cur.pn * tstep;
    S.a_ready(cur);
    if constexpr (SP2) {
        PG8_STAGE(PG8_SB(0, 0), cB, voffB); PG8_STAGE(PG8_SB(0, 1), cB + hstep, voffB); PG8_STAGE(PG8_SA(0, 0), cA, voffA); PG8_STAGE(PG8_SA(0, 1), cA + hstep, voffA);
        if (wr == 1) PG8_BAR;
        PG8_WAIT_V(2); PG8_BAR;
        PG8_STAGE(PG8_SB(1, 0), cB + kstep, voffB); PG8_STAGE(PG8_SA(1, 0), cA + kstep, voffA); PG8_STAGE(PG8_SB(1, 1), cB + hstep + kstep, voffB);
        PG8_WAIT_V(6); PG8_BAR;
    } else {
        PG8_STAGE(PG8_SB(0, 0), cB, voffB); PG8_STAGE(PG8_SA(0, 0), cA, voffA); PG8_STAGE(PG8_SB(0, 1), cB + hstep, voffB); PG8_STAGE(PG8_SA(0, 1), cA + hstep, voffA);
        if (wr == 1) PG8_BAR;
        PG8_WAIT_V(4); PG8_BAR;
        PG8_STAGE(PG8_SB(1, 0), cB + kstep, voffB); PG8_STAGE(PG8_SA(1, 0), cA + kstep, voffA); PG8_STAGE(PG8_SB(1, 1), cB + hstep + kstep, voffB);
        PG8_WAIT_V(6); PG8_BAR;
    }
    for (;;) {
        const bool has_next = S.next(ui + 1, nxt);
        const char* nA = has_next ? (const char*)g.A + (size_t)nxt.pm * tstep : cA; const char* nB = has_next ? (const char*)g.Bt + (size_t)nxt.pn * tstep : cB;
        for (int t = 0; t < nt; t += 2) {
            const bool last = (t == nt - 2);
            const char* a1 = cA + (size_t)(t + 1) * kstep;
            const char* a2 = last ? nA : cA + (size_t)(t + 2) * kstep; const char* b2 = last ? nB : cB + (size_t)(t + 2) * kstep;
            const char* a3 = a2 + kstep; const char* b3 = b2 + kstep;
            if (last && has_next) S.a_ready(nxt);
            if constexpr (SP2) {
            PG8_LDB(B0, 0, 0); PG8_LDB(B1, 0, 1); PG8_SCHED; PG8_LDA(At, 0, 0); PG8_STAGE(PG8_SA(1, 1), a1 + hstep, voffA);
            PG8_WAIT_V(8); PG8_WAIT_L(0); PG8_BAR; PG8_MMA(0, 0, At, B0); PG8_MMA(0, 1, At, B1); PG8_BAR; PG8_SCHED;
            PG8_LDA(At, 0, 1); PG8_STAGE(PG8_SB(0, 0), b2, voffB); PG8_STAGE(PG8_SB(0, 1), b2 + hstep, voffB); PG8_STAGE(PG8_SA(0, 0), a2, voffA);
            PG8_WAIT_V(8); PG8_WAIT_L(0); PG8_BAR; PG8_MMA(1, 0, At, B0); PG8_MMA(1, 1, At, B1); PG8_BAR; PG8_SCHED;
            PG8_LDB(B0, 1, 0); PG8_LDB(B1, 1, 1); PG8_SCHED; PG8_LDA(At, 1, 0); PG8_STAGE(PG8_SA(0, 1), a2 + hstep, voffA);
            PG8_WAIT_V(8); PG8_WAIT_L(0); PG8_BAR; PG8_MMA(0, 0, At, B0); PG8_MMA(0, 1, At, B1); PG8_BAR; PG8_SCHED;
            PG8_LDA(At, 1, 1); PG8_STAGE(PG8_SB(1, 0), b3, voffB); PG8_STAGE(PG8_SB(1, 1), b3 + hstep, voffB); PG8_STAGE(PG8_SA(1, 0), a3, voffA);
            PG8_WAIT_V(8); PG8_WAIT_L(0); PG8_BAR; PG8_MMA(1, 0, At, B0); PG8_MMA(1, 1, At, B1); PG8_BAR; PG8_SCHED;
            } else {
            PG8_LDB(B0, 0, 0); PG8_SCHED; PG8_LDA(At, 0, 0); PG8_STAGE(PG8_SA(1, 1), a1 + hstep, voffA);
            PG8_WAIT_L(8); PG8_BAR; PG8_WAIT_L(0); PG8_MMA(0, 0, At, B0); PG8_BAR; PG8_SCHED;
            PG8_LDB(B1, 0, 1); PG8_STAGE(PG8_SB(0, 0), b2, voffB);
            PG8_BAR; PG8_WAIT_L(0); PG8_MMA(0, 1, At, B1); PG8_BAR;
            PG8_LDA(At, 0, 1); PG8_STAGE(PG8_SA(0, 0), a2, voffA);
            PG8_BAR; PG8_WAIT_L(0); PG8_MMA(1, 0, At, B0); PG8_BAR; PG8_SCHED;
            PG8_STAGE(PG8_SB(0, 1), b2 + hstep, voffB);
            PG8_WAIT_V(6); PG8_BAR; PG8_MMA(1, 1, At, B1); PG8_BAR;
            PG8_LDB(B0, 1, 0); PG8_SCHED; PG8_LDA(At, 1, 0); PG8_STAGE(PG8_SA(0, 1), a2 + hstep, voffA);
            PG8_WAIT_L(8); PG8_BAR; PG8_WAIT_L(0); PG8_MMA(0, 0, At, B0); PG8_BAR; PG8_SCHED;
            PG8_LDB(B1, 1, 1); PG8_STAGE(PG8_SB(1, 0), b3, voffB);
            PG8_BAR; PG8_WAIT_L(0); PG8_MMA(0, 1, At, B1); PG8_BAR;
            PG8_LDA(At, 1, 1); PG8_STAGE(PG8_SA(1, 0), a3, voffA);
            PG8_BAR; PG8_WAIT_L(0); PG8_MMA(1, 0, At, B0); PG8_BAR; PG8_SCHED;
            PG8_STAGE(PG8_SB(1, 1), b3 + hstep, voffB);
            PG8_WAIT_V(6); PG8_BAR; PG8_MMA(1, 1, At, B1); PG8_BAR;
            }
        }
        if constexpr (ALIGN_EPI) { if (wr == 0) PG8_BAR; }
#if defined(EPI_TWICE)
        if constexpr (!Epi::AFTER_DRAIN) { _Pragma("unroll 1") for (int rep_ = 0; rep_ < 2; ++rep_) { E(acc, cur, wr, wc, fr, fq); asm volatile("" ::: "memory"); } S.done(cur); }
#else
        if constexpr (!Epi::AFTER_DRAIN) { E(acc, cur, wr, wc, fr, fq); S.done(cur); }
#endif
        if (!has_next) break;
#pragma unroll
        for (int a = 0; a < 2; ++a)
#pragma unroll
            for (int b = 0; b < 2; ++b)
#pragma unroll
                for (int m = 0; m < 4; ++m)
#pragma unroll
                    for (int n = 0; n < 2; ++n) acc[a][b][m][n] = (f32x4){0.f, 0.f, 0.f, 0.f};
        cur = nxt; cA = nA; cB = nB; ++ui;
        if constexpr (ALIGN_EPI) { if (wr == 1) PG8_BAR; }
    }
    PG8_WAIT_V(0);
    if constexpr (!ALIGN_EPI) { if (wr == 0) PG8_BAR; }
    PG8_BAR;
    if constexpr (Epi::AFTER_DRAIN) { E.fused(acc, cur, wr, wc, fr, fq, lds, wid, lane); S.done(cur); }
#undef PG8_SA
#undef PG8_SB
#undef PG8_STAGE
#undef PG8_LDA
#undef PG8_LDB
#undef PG8_MMA
#undef PG8_WAIT_V
#undef PG8_WAIT_L
#undef PG8_BAR
#undef PG8_SCHED
}
}

namespace att {
typedef unsigned short bf16;
typedef short bf16x8 __attribute__((ext_vector_type(8)));
constexpr int D = 128, NW = 8, QBLK = 32, KVBLK = 64, QB = NW * QBLK;
constexpr int SHM_V = KVBLK * D * 2, SHM_K = KVBLK * D * 2;
constexpr int LDS_WS = 2 * SHM_V + 2 * SHM_K;
constexpr int LDS_F = LDS_WS + NW * 64 * 4;
constexpr int LDS_OST = LDS_F + 4096 * 4;
constexpr int LDS_BYTES = LDS_OST + NW * 32 * 64 * 4;
constexpr float SCALE = 0.08838834764831845f;
constexpr float THR = 8.f;

#define KSWZ(row, colB) ((row) * 256 + ((colB) ^ (((row) & 7) << 4)))
#define SBAR() __builtin_amdgcn_sched_barrier(0)
__device__ __forceinline__ int v_st(int k, int c) { const int kk = (k & ~0xC) | ((k & 4) << 1) | ((k & 8) >> 1); return ((kk >> 3) * 4 + (c >> 5)) * 512 + ((kk & 7) * 32 + (c & 31)) * 2; }
__device__ __forceinline__ int v_rd_base(int lane) { return ((lane & 3) << 3) | (((lane >> 2) & 3) << 6) | (((lane >> 4) & 1) << 5) | (((lane >> 5) & 1) << 8); }
constexpr int v_rd_off(int d0, int ks, int half) { return d0 * 512 + ks * 4096 + half * 2048; }
__device__ __forceinline__ int crow(int r, int hi) { return (r & 3) + 8 * (r >> 2) + 4 * hi; }
__device__ __forceinline__ unsigned cvtpk(float lo, float hi) { unsigned r; asm volatile("v_cvt_pk_bf16_f32 %0, %1, %2" : "=v"(r) : "v"(lo), "v"(hi)); return r; }
__device__ __forceinline__ bf16x8 load8(const bf16* p) { return *reinterpret_cast<const bf16x8*>(p); }
__device__ __forceinline__ void mask_tile(f32x16& p0, f32x16& p1, int dq, unsigned W) {
    const float NEG = -__builtin_inff();
#pragma unroll
    for (int r = 0; r < 16; ++r) {
        const int c = (r & 3) + 8 * (r >> 2);
        if ((unsigned)(dq - c) >= W) p0[r] = NEG;
        if ((unsigned)(dq - c - 32) >= W) p1[r] = NEG;
    }
}
__device__ __forceinline__ void partialSM(f32x16& p0, f32x16& p1, float& m_reg, float& mn, float& alpha) {
    float pmax = p0[0]; for (int r = 1; r < 16; ++r) pmax = fmaxf(pmax, p0[r]); for (int r = 0; r < 16; ++r) pmax = fmaxf(pmax, p1[r]);
    { auto rr = __builtin_amdgcn_permlane32_swap(__float_as_uint(pmax), __float_as_uint(pmax), false, false);
      pmax = fmaxf(__uint_as_float(rr[0]), __uint_as_float(rr[1])); }
    constexpr float C2 = 1.4426950408889634f * SCALE;
    if (__builtin_expect(__all((pmax - m_reg) * SCALE <= THR), 1)) { mn = m_reg; alpha = 1.f; }
    else { mn = fmaxf(m_reg, pmax); alpha = __builtin_amdgcn_exp2f((m_reg - mn) * C2); m_reg = mn; }
    const float mnL = -mn * C2;
    for (int r = 0; r < 16; ++r) p0[r] = fmaf(p0[r], C2, mnL); for (int r = 0; r < 16; ++r) p1[r] = fmaf(p1[r], C2, mnL);
    for (int r = 0; r < 16; ++r) p0[r] = __builtin_amdgcn_exp2f(p0[r]);
}
__device__ __forceinline__ void finishSM(f32x16& p0, f32x16& p1, float alpha, float& l_reg, bf16x8& pa0, bf16x8& pa1, bf16x8& pa2, bf16x8& pa3) {
    for (int r = 0; r < 16; ++r) p1[r] = __builtin_amdgcn_exp2f(p1[r]);
    float ps = 0; for (int r = 0; r < 16; ++r) ps += p0[r]; for (int r = 0; r < 16; ++r) ps += p1[r];
    { auto rr = __builtin_amdgcn_permlane32_swap(__float_as_uint(ps), __float_as_uint(ps), false, false);
      ps = __uint_as_float(rr[0]) + __uint_as_float(rr[1]); }
    l_reg = l_reg * alpha + ps;
#define PK4(P, B_, OUT) do { unsigned a0 = cvtpk(P[B_+0], P[B_+1]), a1 = cvtpk(P[B_+2], P[B_+3]);                          \
        unsigned b0 = cvtpk(P[B_+4], P[B_+5]), b1 = cvtpk(P[B_+6], P[B_+7]);                                             \
        auto r0 = __builtin_amdgcn_permlane32_swap(a0, b0, false, false); auto r1 = __builtin_amdgcn_permlane32_swap(a1, b1, false, false); \
        u32x4 w = {r0[0], r1[0], r0[1], r1[1]}; OUT = *reinterpret_cast<bf16x8*>(&w); } while (0)
    PK4(p0, 0, pa0); PK4(p0, 8, pa1); PK4(p1, 0, pa2); PK4(p1, 8, pa3);
#undef PK4
}
template <int KB, bool SK, bool FOX>
__device__ __forceinline__ void qkt(f32x16& p0, f32x16& p1, const LAS char* K_lds, int r32, int hi, const bf16x8* qr, bool act, const LAS float* fs  ) {
    if (SK && !act) { const float NEG = -__builtin_inff();
#pragma unroll
        for (int r = 0; r < 16; ++r) { p0[r] = NEG; p1[r] = NEG; } return; }
    if constexpr (FOX) {
#pragma unroll
        for (int g = 0; g < 4; ++g) { const f32x4 a = *(const LAS f32x4*)(fs + 8 * g), b = *(const LAS f32x4*)(fs + 32 + 8 * g);
            p0[4 * g] = a[0]; p0[4 * g + 1] = a[1]; p0[4 * g + 2] = a[2]; p0[4 * g + 3] = a[3];
            p1[4 * g] = b[0]; p1[4 * g + 1] = b[1]; p1[4 * g + 2] = b[2]; p1[4 * g + 3] = b[3]; }
    } else { p0 = f32x16{}; p1 = f32x16{}; }
    const LAS char* kb[4];
#pragma unroll
    for (int dd = 0; dd < 4; ++dd) kb[dd] = K_lds + KB * SHM_K + KSWZ(r32, (dd * 16 + hi * 8) * 2);
#pragma unroll
    for (int d0 = 0; d0 < 8; ++d0) { const LAS char* a = kb[d0 & 3] + (d0 >> 2) * 128;
        bf16x8 b0 = *(const LAS bf16x8*)(a);
        bf16x8 b1 = *(const LAS bf16x8*)(a + 32 * 256);
        p0 = __builtin_amdgcn_mfma_f32_32x32x16_bf16(b0, qr[d0], p0, 0, 0, 0);
        p1 = __builtin_amdgcn_mfma_f32_32x32x16_bf16(b1, qr[d0], p1, 0, 0, 0); }
}
template <int VB, bool SK>
__device__ __forceinline__ void pv_tile(f32x16* o, int vb0, bf16x8 pa0, bf16x8 pa1, bf16x8 pa2, bf16x8 pa3, bool act) {
    if (SK && !act) return;
#define TRRD(dst, off) asm volatile("ds_read_b64_tr_b16 %0, %1 offset:%2" : "=&v"(dst) : "v"(vb0), "i"(off) : "memory")
#define PV_D0(d0) do { s16x4 l0, l1, l2, l3, h0, h1, h2, h3; constexpr int b_ = VB * SHM_V + v_rd_off(d0, 0, 0);   \
        TRRD(l0, b_); TRRD(h0, b_ + 2048); TRRD(l1, b_ + 4096); TRRD(h1, b_ + 6144); TRRD(l2, b_ + 8192); TRRD(h2, b_ + 10240); TRRD(l3, b_ + 12288); TRRD(h3, b_ + 14336); \
        asm volatile("s_waitcnt lgkmcnt(0)" ::: "memory"); SBAR();   \
        o[d0] = __builtin_amdgcn_mfma_f32_32x32x16_bf16(pa0, (bf16x8){l0[0], l0[1], l0[2], l0[3], h0[0], h0[1], h0[2], h0[3]}, o[d0], 0, 0, 0);   \
        o[d0] = __builtin_amdgcn_mfma_f32_32x32x16_bf16(pa1, (bf16x8){l1[0], l1[1], l1[2], l1[3], h1[0], h1[1], h1[2], h1[3]}, o[d0], 0, 0, 0);   \
        o[d0] = __builtin_amdgcn_mfma_f32_32x32x16_bf16(pa2, (bf16x8){l2[0], l2[1], l2[2], l2[3], h2[0], h2[1], h2[2], h2[3]}, o[d0], 0, 0, 0);   \
        o[d0] = __builtin_amdgcn_mfma_f32_32x32x16_bf16(pa3, (bf16x8){l3[0], l3[1], l3[2], l3[3], h3[0], h3[1], h3[2], h3[3]}, o[d0], 0, 0, 0); } while (0)
    PV_D0(0); PV_D0(1); PV_D0(2); PV_D0(3);
#undef PV_D0
#undef TRRD
}

template <size_t OQ, size_t OK, size_t OV, size_t OZ, size_t OO> struct Bases { const unsigned char* ws;
    __device__ __forceinline__ const bf16* Q() const { return (const bf16*)(ws + OQ); } __device__ __forceinline__ const bf16* K() const { return (const bf16*)(ws + OK); }
    __device__ __forceinline__ const bf16* V() const { return (const bf16*)(ws + OV); } __device__ __forceinline__ const bf16* Z() const { return (const bf16*)(ws + OZ); }
    __device__ __forceinline__ bf16* O() const { return (bf16*)(ws + OO); } };
struct BlockRef { unsigned qoff; unsigned kvoff; int P0; int jlo; float sink_l2; float qk; };
struct Seam { bf16x8 qr[8]; bf16x8 st_v0, st_v1, st_k0, st_k1; };
__device__ __forceinline__ int swa_jlo(int P0, int W) { const int lowk = P0 - W + 1; return lowk > 0 ? lowk / KVBLK : 0; }
#define UROW(p, k0) ((const char*)(p) + (size_t)((k0) + wid * 4) * (LDKV * 2))
#define VMW() asm volatile("s_waitcnt vmcnt(0)" ::: "memory")
#define VMWN(n) asm volatile("s_waitcnt vmcnt(%0)" :: "i"(n) : "memory")
#define SLOAD_H(Kp, Vp, k0) do { const char* vu_ = UROW(Vp, k0); const char* ku_ = UROW(Kp, k0);                                   \
                         S.st_v0 = *(const bf16x8*)(vu_ + kvlane); S.st_v1 = *(const bf16x8*)(vu_ + 32 * LDKV * 2 + kvlane);              \
                         S.st_k0 = *(const bf16x8*)(ku_ + kvlane); S.st_k1 = *(const bf16x8*)(ku_ + 32 * LDKV * 2 + kvlane); } while (0)
#define SWRITE_HK(bf) do { *(LAS bf16x8*)(K_lds + (bf) * SHM_K + kws) = S.st_k0; *(LAS bf16x8*)(K_lds + (bf) * SHM_K + kws + 32 * 256) = S.st_k1; } while (0)
#define SWRITE_HV(bf) do { *(LAS bf16x8*)(V_lds + (bf) * SHM_V + vst0) = S.st_v0; *(LAS bf16x8*)(V_lds + (bf) * SHM_V + vst1) = S.st_v1; } while (0)
#define SWRITE_H(bf) do { SWRITE_HV(bf); SWRITE_HK(bf); } while (0)
template <bool FOX, int LDQ, int LDKV, class BasesT>
__device__ __forceinline__ void attn_prime(const BasesT& T, const BlockRef& cur, int W, LAS char* lds, Seam& S) {
    const int tid = threadIdx.x, wid = __builtin_amdgcn_readfirstlane(tid >> 6), lane = tid & 63, r32 = lane & 31, hi = lane >> 5;
    const int sr = tid >> 4, sc = (tid & 15) * 8, kws = KSWZ(sr, sc * 2); LAS char* K_lds = lds + 2 * SHM_V;
    const unsigned kvlane = (unsigned)((lane >> 4) * LDKV + sc) * 2u, qlane = (unsigned)(r32 * LDQ + hi * 8) * 2u;
    const int kb0 = FOX ? ((cur.P0 + QB - 1) / KVBLK) * KVBLK : swa_jlo(cur.P0, W) * KVBLK;
    { const char* qu = (const char*)(T.Q() + cur.qoff) + (size_t)wid * (QBLK * LDQ * 2);
      for (int d0 = 0; d0 < 8; ++d0) S.qr[d0] = *(const bf16x8*)(qu + d0 * 32 + qlane); }
    SLOAD_H(T.K() + cur.kvoff, T.V() + cur.kvoff, kb0); VMW(); SWRITE_HK(0);
    __syncthreads();
}
template <bool FOX, int LDQ, int LDKV, int LDO, class BasesT>
__device__ __forceinline__ void attn_block(const BasesT& T, const BlockRef& cur, const BlockRef& nxt, int skv, int W, LAS char* lds, Seam& S) {
    constexpr bool SK = WSKIP_ON && !FOX;
    const int tid = threadIdx.x, wid = __builtin_amdgcn_readfirstlane(tid >> 6), lane = tid & 63, r32 = lane & 31, hi = lane >> 5;
    const int j_lo = FOX ? cur.jlo : swa_jlo(cur.P0, W);
    int j_hi = (cur.P0 + QB - 1) / KVBLK + 1; if (j_hi > skv / KVBLK) j_hi = skv / KVBLK;
    int NT = j_hi - j_lo;
    const int kbn = FOX ? ((nxt.P0 + QB - 1) / KVBLK) * KVBLK : swa_jlo(nxt.P0, W) * KVBLK;
    const int qlo = cur.P0 + wid * QBLK, qm = qlo + r32 - 4 * hi;
    LAS char* V_lds = lds; LAS char* K_lds = lds + 2 * SHM_V;
    LAS float* ws = (LAS float*)(lds + LDS_WS) + wid * 64; LAS float* li_l = ws; LAS float* al_l = ws + 32;
    const LAS float* Fs = (const LAS float*)(lds + LDS_F) + 4 * hi;
    float m_reg = -1e30f, l_reg = 0; f32x16 o[4] = {};
    const int sr = tid >> 4, sc = (tid & 15) * 8, vst0 = v_st(sr, sc), vst1 = v_st(32 + sr, sc), kws = KSWZ(sr, sc * 2);
    const unsigned kvlane = (unsigned)((lane >> 4) * LDKV + sc) * 2u, qlane = (unsigned)(r32 * LDQ + hi * 8) * 2u;
    const int vb0 = (int)(uintptr_t)V_lds + v_rd_base(lane);
    const unsigned kvo = cur.kvoff;
#define Kh (T.K() + kvo)
#define Vh (T.V() + kvo)
#define RESC(a) do { if (__any((a) < 1.f)) { if (hi == 0) al_l[r32] = (a); asm volatile("s_waitcnt lgkmcnt(0)" ::: "memory");              \
                     for (int d_ = 0; d_ < 4; ++d_) for (int r = 0; r < 16; ++r) o[d_][r] *= al_l[crow(r, hi)]; } } while (0)
#define KBASE(t) ((FOX ? (j_hi - 1 - (t)) : (j_lo + (t))) * KVBLK)
#define ACT(t) (KBASE(t) <= qlo + QBLK - 1 && KBASE(t) + KVBLK - 1 >= qlo - W + 1)
#define MASKT(P0_, P1_, t) do { const int kb_ = KBASE(t); if ((!SK || ACT(t)) && (kb_ + KVBLK - 1 > qlo || kb_ <= qlo + QBLK - 1 - W)) mask_tile(P0_, P1_, qm - kb_, (unsigned)W); } while (0)
    constexpr int NQL = 8;
#define SEAM_K0() do { VMWN(NQL); SWRITE_HK(0); SBAR(); } while (0)
    f32x16 pA0, pA1, pB0, pB1; float mnA, mnB, alA, alB; bf16x8 pa0, pa1, pa2, pa3;
    SWRITE_HV(0); SBAR();
    if (NT > 1) { SLOAD_H(Kh, Vh, KBASE(1)); }
    SBAR(); qkt<0, SK, FOX>(pA0, pA1, K_lds, r32, hi, S.qr, ACT(0), Fs + KBASE(0));
    MASKT(pA0, pA1, 0); partialSM(pA0, pA1, m_reg, mnA, alA);
    if (NT > 1) { VMW(); SWRITE_H(1); }
    __syncthreads();
#define HALF_STEP(PX0, PX1, mnX, alX, PY0, PY1, alY, t, KB, VB, SB) do {                                                      \
        SBAR(); qkt<KB, SK, FOX>(PX0, PX1, K_lds, r32, hi, S.qr, ACT(t), Fs + KBASE(t));                                     \
        finishSM(PY0, PY1, alY, l_reg, pa0, pa1, pa2, pa3); SBAR();                                                           \
        if ((t) + 1 < NT) { SLOAD_H(Kh, Vh, KBASE((t) + 1)); SBAR(); }                                                        \
        pv_tile<VB, SK>(o, vb0, pa0, pa1, pa2, pa3, ACT((t) - 1)); MASKT(PX0, PX1, (t)); partialSM(PX0, PX1, m_reg, mnX, alX);  \
        __syncthreads();                                                                                                      \
        if ((t) + 1 < NT) { VMW(); SWRITE_H(SB); }                                                                            \
        RESC(alX); __syncthreads(); } while (0)
    for (int t = 1; t + 1 < NT; t += 2) {
        HALF_STEP(pB0, pB1, mnB, alB, pA0, pA1, alA, t, 1, 0, 0);
        HALF_STEP(pA0, pA1, mnA, alA, pB0, pB1, alB, t + 1, 0, 1, 1);
        if constexpr (FOX) { if (t == 3 && NT > 6) {
            float mw = m_reg;
#pragma unroll
            for (int o_ = 1; o_ < 32; o_ <<= 1) mw = fminf(mw, __shfl_xor(mw, o_));
            if (lane == 0) li_l[0] = mw;
            asm volatile("s_waitcnt lgkmcnt(0)" ::: "memory"); __syncthreads();
            const LAS float* slot = (const LAS float*)(lds + LDS_WS); float mb = slot[0];
#pragma unroll
            for (int w_ = 1; w_ < NW; ++w_) mb = fminf(mb, slot[w_ * 64]);
            const LAS float* Fb = (const LAS float*)(lds + LDS_F);
            const unsigned long long alive = __ballot(Fb[64 * lane + 63] + cur.qk > mb - (40.0f / (1.4426950408889634f * SCALE) + 16.0f));
            int jd = alive ? (int)__builtin_ctzll(alive) : 63; if (jd < j_lo) jd = j_lo;
            int nt2 = j_hi - jd; if (nt2 < 6) nt2 = 6;
            if (nt2 < NT) NT = nt2;
        } }
    }
    const bool even = (NT & 1) == 0;
    if (even) { SBAR(); qkt<1, SK, FOX>(pB0, pB1, K_lds, r32, hi, S.qr, ACT(NT - 1), Fs + KBASE(NT - 1)); SBAR(); }
    SLOAD_H(T.K() + nxt.kvoff, T.V() + nxt.kvoff, kbn); SBAR();
    { const char* qu = (const char*)(T.Q() + nxt.qoff) + (size_t)wid * (QBLK * LDQ * 2);
#pragma unroll
      for (int d0 = 0; d0 < 8; ++d0) S.qr[d0] = *(const bf16x8*)(qu + d0 * 32 + qlane); }
    SBAR();
    finishSM(pA0, pA1, alA, l_reg, pa0, pa1, pa2, pa3); SBAR();
    pv_tile<0, SK>(o, vb0, pa0, pa1, pa2, pa3, ACT(even ? NT - 2 : NT - 1));
    if (even) { MASKT(pB0, pB1, NT - 1); partialSM(pB0, pB1, m_reg, mnB, alB); __syncthreads(); RESC(alB);
        finishSM(pB0, pB1, alB, l_reg, pa0, pa1, pa2, pa3); SBAR(); pv_tile<1, SK>(o, vb0, pa0, pa1, pa2, pa3, ACT(NT - 1)); }
    SBAR(); SEAM_K0();
    const int c8 = lane & 7, rr = lane >> 3;
    u32x4 zq[2][4];
    { const char* Zu = (const char*)(T.Z() + cur.qoff) + (size_t)wid * (QBLK * LDO * 2) + (unsigned)(rr * LDO + c8 * 8) * 2u;
#pragma unroll
      for (int h2 = 0; h2 < 2; ++h2)
#pragma unroll
          for (int j = 0; j < 4; ++j) zq[h2][j] = *(const u32x4*)(Zu + j * (8 * LDO * 2) + h2 * 128); }
    if constexpr (!FOX) l_reg += __builtin_amdgcn_exp2f(cur.sink_l2 - m_reg * (1.4426950408889634f * SCALE));
    if (hi == 0) li_l[r32] = l_reg; asm volatile("s_waitcnt lgkmcnt(0)" ::: "memory");
    float rli[16];
#pragma unroll
    for (int r = 0; r < 16; ++r) rli[r] = __builtin_amdgcn_rcpf(li_l[crow(r, hi)]);
    LAS float* ost = (LAS float*)(lds + LDS_OST) + wid * (32 * 64);
    char* Ou = (char*)(T.O() + cur.qoff) + (size_t)wid * (QBLK * LDO * 2) + (unsigned)(rr * LDO + c8 * 8) * 2u;
#pragma unroll
    for (int h2 = 0; h2 < 2; ++h2) {
#pragma unroll
        for (int r = 0; r < 16; ++r) { const int row = crow(r, hi); ost[row * 64 + r32] = o[2 * h2][r] * rli[r]; ost[row * 64 + 32 + r32] = o[2 * h2 + 1][r] * rli[r]; }
        asm volatile("s_waitcnt lgkmcnt(0)" ::: "memory");
#pragma unroll
        for (int j = 0; j < 4; ++j) { const LAS float* sp = ost + (rr + 8 * j) * 64 + c8 * 8; const f32x4 a = *(const LAS f32x4*)sp, bq = *(const LAS f32x4*)(sp + 4); const u32x4 z = zq[h2][j];
            u32x4 w; w.x = cvtpk(a[0] * __uint_as_float(z.x << 16), a[1] * __uint_as_float(z.x & 0xffff0000u)); w.y = cvtpk(a[2] * __uint_as_float(z.y << 16), a[3] * __uint_as_float(z.y & 0xffff0000u));
            w.z = cvtpk(bq[0] * __uint_as_float(z.z << 16), bq[1] * __uint_as_float(z.z & 0xffff0000u)); w.w = cvtpk(bq[2] * __uint_as_float(z.w << 16), bq[3] * __uint_as_float(z.w & 0xffff0000u));
            *(u32x4*)(Ou + j * (8 * LDO * 2) + h2 * 128) = w; }
        asm volatile("s_waitcnt lgkmcnt(0)" ::: "memory");
    }
    __syncthreads();
#undef Kh
#undef Vh
#undef RESC
#undef KBASE
#undef ACT
#undef MASKT
#undef SEAM_K0
#undef HALF_STEP
}
#undef UROW
#undef VMW
#undef VMWN
#undef SLOAD_H
#undef SWRITE_HK
#undef SWRITE_HV
#undef SWRITE_H
#undef SBAR
#undef KSWZ
}

#define XB_TMO      128
#define XB_XCNT(j)  (256  + 64 * (j))
#define XB_XSUB(j)  (1280 + 64 * (j))
#define XB_XGEN(j)  (2304 + 64 * (j))
#define XB_TOP      3328
#define XB_TOPGEN   3392
#define XCD_BAR_WORDS 3456
#define XB_SPIN_CAP (1u << 18)

__device__ __forceinline__ unsigned xb_ld(unsigned* p)              { return __hip_atomic_load(p, __ATOMIC_RELAXED, __HIP_MEMORY_SCOPE_AGENT); }
__device__ __forceinline__ unsigned xb_add(unsigned* p, unsigned v) { return __hip_atomic_fetch_add(p, v, __ATOMIC_RELAXED, __HIP_MEMORY_SCOPE_AGENT); }
__device__ __forceinline__ unsigned xb_xcc_id() { return (unsigned)__builtin_amdgcn_s_getreg((3 << 11) | 20) & 0xFu; }
#define XB_SPIN(cond, bar) do { unsigned _sp = 0; while (cond) { __builtin_amdgcn_s_sleep(1); \
    if ((++_sp & 255u) == 0u) { if (xb_ld(&(bar)[XB_TMO])) break; if (_sp > XB_SPIN_CAP) { atomicAdd(&(bar)[XB_TMO], 1u); break; } } } } while (0)

struct XcdBarrier {
    unsigned* bar; unsigned x;
    volatile LAS unsigned* st;
};

__device__ __forceinline__ XcdBarrier xcd_barrier_post(unsigned* bar, volatile LAS unsigned* st) {
    XcdBarrier b; b.bar = bar; b.x = xb_xcc_id(); b.st = st;
    if (threadIdx.x == 0) (void)xb_add(&bar[XB_XCNT(b.x)], 1u);
    return b;
}
__device__ __forceinline__ void xcd_barrier_complete(unsigned* bar, unsigned x, unsigned& nloc, unsigned& nx) {
    const unsigned G = gridDim.x * gridDim.y * gridDim.z;
    unsigned sum, cnt, mine, sp = 0u;
    for (;;) {
        sum = 0u; cnt = 0u; mine = 0u;
#pragma unroll
        for (unsigned j = 0; j < 16; ++j) { const unsigned c = xb_ld(&bar[XB_XCNT(j)]); sum += c; cnt += (c > 0u) ? 1u : 0u; mine = (j == x) ? c : mine; }
        if (sum == G) break;
        __builtin_amdgcn_s_sleep(1);
        if ((++sp & 255u) == 0u) { if (xb_ld(&bar[XB_TMO])) break; if (sp > XB_SPIN_CAP) { atomicAdd(&bar[XB_TMO], 1u); break; } }
    }
    nloc = mine > 0u ? mine : 1u; nx = cnt > 0u ? cnt : 1u;
}

__device__ __forceinline__ void xcd_barrier(const XcdBarrier& b) {
    asm volatile("s_waitcnt vmcnt(0)" ::: "memory");
    __syncthreads();
    if (threadIdx.x == 0) {
        unsigned* bar = b.bar;
        __builtin_amdgcn_s_waitcnt(0);
        unsigned nloc = b.st[0], nx = b.st[1];
        if (nloc == 0u) { xcd_barrier_complete(bar, b.x, nloc, nx); b.st[0] = nloc; b.st[1] = nx; }
        const unsigned old = xb_add(&bar[XB_XSUB(b.x)], 1u);
        const unsigned gen = old / nloc;
        if (old + 1u == (gen + 1u) * nloc) {
            __builtin_amdgcn_fence(__ATOMIC_RELEASE, "agent");
            asm volatile("s_waitcnt vmcnt(0)" ::: "memory");
            const unsigned og = xb_add(&bar[XB_TOP], 1u);
            const unsigned tg = og / nx;
            if (og + 1u == (tg + 1u) * nx) xb_add(&bar[XB_TOPGEN], 1u);
            else XB_SPIN(xb_ld(&bar[XB_TOPGEN]) == tg, bar);
            __builtin_amdgcn_fence(__ATOMIC_ACQUIRE, "agent");
            xb_add(&bar[XB_XGEN(b.x)], 1u);
            asm volatile("s_waitcnt vmcnt(0)" ::: "memory");
        } else {
            XB_SPIN(xb_ld(&bar[XB_XGEN(b.x)]) == gen, bar);
            __builtin_amdgcn_fence(__ATOMIC_ACQUIRE, "agent");
            asm volatile("s_waitcnt vmcnt(0)" ::: "memory");
        }
    }
    __syncthreads();
}


constexpr size_t MiB = 1u << 20;
constexpr size_t WS_CTL = 0, CTL_ZERO_BYTES = 1 * MiB;
constexpr size_t WS_SLAB = 1 * MiB;
constexpr size_t WS_MOD = 3 * MiB;
constexpr size_t WS_ROPE = 4 * MiB;
constexpr size_t WS_LOGF = 6 * MiB;
constexpr size_t WS_WFT = 7 * MiB;
constexpr size_t WS_W1T = 8 * MiB;
constexpr size_t WS_W2T = 136 * MiB;
constexpr size_t WS_W3T = 168 * MiB;
constexpr size_t WS_WKVT = 232 * MiB;
constexpr size_t WS_W4T = 240 * MiB;
constexpr size_t WS_HB = 272 * MiB;
constexpr size_t WS_KVN = 336 * MiB;
constexpr size_t WS_Q = 400 * MiB, WS_K = 464 * MiB, WS_V = 528 * MiB, WS_Z = 592 * MiB;
constexpr size_t WS_OG = 656 * MiB;
constexpr size_t WS_H1 = 720 * MiB;
constexpr size_t WS_KV1 = 848 * MiB;
constexpr size_t WS_FDBG = 864 * MiB;
constexpr size_t WS_END = 866 * MiB;
constexpr int CW_BAR = 4096;
constexpr int CW_QUEUE = 8192;
constexpr int CW_NORM = 8448;

constexpr int LDS_BYTES = 155648;
constexpr int MISC_OFF = LDS_BYTES - 256;
constexpr int NWAVES = 8, NTHR = 512;
static_assert(att::LDS_BYTES <= MISC_OFF && 131072 <= MISC_OFF, "LDS map");

struct Params { const float* in[14]; float* out; unsigned char* ws; int ph_lo, ph_hi; };
enum { I_X = 0, I_C, I_NORMG, I_ADAW, I_ADAB, I_AWIN, I_ABF, I_AWOUT, I_KVG, I_KVW, I_BWIN, I_SINK, I_BWOUT, I_FING };

struct Frame { LAS unsigned char* lds; int tid, lane, wave, vcu, G; };

__device__ __forceinline__ float wave_sum(float v) {
#pragma unroll
    for (int o = 1; o < 64; o <<= 1) v += __shfl_xor(v, o);
    return v;
}
__device__ __forceinline__ unsigned f2bf(float f) { unsigned u = __builtin_bit_cast(unsigned, f); return (u + 0x7fffu + ((u >> 16) & 1u)) >> 16; }
__device__ __forceinline__ unsigned pk2(float lo, float hi) { return f2bf(lo) | (f2bf(hi) << 16); }
__device__ __forceinline__ float bf2f(unsigned short b) { return __uint_as_float((unsigned)b << 16); }

#if defined(TR128)
template <class RowMap>
__device__ __forceinline__ void transpose_item(const float* W, int ldw, int K, int k0, int c0, bf16_t* WT, RowMap rowmap, LAS float* scr, int lane) {
    const int kk = lane >> 3, nn = (lane & 7) * 4;
    f32x4 v[16];
#pragma unroll
    for (int i = 0; i < 16; ++i) v[i] = *(const GAS f32x4*)(W + (size_t)(k0 + 8 * i + kk) * ldw + c0 + nn);
#pragma unroll
    for (int i = 0; i < 16; ++i) { LAS float* s = scr + (8 * i + kk) * 33 + nn; s[0] = v[i][0]; s[1] = v[i][1]; s[2] = v[i][2]; s[3] = v[i][3]; }
    asm volatile("s_waitcnt lgkmcnt(0)" ::: "memory");
    const int c = lane & 15, nr = lane >> 4;
#pragma unroll
    for (int j = 0; j < 8; ++j) { const int n = nr + 4 * j; const LAS float* s = scr + (8 * c) * 33 + n;
        u32x4 o; o.x = pk2(s[0 * 33], s[1 * 33]); o.y = pk2(s[2 * 33], s[3 * 33]); o.z = pk2(s[4 * 33], s[5 * 33]); o.w = pk2(s[6 * 33], s[7 * 33]);
        *(GAS u32x4*)(WT + (size_t)rowmap(c0 + n) * K + k0 + 8 * c) = o; }
    asm volatile("s_waitcnt lgkmcnt(0)" ::: "memory");
}
#define TR_KB 128
#define TR_NB 32
#define TR_SCR (128 * 33)
#else
template <class RowMap>
__device__ __forceinline__ void transpose_item(const float* W, int ldw, int K, int k0, int c0, bf16_t* WT, RowMap rowmap, LAS float* scr, int lane) {
    const int kk = lane >> 4, nn = (lane & 15) * 4;
    f32x4 v[16];
#pragma unroll
    for (int i = 0; i < 16; ++i) v[i] = *(const GAS f32x4*)(W + (size_t)(k0 + 4 * i + kk) * ldw + c0 + nn);
#pragma unroll
    for (int i = 0; i < 16; ++i) { LAS float* s = scr + (4 * i + kk) * 65 + nn; s[0] = v[i][0]; s[1] = v[i][1]; s[2] = v[i][2]; s[3] = v[i][3]; }
    asm volatile("s_waitcnt lgkmcnt(0)" ::: "memory");
    const int c = lane & 7, nr = lane >> 3;
#pragma unroll
    for (int j = 0; j < 8; ++j) { const int n = nr + 8 * j; const LAS float* s = scr + (8 * c) * 65 + n;
        u32x4 o; o.x = pk2(s[0 * 65], s[1 * 65]); o.y = pk2(s[2 * 65], s[3 * 65]); o.z = pk2(s[4 * 65], s[5 * 65]); o.w = pk2(s[6 * 65], s[7 * 65]);
        *(GAS u32x4*)(WT + (size_t)rowmap(c0 + n) * K + k0 + 8 * c) = o; }
    asm volatile("s_waitcnt lgkmcnt(0)" ::: "memory");
}
#define TR_KB 64
#define TR_NB 64
#define TR_SCR (64 * 65)
#endif
struct RowId { __device__ __forceinline__ int operator()(int c) const { return c; } };
struct RowRope { int lim; __device__ __forceinline__ int operator()(int c) const { if (c >= lim) return c; const int j = c & 127, jj = j & 63; return (c & ~127) + 8 * (jj >> 2) + ((j >> 6) << 2) + (jj & 3); } };

__device__ __forceinline__ void p0_prologue(const Frame& F, const Params& P) {
    unsigned char* ws = P.ws;
#ifndef P0A_REP
#define P0A_REP 1
#endif
    _Pragma("unroll 1") for (int repa_ = 0; repa_ < P0A_REP; ++repa_)
    {
        LAS float* sc = (LAS float*)F.lds;
        LAS float* red = (LAS float*)(F.lds + 32768);
        const float* c = P.in[I_C];
        for (int i = F.tid; i < 2 * DM; i += NTHR) { const float v = c[i]; sc[i] = v / (1.0f + __expf(-v)); }
        __syncthreads();
        float* slab = (float*)(ws + WS_SLAB);
        for (int t = F.vcu; t < 768; t += F.G) {
            const int cg = t % 96, ks = t / 96, l = cg / 48, n0 = (cg % 48) * 256;
            const float* Wp = P.in[I_ADAW] + (size_t)l * DM * MOD + (size_t)(ks * 512 + F.wave * 64) * MOD + n0 + 4 * F.lane;
            const LAS float* s0 = sc + ks * 512 + F.wave * 64; const LAS float* s1 = s0 + DM;
            f32x4 a0 = (f32x4){0.f, 0.f, 0.f, 0.f}, a1 = a0;
#pragma unroll 16
            for (int kk = 0; kk < 64; ++kk) { const f32x4 w = *(const GAS f32x4*)(Wp + (size_t)kk * MOD); a0 += w * s0[kk]; a1 += w * s1[kk]; }
            *(LAS f32x4*)(red + (F.wave * 2 + 0) * 256 + 4 * F.lane) = a0; *(LAS f32x4*)(red + (F.wave * 2 + 1) * 256 + 4 * F.lane) = a1;
            __syncthreads();
            { const int b = F.tid >> 8, col = F.tid & 255; float s = 0.f;
#pragma unroll
              for (int w = 0; w < 8; ++w) s += red[(w * 2 + b) * 256 + col];
              slab[(size_t)((ks * 2 + l) * 2 + b) * MOD + n0 + col] = s; }
            __syncthreads();
        }
    }
    {
        LAS float* scr = (LAS float*)F.lds + F.wave * TR_SCR;
        const int gw = F.vcu * NWAVES + F.wave, NGW = F.G * NWAVES;
        constexpr int KBL = DM / TR_KB;
        constexpr int I1 = KBL * (N1 / TR_NB), I2 = KBL * (DM / TR_NB), IKV = KBL * (NKV2 / TR_NB), I3 = KBL * (N3 / TR_NB), I4 = I2;
        constexpr int NIT = I1 + I2 + IKV + I3 + I4;
        for (int it = gw; it < NIT; it += NGW) {
            int r = it;
            if (r < I2) { transpose_item(P.in[I_AWOUT], DM, DM, (r % KBL) * TR_KB, (r / KBL) * TR_NB, (bf16_t*)(ws + WS_W2T), RowId{}, scr, F.lane); continue; } r -= I2;
            if (r < IKV) { transpose_item(P.in[I_KVW], NKV2, DM, (r % KBL) * TR_KB, (r / KBL) * TR_NB, (bf16_t*)(ws + WS_WKVT), RowRope{KVW}, scr, F.lane); continue; } r -= IKV;
            if (r < I3) { transpose_item(P.in[I_BWIN], N3, DM, (r % KBL) * TR_KB, (r / KBL) * TR_NB, (bf16_t*)(ws + WS_W3T), RowRope{DM}, scr, F.lane); continue; } r -= I3;
            if (r < I4) { transpose_item(P.in[I_BWOUT], DM, DM, (r % KBL) * TR_KB, (r / KBL) * TR_NB, (bf16_t*)(ws + WS_W4T), RowId{}, scr, F.lane); continue; } r -= I4;
            transpose_item(P.in[I_AWIN], N1F, DM, (r % KBL) * TR_KB, (r / KBL) * TR_NB, (bf16_t*)(ws + WS_W1T), RowId{}, scr, F.lane);
        }
    }
    {
        const int gt = F.vcu * NTHR + F.tid, NGT = F.G * NTHR;
        bf16_t* wft = (bf16_t*)(ws + WS_WFT); const float* W = P.in[I_AWIN];
        for (int i = gt; i < NH * DM; i += NGT) { const int k = i >> 5, n = i & 31; wft[(size_t)n * DM + k] = (bf16_t)f2bf(W[(size_t)k * N1F + N1 + n]); }
        float* cs = (float*)(ws + WS_ROPE); float* sn = cs + SEQ * 64;
        for (int i = gt; i < SEQ * 64; i += NGT) {
            const int pos = i >> 6, j = i & 63;
            double th = 1.0; for (int q = 0; q < j; ++q) th *= 0.8659643233600653523531691834202299819398;
            const double t2 = th * th; double cc = 1.0, ss = th, tc = 1.0, ts = th;
#pragma unroll
            for (int q = 1; q <= 11; ++q) { tc *= t2 * (-1.0 / (double)((2 * q - 1) * (2 * q))); ts *= t2 * (-1.0 / (double)((2 * q) * (2 * q + 1))); cc += tc; ss += ts; }
            double rc = 1.0, rs = 0.0;
            for (int mbit = 0; mbit < 12; ++mbit) {
                if ((pos >> mbit) & 1) { const double nc = rc * cc - rs * ss, ns = rs * cc + rc * ss; rc = nc; rs = ns; }
                const double c2 = cc * cc - ss * ss, s2 = 2.0 * ss * cc; cc = c2; ss = s2;
            }
            cs[i] = (float)rc; sn[i] = (float)rs;
        }
    }
}

__device__ __forceinline__ void p1_norm0(const Frame& F, const Params& P) {
    unsigned char* ws = P.ws;
    const float* slab = (const float*)(ws + WS_SLAB); float* mod = (float*)(ws + WS_MOD);
    for (int i = F.vcu * NTHR + F.tid; i < 2 * 2 * MOD; i += F.G * NTHR) {
        const int n = i % MOD, lb = i / MOD, l = lb >> 1; float s = P.in[I_ADAB][l * MOD + n];
#pragma unroll
        for (int ks = 0; ks < 8; ++ks) s += slab[(size_t)(ks * 4 + lb) * MOD + n];
        mod[i] = s;
    }
    LAS float* gs = (LAS float*)F.lds; LAS float* sh = gs + DM;
    LAS float* red = sh + DM;
    bf16_t* h0 = (bf16_t*)(ws + WS_HB); const bf16_t* wft = (const bf16_t*)(ws + WS_WFT); float* logf = (float*)(ws + WS_LOGF);
    for (int rb = F.vcu; rb < M / 32; rb += F.G) {
        const int row0 = rb * 32, b = row0 / SEQ;
        __syncthreads();
        for (int k = F.tid; k < DM; k += NTHR) {
            float s_sh = P.in[I_ADAB][k], s_sc = P.in[I_ADAB][DM + k];
#pragma unroll
            for (int ks = 0; ks < 8; ++ks) { const float* sl = slab + (size_t)(ks * 4 + b) * MOD; s_sh += sl[k]; s_sc += sl[DM + k]; }
            gs[k] = P.in[I_NORMG][k] * (1.0f + s_sc); sh[k] = s_sh;
        }
        __syncthreads();
#pragma unroll 1
        for (int rr = 0; rr < 4; ++rr) {
            const int row = row0 + F.wave * 4 + rr;
            const GAS f32x4* xr = (const GAS f32x4*)(P.in[I_X] + (size_t)row * DM) + F.lane;
            f32x4 v[16]; float ss = 0.f;
#pragma unroll
            for (int j = 0; j < 16; ++j) { v[j] = __builtin_nontemporal_load(xr + 64 * j); ss += (v[j].x * v[j].x + v[j].y * v[j].y) + (v[j].z * v[j].z + v[j].w * v[j].w); }
            const float rstd = 1.0f / sqrtf(wave_sum(ss) * (1.0f / DM) + EPS);
            GAS u32x2* o8 = (GAS u32x2*)(h0 + (size_t)row * DM) + F.lane;
#pragma unroll
            for (int j = 0; j < 16; ++j) { const f32x4 g = *(const LAS f32x4*)(gs + 256 * j + 4 * F.lane), s = *(const LAS f32x4*)(sh + 256 * j + 4 * F.lane);
                const f32x4 y = v[j] * rstd * g + s; u32x2 w; w.x = pk2(y.x, y.y); w.y = pk2(y.z, y.w); o8[64 * j] = w; }
        }
        asm volatile("s_waitcnt vmcnt(0)" ::: "memory");
        __syncthreads();
        {
            const int r = F.lane & 31, hh = F.lane >> 5;
            const bf16_t* ap = wft + (size_t)r * DM + F.wave * 512 + 8 * hh;
            const bf16_t* bp = h0 + (size_t)(row0 + r) * DM + F.wave * 512 + 8 * hh;
            f32x16 acc = {};
#pragma unroll 8
            for (int k = 0; k < 512; k += 16) { const bf16x8 a = *(const GAS bf16x8*)(ap + k), bb = *(const GAS bf16x8*)(bp + k); acc = __builtin_amdgcn_mfma_f32_32x32x16_bf16(a, bb, acc, 0, 0, 0); }
#pragma unroll
            for (int q = 0; q < 16; ++q) red[(F.wave * 16 + q) * 64 + F.lane] = acc[q];
            __syncthreads();
#pragma unroll
            for (int qq = 0; qq < 2; ++qq) { const int q = 2 * F.wave + qq; float s = 0.f;
#pragma unroll
                for (int w = 0; w < 8; ++w) s += red[(w * 16 + q) * 64 + F.lane];
                const int n = (q & 3) + 8 * (q >> 2) + 4 * hh;
                const float xg = s + P.in[I_ABF][n];
                const float lf = fminf(xg, 0.f) - log1pf(__expf(-fabsf(xg)));
                logf[(size_t)(b * NH + n) * SEQ + (row0 % SEQ) + r] = lf; }
        }
    }
}

template <class DstPtr>
__device__ __forceinline__ void scan_logf(const Frame& F, const float* lf, DstPtr dst, float scale, LAS float* wsum) {
    unsigned lo_ = 32u * (unsigned)F.tid; asm volatile("" : "+v"(lo_));
    const f32x4 a = *(const GAS f32x4*)((const char*)lf + lo_), b = *(const GAS f32x4*)((const char*)lf + lo_ + 16);
    float v[8] = {a.x, a.y, a.z, a.w, b.x, b.y, b.z, b.w};
#pragma unroll
    for (int e = 1; e < 8; ++e) v[e] += v[e - 1];
    const float total = v[7]; float incl = total; int ln_ = (int)(lo_ >> 5) & 63;
#pragma unroll
    for (int o = 1; o < 64; o <<= 1) { const float n = __int_as_float(__builtin_amdgcn_ds_bpermute((ln_ - o) << 2, __float_as_int(incl))); if (ln_ >= o) incl += n; }
    if (ln_ == 63) wsum[F.wave] = incl;
    __syncthreads();
    float off = incl - total;
    for (int w = 0; w < F.wave; ++w) off += wsum[w];
#pragma unroll
    for (int e = 0; e < 8; ++e) dst[8 * F.tid + e] = scale * (off + v[e]);
    __syncthreads();
}

__device__ __forceinline__ att::BlockRef fox_ref(int n, int jlo, float qk) {
    const int qb = 15 - (n >> 6), bh = n & 63, b = bh >> 5, h = bh & 31; att::BlockRef r;
    r.kvoff = (unsigned)b * (SEQ * DM) + h * HD; r.qoff = r.kvoff + (unsigned)qb * (256u * DM); r.P0 = qb * 256; r.jlo = jlo; r.sink_l2 = 0.f; r.qk = qk; return r;
}
__device__ __forceinline__ int fox_jlo(const Frame& F, int n, const unsigned* nrm, float& qk) {
    const int qb = 15 - (n >> 6), bh = n & 63, b = bh >> 5, h = bh & 31;
    const float* nq = (const float*)nrm + ((0 * 2 + b) * 32 + h) * 4; const float* nk = (const float*)nrm + ((1 * 2 + b) * 32 + h) * 4;
    const float q2 = (nq[0] + nq[1]) + (nq[2] + nq[3]), k2 = (nk[0] + nk[1]) + (nk[2] + nk[3]);
    qk = 1.03f * sqrtf(q2 * k2);
    const float X = 40.0f / (LOG2E * att::SCALE) + att::THR / att::SCALE + 2.0f * qk + 16.0f;
#if defined(PROBE_X)
    const float Xp = (float)(PROBE_X);
#define X Xp
#endif
    const LAS float* Fs = (const LAS float*)(F.lds + att::LDS_F);
    const float thresh = Fs[qb * 256] - X;
    const unsigned long long m = __ballot(Fs[64 * F.lane + 63] > thresh);
    return m ? __builtin_ctzll(m) : 63;
#if defined(PROBE_X)
#undef X
#endif
}
__device__ __forceinline__ void p3_fox(const Frame& F, const Params& P, LAS char* lds, volatile LAS unsigned* MISC) {
    unsigned char* ws = P.ws;
#define logf ((const float*)(ws + WS_LOGF))
#define qhead ((unsigned*)(ws + WS_CTL) + CW_QUEUE)
#define nrm ((const unsigned*)(ws + WS_CTL) + CW_NORM)
    att::Bases<WS_Q, WS_K, WS_V, WS_Z, WS_OG> T; T.ws = ws;
    int n_cur = F.vcu;
    if (F.tid == 0) MISC[16] = 256u + __hip_atomic_fetch_add(qhead, 1u, __ATOMIC_RELAXED, __HIP_MEMORY_SCOPE_AGENT);
    scan_logf(F, logf + (size_t)(n_cur & 63) * SEQ, (LAS float*)(F.lds + att::LDS_F), -SQRT_HD, (LAS float*)(F.lds + att::LDS_WS));
    int n_nxt = (int)MISC[16];
    att::Seam S;
    float qk_ = 0.f; const int jl0_ = fox_jlo(F, n_cur, nrm, qk_);
    att::BlockRef cur = fox_ref(n_cur, jl0_, qk_);
    att::attn_prime<true, DM, DM>(T, cur, 1 << 28, lds, S);
#pragma unroll 1
    for (;;) {
        const bool has_next = n_nxt < 1024;
        unsigned n_nn = 0u;
        if (F.tid == 0) n_nn = 256u + __hip_atomic_fetch_add(qhead, 1u, __ATOMIC_RELAXED, __HIP_MEMORY_SCOPE_AGENT);
        const att::BlockRef nxt = has_next ? fox_ref(n_nxt, 0, 0.f) : cur;
        att::attn_block<true, DM, DM, DM>(T, cur, nxt, SEQ, 1 << 28, lds, S);
        if (!has_next) break;
        if (F.tid == 0) MISC[16] = n_nn;
        if ((n_nxt & 63) != (n_cur & 63)) scan_logf(F, logf + (size_t)(n_nxt & 63) * SEQ, (LAS float*)(F.lds + att::LDS_F), -SQRT_HD, (LAS float*)(F.lds + att::LDS_WS));
        else __syncthreads();
        { float qk2_ = 0.f; const int jl_ = fox_jlo(F, n_nxt, nrm, qk2_); cur = fox_ref(n_nxt, jl_, qk2_); }
        n_cur = n_nxt; n_nxt = (int)MISC[16];
        __syncthreads();
    }
#undef logf
#undef qhead
#undef nrm
}
__device__ __forceinline__ att::BlockRef swa_ref(int idx, int b, int kvh, const float* sinks) {
    const int h = kvh * 8 + (idx >> 4), qb = idx & 15; att::BlockRef r; r.qoff = ((unsigned)b * SEQ + (unsigned)qb * 256u) * DM + h * HD; r.kvoff = (unsigned)b * (SEQ * NKV2) + kvh * HD; r.P0 = qb * 256; r.jlo = 0; r.qk = 0.f; r.sink_l2 = sinks[h] * LOG2E; return r;
}
__device__ __forceinline__ void p7_swa(const Frame& F, const Params& P, LAS char* lds) {
    unsigned char* ws = P.ws;
    { const int it = F.vcu;
        const int g8 = it >> 5, b = g8 >> 2, kvh = g8 & 3, i0 = (it & 31) * 4;
        att::Bases<WS_Q, WS_KV1, WS_KV1 + (size_t)KVW * 2, WS_Z, WS_OG> T; T.ws = ws;
        att::Seam S;
        att::BlockRef cur = swa_ref(i0, b, kvh, P.in[I_SINK]);
        att::attn_prime<false, DM, NKV2>(T, cur, 128, lds, S);
#pragma unroll 1
        for (int t = 0; t < 4; ++t) { const att::BlockRef nxt = (t < 3) ? swa_ref(i0 + t + 1, b, kvh, P.in[I_SINK]) : cur; att::attn_block<false, DM, NKV2, DM>(T, cur, nxt, SEQ, 128, lds, S); cur = nxt; }
    }
}

__device__ __forceinline__ void p5_norm1(const Frame& F, const Params& P) {
    unsigned char* ws = P.ws;
    const float* mod = (const float*)(ws + WS_MOD); const float* h1 = (const float*)(ws + WS_H1);
    bf16_t* hb = (bf16_t*)(ws + WS_HB); bf16_t* kvn = (bf16_t*)(ws + WS_KVN);
    LAS float* gs = (LAS float*)F.lds; LAS float* sh = gs + DM; LAS float* gk = sh + DM;
    for (int rb = F.vcu; rb < M / 32; rb += F.G) {
        const int row0 = rb * 32, b = row0 / SEQ;
        __syncthreads();
        for (int k = F.tid; k < DM; k += NTHR) { const float* m1 = mod + (size_t)(2 + b) * MOD; gs[k] = P.in[I_NORMG][DM + k] * (1.0f + m1[DM + k]); sh[k] = m1[k]; gk[k] = P.in[I_KVG][k]; }
        __syncthreads();
#pragma unroll 1
        for (int rr = 0; rr < 4; ++rr) {
            const int row = row0 + F.wave * 4 + rr;
            const GAS f32x4* xr = (const GAS f32x4*)(h1 + (size_t)row * DM) + F.lane;
            f32x4 v[16]; float ss = 0.f;
#pragma unroll
            for (int j = 0; j < 16; ++j) { v[j] = xr[64 * j]; ss += (v[j].x * v[j].x + v[j].y * v[j].y) + (v[j].z * v[j].z + v[j].w * v[j].w); }
            const float rstd = 1.0f / sqrtf(wave_sum(ss) * (1.0f / DM) + EPS);
            GAS u32x2* o1 = (GAS u32x2*)(hb + (size_t)row * DM) + F.lane; GAS u32x2* o2 = (GAS u32x2*)(kvn + (size_t)row * DM) + F.lane;
#pragma unroll
            for (int j = 0; j < 16; ++j) { const int kx = 256 * j + 4 * F.lane; const f32x4 g = *(const LAS f32x4*)(gs + kx), s = *(const LAS f32x4*)(sh + kx), k4 = *(const LAS f32x4*)(gk + kx);
                const f32x4 xn = v[j] * rstd, y = xn * g + s, z = xn * k4; u32x2 w; w.x = pk2(y.x, y.y); w.y = pk2(y.z, y.w); o1[64 * j] = w; w.x = pk2(z.x, z.y); w.y = pk2(z.z, z.w); o2[64 * j] = w;
                asm volatile("" ::: "memory"); }
        }
    }
}
__device__ __forceinline__ void p9_final(const Frame& F, const Params& P) {
    LAS float* gf = (LAS float*)F.lds;
    __syncthreads();
    for (int k = F.tid; k < DM; k += NTHR) gf[k] = P.in[I_FING][k];
    __syncthreads();
    const int gw = F.vcu * NWAVES + F.wave, NGW = F.G * NWAVES;
    for (int row = gw; row < M; row += NGW) {
        GAS f32x4* xr = (GAS f32x4*)(P.out + (size_t)row * DM) + F.lane;
        f32x4 v[16]; float ss = 0.f;
#pragma unroll
        for (int j = 0; j < 16; ++j) { v[j] = xr[64 * j]; ss += (v[j].x * v[j].x + v[j].y * v[j].y) + (v[j].z * v[j].z + v[j].w * v[j].w); }
        const float rstd = 1.0f / sqrtf(wave_sum(ss) * (1.0f / DM) + EPS);
#pragma unroll
        for (int j = 0; j < 16; ++j) xr[64 * j] = v[j] * rstd * *(const LAS f32x4*)(gf + 256 * j + 4 * F.lane);
    }
}


template <class E, class Sched>
__device__ __forceinline__ void naive_gemm_bf16(const Frame& F, const bf16_t* A, const bf16_t* Bt, int K, const Sched& S, const E& e, const float* cs, const float* sn) {
    const int r = F.lane & 31, hh = F.lane >> 5; pg8::Unit u;
    for (int i = 0; S.next(i, u); ++i) {
        const pg8::Dest d = e.dest(u); const int rowu = e.row_of(u);
        for (int t = F.wave; t < 64; t += NWAVES) {
            const int tr = t >> 3, tc = t & 7;
            const bf16_t* ap = A + ((size_t)u.pm * 256 + tr * 32 + r) * K + 8 * hh; const bf16_t* bp = Bt + ((size_t)u.pn * 256 + tc * 32 + r) * K + 8 * hh;
            f32x16 acc = {};
#pragma unroll 4
            for (int k = 0; k < K; k += 16) { const bf16x8 a = *(const GAS bf16x8*)(ap + k), b = *(const GAS bf16x8*)(bp + k); acc = __builtin_amdgcn_mfma_f32_32x32x16_bf16(a, b, acc, 0, 0, 0); }
#pragma unroll
            for (int q = 0; q < 16; ++q) {
                const int row = rowu + tr * 32 + (q & 3) + 8 * (q >> 2) + 4 * hh, p = tc * 32 + r; float v = acc[q];
                if (d.mode == 1) v = pg8::silu_f(v);
                const float partner = __shfl_xor(v, 4);
                if (d.mode == 2) { const int pos = row & 4095, j = 4 * ((p & 127) >> 3) + (p & 3); const float c = cs[pos * 64 + j], s = sn[pos * 64 + j]; v = (p & 4) ? (v * c + partner * s) : (v * c - partner * s); }
                d.p[(size_t)row * d.ld + p] = (bf16_t)f2bf(v);
            }
        }
    }
}
template <class Sched>
__device__ __forceinline__ void naive_gemm_resgate(const Frame& F, const bf16_t* A, const bf16_t* Bt, int K, const Sched& S, const pg8::EpiResGate& e) {
    const int r = F.lane & 31, hh = F.lane >> 5; pg8::Unit u;
    for (int i = 0; S.next(i, u); ++i)
        for (int t = F.wave; t < 64; t += NWAVES) {
            const int tr = t >> 3, tc = t & 7;
            const bf16_t* ap = A + ((size_t)u.pm * 256 + tr * 32 + r) * K + 8 * hh; const bf16_t* bp = Bt + ((size_t)u.pn * 256 + tc * 32 + r) * K + 8 * hh;
            f32x16 acc = {};
#pragma unroll 4
            for (int k = 0; k < K; k += 16) { const bf16x8 a = *(const GAS bf16x8*)(ap + k), b = *(const GAS bf16x8*)(bp + k); acc = __builtin_amdgcn_mfma_f32_32x32x16_bf16(a, b, acc, 0, 0, 0); }
#pragma unroll
            for (int q = 0; q < 16; ++q) { const int row = u.pm * 256 + tr * 32 + (q & 3) + 8 * (q >> 2) + 4 * hh, col = u.pn * 256 + tc * 32 + r; const size_t off = (size_t)row * 4096 + col;
                e.out[off] = e.base[off] + e.gate[(size_t)(row >> 12) * e.gate_ld + col] * acc[q]; }
        }
}
template <bool FOX>
__device__ __forceinline__ void naive_attn(const Frame& F, const Params& P) {
    unsigned char* ws = P.ws;
    const bf16_t* Q = (const bf16_t*)(ws + WS_Q); const bf16_t* Z = (const bf16_t*)(ws + WS_Z); bf16_t* OG = (bf16_t*)(ws + WS_OG);
    LAS float* Fl = (LAS float*)F.lds; LAS float* qs = Fl + 4096 + F.wave * 128; LAS float* wsum = Fl + 4096 + 8 * 128;
    for (int it = F.vcu; it < 256; it += F.G) {
        const int bh = it >> 2, s4 = it & 3, b = bh >> 5, h = bh & 31;
        __syncthreads();
        if (FOX) scan_logf(F, (const float*)(ws + WS_LOGF) + (size_t)bh * SEQ, Fl, 1.0f, wsum);
        const bf16_t* Kp; const bf16_t* Vp; int ldkv;
        if (FOX) { Kp = (const bf16_t*)(ws + WS_K) + (size_t)b * SEQ * DM + h * HD; Vp = (const bf16_t*)(ws + WS_V) + (size_t)b * SEQ * DM + h * HD; ldkv = DM; }
        else { Kp = (const bf16_t*)(ws + WS_KV1) + (size_t)b * SEQ * NKV2 + (h >> 3) * HD; Vp = Kp + KVW; ldkv = NKV2; }
        const float sink = FOX ? 0.f : P.in[I_SINK][h];
        for (int t = F.wave; t < SEQ / 4; t += NWAVES) {
            const int i = 4 * t + s4; const size_t qo = ((size_t)b * SEQ + i) * DM + h * HD;
            { const unsigned qq = *(const GAS unsigned*)(Q + qo + 2 * F.lane); qs[2 * F.lane] = __uint_as_float(qq << 16) * att::SCALE; qs[2 * F.lane + 1] = __uint_as_float(qq & 0xffff0000u) * att::SCALE; }
            asm volatile("s_waitcnt lgkmcnt(0)" ::: "memory");
            float m = -1e30f, l = 0.f, o0 = 0.f, o1 = 0.f;
            const int jst = FOX ? 0 : (i > 127 ? i - 127 : 0);
            for (int jc = jst; jc <= i; jc += 64) {
                const int j = jc + F.lane; const bool valid = j <= i; const int jl = valid ? j : i;
                const bf16_t* kr = Kp + (size_t)jl * ldkv; float dot = 0.f;
#pragma unroll 4
                for (int d = 0; d < 128; d += 8) { const u32x4 kk = *(const GAS u32x4*)(kr + d); const LAS float* qd = qs + d;
                    dot += __uint_as_float(kk.x << 16) * qd[0] + __uint_as_float(kk.x & 0xffff0000u) * qd[1] + __uint_as_float(kk.y << 16) * qd[2] + __uint_as_float(kk.y & 0xffff0000u) * qd[3]
                         + __uint_as_float(kk.z << 16) * qd[4] + __uint_as_float(kk.z & 0xffff0000u) * qd[5] + __uint_as_float(kk.w << 16) * qd[6] + __uint_as_float(kk.w & 0xffff0000u) * qd[7]; }
                float sv = dot; if (FOX) sv += Fl[i] - Fl[jl];
                if (!valid) sv = -__builtin_inff();
                float cm = sv;
#pragma unroll
                for (int o = 1; o < 64; o <<= 1) cm = fmaxf(cm, __shfl_xor(cm, o));
                const float mn = fmaxf(m, cm), alpha = __expf(m - mn), p = valid ? __expf(sv - mn) : 0.f;
                l = l * alpha + wave_sum(p); o0 *= alpha; o1 *= alpha; m = mn;
                const int nj = (i - jc + 1) < 64 ? (i - jc + 1) : 64;
                for (int jj = 0; jj < nj; ++jj) { const float pj = __shfl(p, jj); const bf16_t* vr = Vp + (size_t)(jc + jj) * ldkv; o0 += pj * bf2f(vr[F.lane]); o1 += pj * bf2f(vr[F.lane + 64]); }
            }
            if (!FOX) l += __expf(sink - m);
            const float rl = 1.0f / l;
            OG[qo + F.lane] = (bf16_t)f2bf(o0 * rl * bf2f(Z[qo + F.lane])); OG[qo + F.lane + 64] = (bf16_t)f2bf(o1 * rl * bf2f(Z[qo + F.lane + 64]));
        }
    }
}

constexpr int NPHASE = 10;
__global__ void __launch_bounds__(NTHR, 2) fwd(Params P) {
    extern __shared__ __attribute__((aligned(16))) unsigned char lds[];
#define MAKE_FRAME() Frame F; { unsigned t_ = threadIdx.x; asm volatile("" : "+v"(t_)); F.lds = (LAS unsigned char*)lds; F.tid = (int)t_; F.lane = F.tid & 63; F.wave = __builtin_amdgcn_readfirstlane(F.tid >> 6); \
        F.G = gridDim.x; const int bx_ = blockIdx.x; F.vcu = (F.G % 8 == 0) ? (bx_ % 8) * (F.G / 8) + bx_ / 8 : bx_; }
    volatile LAS unsigned* MISC = (volatile LAS unsigned*)((LAS unsigned char*)lds + MISC_OFF);
    for (int u = threadIdx.x; u < (LDS_BYTES - MISC_OFF) / 4; u += NTHR) MISC[u] = 0u;
    __syncthreads();
    unsigned char* ws = P.ws;
    const int lo = P.ph_lo, hi = P.ph_hi;
    if (hi - lo > 1) (void)xcd_barrier_post((unsigned*)(ws + WS_CTL) + CW_BAR, MISC + 8);
#ifndef PH_MASK
#define PH_MASK 0x3ff
#endif
#define IN(k) (((PH_MASK >> (k)) & 1) && lo <= (k) && (k) < hi)
#ifndef SEAM_TWICE
#define SEAM_TWICE 0
#endif
#define SEAM(k) do { if (IN(k) && IN((k) + 1)) { XcdBarrier bar_; bar_.bar = (unsigned*)(ws + WS_CTL) + CW_BAR; bar_.x = xb_xcc_id(); bar_.st = MISC + 8; xcd_barrier(bar_); if (SEAM_TWICE) xcd_barrier(bar_); } } while (0)
#ifndef REP_MASK
#define REP_MASK 0
#endif
#define REPS(k) _Pragma("unroll 1") for (int rep_ = 0; rep_ < (((REP_MASK >> (k)) & 1) ? 2 : 1); ++rep_)
#define cs ((const float*)(ws + WS_ROPE))
#define sn ((const float*)(ws + WS_ROPE) + SEQ * 64)
#define mod ((const float*)(ws + WS_MOD))

    if (IN(0)) { MAKE_FRAME(); REPS(0) { p0_prologue(F, P); } SEAM(0); }
    if (IN(1)) { MAKE_FRAME(); REPS(1) { p1_norm0(F, P); } SEAM(1); }
    if (IN(2)) { MAKE_FRAME();
        REPS(2) {
#ifndef GX_WGM
#define GX_WGM 4
#endif
#ifndef G1_WGM
#define G1_WGM 4
#endif
        pg8::StaticOrder S; S.init(M, N1, F.G, (int)blockIdx.x, G1_WGM);
        pg8::EpiStoreBf16<pg8::EpiQKVZ> E{{(bf16_t*)(ws + WS_Q), (WS_K - WS_Q) / 2}, cs, sn, (unsigned*)(ws + WS_CTL) + CW_NORM};
#if NAIVE_GEMM
        naive_gemm_bf16(F, (const bf16_t*)(ws + WS_HB), (const bf16_t*)(ws + WS_W1T), DM, S, E.e, cs, sn);
        if (blockIdx.x == 0) for (int i = F.tid; i < 512; i += NTHR) E.nrm[i] = __float_as_uint(1e12f);
#else
        pg8::Gemm g{(const bf16_t*)(ws + WS_HB), (const bf16_t*)(ws + WS_W1T), M, N1, DM};
#if defined(PROBE_NULL_EPI)
        { pg8::EpiNull EN; pg8::gemm_phase<pg8::EpiNull, pg8::StaticOrder, true, true>(F.lds, g, S, EN); }
#endif
        pg8::gemm_phase<pg8::EpiStoreBf16<pg8::EpiQKVZ>, pg8::StaticOrder, true, true>(F.lds, g, S, E);
#endif
        }
        SEAM(2);
    }
    if (IN(3)) { MAKE_FRAME();
        REPS(3) {
#if NAIVE_FOX
        naive_attn<true>(F, P);
#else
        p3_fox(F, P, (LAS char*)F.lds, MISC);
#endif
        }
        SEAM(3);
    }
    if (IN(4)) { MAKE_FRAME();
        REPS(4) {
        pg8::StaticOrder S; S.init(M, DM, F.G, (int)blockIdx.x, GX_WGM);
        pg8::EpiResGate E{P.in[I_X], (float*)(ws + WS_H1), mod + 2 * DM, MOD};
#if NAIVE_GEMM
        naive_gemm_resgate(F, (const bf16_t*)(ws + WS_OG), (const bf16_t*)(ws + WS_W2T), DM, S, E);
#else
        pg8::Gemm g{(const bf16_t*)(ws + WS_OG), (const bf16_t*)(ws + WS_W2T), M, DM, DM};
        pg8::gemm_phase<pg8::EpiResGate, pg8::StaticOrder, true, true>(F.lds, g, S, E);
#endif
        }
        SEAM(4);
    }
    if (IN(5)) { MAKE_FRAME(); REPS(5) { p5_norm1(F, P); } SEAM(5); }
    if (IN(6)) { MAKE_FRAME();
        REPS(6) {
        pg8::OrderQZKV S; S.init(F.G, (int)blockIdx.x, GX_WGM);
        pg8::EpiStoreBf16<pg8::EpiQZKV> E{{(bf16_t*)(ws + WS_Q), (bf16_t*)(ws + WS_Z), (bf16_t*)(ws + WS_KV1)}, cs, sn, nullptr};
#if NAIVE_GEMM
        naive_gemm_bf16(F, (const bf16_t*)(ws + WS_HB), (const bf16_t*)(ws + WS_W3T), DM, S, E.e, cs, sn);
#else
        pg8::Gemm g{(const bf16_t*)(ws + WS_HB), (const bf16_t*)(ws + WS_W3T), 2 * M, N3 + NKV2, DM};
        pg8::gemm_phase<pg8::EpiStoreBf16<pg8::EpiQZKV>, pg8::OrderQZKV, true, true>(F.lds, g, S, E);
#endif
        }
        SEAM(6);
    }
    if (IN(7)) { MAKE_FRAME();
        REPS(7) {
#if NAIVE_SWA
        naive_attn<false>(F, P);
#else
        p7_swa(F, P, (LAS char*)F.lds);
#endif
        }
        SEAM(7);
    }
    if (IN(8)) { MAKE_FRAME();
        REPS(8) {
        pg8::StaticOrder S; S.init(M, DM, F.G, (int)blockIdx.x, GX_WGM);
        pg8::EpiResGate E{(const float*)(ws + WS_H1), P.out, mod + 2 * MOD + 2 * DM, MOD};
#if NAIVE_GEMM
        naive_gemm_resgate(F, (const bf16_t*)(ws + WS_OG), (const bf16_t*)(ws + WS_W4T), DM, S, E);
#else
        pg8::Gemm g{(const bf16_t*)(ws + WS_OG), (const bf16_t*)(ws + WS_W4T), M, DM, DM};
        pg8::gemm_phase<pg8::EpiResGate, pg8::StaticOrder, true, true>(F.lds, g, S, E);
#endif
        }
        SEAM(8);
    }
    if (IN(9)) { MAKE_FRAME(); p9_final(F, P); }
#undef IN
#undef SEAM
#undef cs
#undef sn
#undef mod
}

extern "C" void kernel_launch(void* const* d_in, const int* in_sizes, int n_in, void* d_out, int out_size, void* d_ws, size_t ws_size, hipStream_t stream) {
    static int grid = 0;
    if (grid == 0) {
        if (n_in != 14 || out_size != M * DM || ws_size < WS_END) { fprintf(stderr, "kernel_launch: unexpected shapes (n_in %d, out %d, ws %zu)\n", n_in, out_size, ws_size); grid = -1; return; }
        int dev = 0, cus = 0, per_cu = 0;
        if (hipGetDevice(&dev) != hipSuccess || hipDeviceGetAttribute(&cus, hipDeviceAttributeMultiprocessorCount, dev) != hipSuccess) { grid = -1; return; }
        if (hipFuncSetAttribute((const void*)fwd, hipFuncAttributeMaxDynamicSharedMemorySize, LDS_BYTES) != hipSuccess) { fprintf(stderr, "kernel_launch: hipFuncSetAttribute failed\n"); grid = -1; return; }
        if (hipOccupancyMaxActiveBlocksPerMultiprocessor(&per_cu, (const void*)fwd, NTHR, LDS_BYTES) != hipSuccess || per_cu < 1) fprintf(stderr, "kernel_launch: occupancy query reports %d workgroups per CU\n", per_cu);
        (void)hipGetLastError();
        grid = cus;
        if (grid > 256) grid = 256;
    }
    if (grid < 0) return;
    (void)hipMemsetAsync((char*)d_ws + WS_CTL, 0, CTL_ZERO_BYTES, stream);
    Params p{};
    for (int i = 0; i < 14; ++i) p.in[i] = (const float*)d_in[i];
    p.out = (float*)d_out; p.ws = (unsigned char*)d_ws;
#if MK_N_LAUNCHES == 1
    p.ph_lo = 0; p.ph_hi = NPHASE;
    hipLaunchKernelGGL(fwd, dim3(grid), dim3(NTHR), LDS_BYTES, stream, p);
#else
    for (int k = 0; k < NPHASE; ++k) { p.ph_lo = k; p.ph_hi = k + 1; hipLaunchKernelGGL(fwd, dim3(grid), dim3(NTHR), LDS_BYTES, stream, p); }
#endif
    const hipError_t le = hipPeekAtLastError();
    if (le != hipSuccess) fprintf(stderr, "kernel_launch: launch failed: %s\n", hipGetErrorName(le));
}
```

```cpp
#include <hip/hip_runtime.h>
#include <cstdio>
#include <cstdint>

#ifndef MK_N_LAUNCHES
#define MK_N_LAUNCHES 1
#endif
#define NT_OUT 1
#ifndef WSKIP_ON
#define WSKIP_ON 0
#endif
#ifndef NAIVE_GEMM
#define NAIVE_GEMM 0
#endif
#ifndef NAIVE_FOX
#define NAIVE_FOX 0
#endif
#ifndef NAIVE_SWA
#define NAIVE_SWA 0
#endif

#define GAS __attribute__((address_space(1)))
#define LAS __attribute__((address_space(3)))
typedef float f32x16 __attribute__((ext_vector_type(16)));
typedef short s16x4 __attribute__((ext_vector_type(4)));
typedef unsigned u32x2 __attribute__((ext_vector_type(2)));

constexpr int DM = 4096, BATCH = 2, SEQ = 4096, M = BATCH * SEQ;
constexpr int NH = 32, HD = 128, NKV = 4, KVW = NKV * HD;
constexpr int N1 = 4 * DM;
constexpr int N1F = N1 + NH;
constexpr int N3 = 2 * DM, NKV2 = 2 * KVW;
constexpr int MOD = 3 * DM;
constexpr float EPS = 1e-6f;
constexpr float LOG2E = 1.4426950408889634f;
constexpr float SQRT_HD = 11.313708498984761f;

typedef unsigned short bf16_t;
typedef short bf16x8 __attribute__((ext_vector_type(8)));
typedef float f32x4 __attribute__((ext_vector_type(4)));
typedef unsigned u32x4 __attribute__((ext_vector_type(4)));

namespace pg8 {
#define PG8_LAS __attribute__((address_space(3)))
typedef unsigned short bf16_t;
typedef short bf16x8 __attribute__((ext_vector_type(8)));
typedef float f32x4 __attribute__((ext_vector_type(4)));
typedef unsigned u32x4 __attribute__((ext_vector_type(4)));
constexpr int BM = 256, BK = 64, HALF = 128, HTB = HALF * BK * 2  , STAGE_BYTES = 8 * HTB, NXCD = 8, WGM = 8;

__host__ __device__ __forceinline__ int lds_byte(int r, int c) { const int st = (r >> 4) * 2 + (c >> 5), rr = r & 15, cc = c & 31, ob = rr * 64 + cc * 2; return st * 1024 + (ob ^ (((ob >> 9) & 1) << 5)); }
__host__ __device__ __forceinline__ void stage_rc(int b, int& R, int& C) { const int st = b / 1024, sb = b % 1024, swz = sb ^ (((sb >> 9) & 1) << 5); R = (st >> 1) * 16 + swz / 64; C = (st & 1) * 32 + (swz % 64) / 2; }
__host__ __device__ __forceinline__ int perm32(int rho) { const int n = rho >> 4, i = rho & 15; return 8 * (i >> 2) + 4 * n + (i & 3); }

struct Unit { int pm, pn; };
struct Gemm { const bf16_t* A; const bf16_t* Bt; int M, N, K; };

struct StaticOrder {
    int nM, nN, nwg, G, c, wgm;
    __host__ __device__ void init(int M, int N, int G_, int c_, int wgm_ = WGM) { nM = M / BM; nN = N / BM; nwg = nM * nN; G = G_; c = c_; wgm = wgm_; }
    __host__ __device__ bool next(int i, Unit& u) const {
        const long L = (long)i * G + c; if (L >= nwg) return false;
        int wgid = (int)L; { const int q = nwg / NXCD, r = nwg % NXCD, xcd = wgid % NXCD, off = wgid / NXCD; wgid = (xcd < r ? xcd * (q + 1) : r * (q + 1) + (xcd - r) * q) + off; }
        const int nig = wgm * nN, gid = wgid / nig, fm = gid * wgm, gsz = (nM - fm) < wgm ? (nM - fm) : wgm;
        u.pm = fm + ((wgid % nig) % gsz); u.pn = (wgid % nig) / gsz; return true;
    }
    __device__ __forceinline__ void a_ready(const Unit&) const {}
    __device__ __forceinline__ void done(const Unit&) const {}
};

__device__ __forceinline__ unsigned cvt_pk_bf16(float lo, float hi) { unsigned r; asm volatile("v_cvt_pk_bf16_f32 %0, %1, %2" : "=v"(r) : "v"(lo), "v"(hi)); return r; }
__device__ __forceinline__ float silu_f(float v) { return v * __builtin_amdgcn_rcpf(1.0f + __builtin_amdgcn_exp2f(-1.4426950408889634f * v)); }
__device__ __forceinline__ f32x4 silu4(f32x4 v) { return (f32x4){silu_f(v[0]), silu_f(v[1]), silu_f(v[2]), silu_f(v[3])}; }

struct Dest { bf16_t* p; int ld; int mode; };

struct EpiQKVZ {
    static constexpr bool PERM = true, AFTER_DRAIN = false;
    bf16_t* O; size_t split_stride;
    __device__ __forceinline__ Dest dest(const Unit& u) const { const int colt = u.pn * BM, t = colt >> 12; Dest d; d.p = O + (size_t)t * split_stride + (colt & 4095); d.ld = 4096; d.mode = (t == 3) ? 1 : 0; return d; }
    __device__ __forceinline__ int row_of(const Unit& u) const { return u.pm * BM; }
};
struct EpiQZKV {
    static constexpr bool PERM = true, AFTER_DRAIN = false;
    bf16_t* Q1; bf16_t* Z1; bf16_t* KV1;
    __device__ __forceinline__ Dest dest(const Unit& u) const {
        Dest d;
        if (u.pn < 32) { const int colt = u.pn * BM; if (colt < 4096) { d.p = Q1 + colt; d.mode = 2; } else { d.p = Z1 + (colt - 4096); d.mode = 1; } d.ld = 4096; }
        else { const int colt = (u.pn - 32) * BM; d.p = KV1 + colt; d.ld = 1024; d.mode = (colt < 512) ? 2 : 0; }
        return d;
    }
    __device__ __forceinline__ int row_of(const Unit& u) const { return (u.pn < 32 ? u.pm : u.pm - 32) * BM; }
};
template <class E> struct EpiStoreBf16 {
    static constexpr bool PERM = true, AFTER_DRAIN = false;
    E e; const float* cs; const float* sn; unsigned* nrm;
    __device__ __forceinline__ void operator()(const f32x4 (&acc)[2][2][4][2], const Unit& u, int wr, int wc, int fr, int fq) const {
        const Dest d = e.dest(u); const int row0 = e.row_of(u) + wr * 64 + fr; const int col0 = wc * 32 + 8 * fq;
        const int g4 = (4 * wc + fq) * 4;
        float nmax[2] = {0.f, 0.f};
#pragma unroll
        for (int ai = 0; ai < 2; ++ai)
#pragma unroll
            for (int m = 0; m < 4; ++m) { const int row = row0 + ai * HALF + m * 16; bf16_t* rowp = d.p + (size_t)row * d.ld + col0;
                f32x4 c4 = (f32x4){1.f, 1.f, 1.f, 1.f}, s4 = (f32x4){0.f, 0.f, 0.f, 0.f};
                if (d.mode == 2) { const int pos = row & 4095; c4 = *(const f32x4*)(cs + pos * 64 + g4); s4 = *(const f32x4*)(sn + pos * 64 + g4); }
#pragma unroll
                for (int bj = 0; bj < 2; ++bj) { f32x4 v0 = acc[ai][bj][m][0], v1 = acc[ai][bj][m][1];
                    if (d.mode == 1) { v0 = silu4(v0); v1 = silu4(v1); }
                    if (d.mode == 2) { const f32x4 y1 = v0 * c4 - v1 * s4, y2 = v1 * c4 + v0 * s4; v0 = y1; v1 = y2; }
                    if (nrm) { float ss = (v0[0] * v0[0] + v0[1] * v0[1]) + (v0[2] * v0[2] + v0[3] * v0[3]) + (v1[0] * v1[0] + v1[1] * v1[1]) + (v1[2] * v1[2] + v1[3] * v1[3]);
                        ss += __shfl_xor(ss, 16); ss += __shfl_xor(ss, 32); nmax[bj] = fmaxf(nmax[bj], ss); }
                    u32x4 w; w.x = cvt_pk_bf16(v0[0], v0[1]); w.y = cvt_pk_bf16(v0[2], v0[3]); w.z = cvt_pk_bf16(v1[0], v1[1]); w.w = cvt_pk_bf16(v1[2], v1[3]);
#if defined(NT_OUT)
                    __builtin_nontemporal_store(w, (u32x4*)(rowp + bj * HALF)); } }
#else
                    *(u32x4*)(rowp + bj * HALF) = w; } }
#endif
        if (nrm) { const int colt = u.pn * BM, t = colt >> 12;
            if (t < 2) {
#pragma unroll
                for (int bj = 0; bj < 2; ++bj) { float mx = nmax[bj];
#pragma unroll
                    for (int o = 1; o < 16; o <<= 1) mx = fmaxf(mx, __shfl_xor(mx, o));
                    if (fr == 0 && fq == 0) atomicMax(nrm + ((((t * 2 + ((u.pm * BM) >> 12)) * 32) + ((colt & 4095) >> 7) + bj) * 4 + wc), __float_as_uint(mx)); } } }
    }
};
struct EpiResGate {
    static constexpr bool PERM = false, AFTER_DRAIN = false;
    const float* base; float* out; const float* gate; int gate_ld;
    __device__ __forceinline__ void operator()(const f32x4 (&acc)[2][2][4][2], const Unit& u, int wr, int wc, int fr, int fq) const {
        const int row0 = u.pm * BM + wr * 64 + fr, col0 = u.pn * BM + wc * 32 + 4 * fq; const float* gp = gate + (size_t)((u.pm * BM) >> 12) * gate_ld + col0;
        f32x4 gv[2][2];
#pragma unroll
        for (int bj = 0; bj < 2; ++bj)
#pragma unroll
            for (int n = 0; n < 2; ++n) gv[bj][n] = *(const f32x4*)(gp + bj * HALF + n * 16);
#pragma unroll
        for (int ai = 0; ai < 2; ++ai)
#pragma unroll
            for (int m = 0; m < 4; ++m) { const size_t off = (size_t)(row0 + ai * HALF + m * 16) * 4096 + col0;
#pragma unroll
                for (int bj = 0; bj < 2; ++bj)
#pragma unroll
                    for (int n = 0; n < 2; ++n) { const f32x4 bs = *(const f32x4*)(base + off + bj * HALF + n * 16); *(f32x4*)(out + off + bj * HALF + n * 16) = bs + gv[bj][n] * acc[ai][bj][m][n]; } }
    }
};
struct EpiNull {
    static constexpr bool PERM = true, AFTER_DRAIN = false;
    __device__ __forceinline__ void operator()(const f32x4 (&acc)[2][2][4][2], const Unit&, int, int, int, int) const {
#pragma unroll
        for (int ai = 0; ai < 2; ++ai)
#pragma unroll
            for (int bj = 0; bj < 2; ++bj)
#pragma unroll
                for (int m = 0; m < 4; ++m) asm volatile("" :: "v"(acc[ai][bj][m][0]), "v"(acc[ai][bj][m][1]));
    }
};
struct OrderQZKV {
    StaticOrder so; int G, c;
    __device__ void init(int G_, int c_, int wgm_) { so.init(8192, 8192, G_, c_, wgm_); G = G_; c = c_; }
    __device__ bool next(int i, Unit& u) const {
        if (so.next(i, u)) return true;
        const long L = (long)i * G + c - 1024; if (L < 0 || L >= 128) return false;
        u.pm = 32 + (int)(L >> 2); u.pn = 32 + (int)(L & 3); return true;
    }
    __device__ __forceinline__ void a_ready(const Unit&) const {}
    __device__ __forceinline__ void done(const Unit&) const {}
};

template <class Epi, class Sched, bool ALIGN_EPI = false, bool SP2 = false>
__device__ __forceinline__ void gemm_phase(PG8_LAS unsigned char* lds, const Gemm g, const Sched& S, const Epi& E) {
    const int tid = threadIdx.x, wid = __builtin_amdgcn_readfirstlane(tid >> 6), lane = tid & 63, wr = wid >> 2, wc = wid & 3, fr = lane & 15, fq = lane >> 4;
    const int K = g.K, nt = K / BK;
    unsigned voffA[2], voffB[2];
#pragma unroll
    for (int i = 0; i < 2; ++i) { int R, C; stage_rc(tid * 16 + i * 8192, R, C); const int Rb = Epi::PERM ? ((R & ~31) + perm32(R & 31)) : R;
        voffA[i] = (unsigned)(R * K + C) * 2u; voffB[i] = (unsigned)(Rb * K + C) * 2u; }
    const size_t kstep = (size_t)(BK * 2);
    const size_t hstep = (size_t)HALF * K * 2;
    const size_t tstep = 2 * hstep;
    const unsigned ldsw = (unsigned)wid * 1024u;
    const int aoff = lds_byte(wr * 64 + fr, fq * 8), boff = lds_byte(wc * 32 + fr, fq * 8);
#define PG8_SA(b, h) (((b) * 2 + (h)) * HTB)
#define PG8_SB(b, h) ((4 + (b) * 2 + (h)) * HTB)
#define PG8_STAGE(bufoff, gbase, voff) do { _Pragma("unroll") for (int _i = 0; _i < 2; ++_i) \
        __builtin_amdgcn_global_load_lds((const unsigned*)((const char*)(gbase) + (voff)[_i]), (PG8_LAS unsigned*)(lds + (bufoff) + ldsw + _i * 8192), 16, 0, 0); } while (0)
#define PG8_LDA(dst, b, h) do { _Pragma("unroll") for (int m = 0; m < 4; ++m) _Pragma("unroll") for (int k = 0; k < 2; ++k) dst[m][k] = *(const PG8_LAS bf16x8*)(lds + PG8_SA(b, h) + aoff + m * 2048 + k * 1024); } while (0)
#define PG8_LDB(dst, b, h) do { _Pragma("unroll") for (int n = 0; n < 2; ++n) _Pragma("unroll") for (int k = 0; k < 2; ++k) dst[n][k] = *(const PG8_LAS bf16x8*)(lds + PG8_SB(b, h) + boff + n * 2048 + k * 1024); } while (0)
#define PG8_MMA(ai, bj, At, Bt) do { __builtin_amdgcn_s_setprio(1); _Pragma("unroll") for (int m = 0; m < 4; ++m) _Pragma("unroll") for (int n = 0; n < 2; ++n) _Pragma("unroll") for (int k = 0; k < 2; ++k) \
        acc[ai][bj][m][n] = __builtin_amdgcn_mfma_f32_16x16x32_bf16(Bt[n][k], At[m][k], acc[ai][bj][m][n], 0, 0, 0); __builtin_amdgcn_s_setprio(0); } while (0)
#define PG8_WAIT_V(n) asm volatile("s_waitcnt vmcnt(" #n ")" ::: "memory")
#define PG8_WAIT_L(n) asm volatile("s_waitcnt lgkmcnt(" #n ")" ::: "memory")
#define PG8_BAR __builtin_amdgcn_s_barrier()
#define PG8_SCHED __builtin_amdgcn_sched_barrier(0)
    Unit cur, nxt; int ui = 0;
    if (!S.next(0, cur)) return;
    f32x4 acc[2][2][4][2];
#pragma unroll
    for (int a = 0; a < 2; ++a)
#pragma unroll
        for (int b = 0; b < 2; ++b)
#pragma unroll
            for (int m = 0; m < 4; ++m)
#pragma unroll
                for (int n = 0; n < 2; ++n) acc[a][b][m][n] = (f32x4){0.f, 0.f, 0.f, 0.f};
    bf16x8 At[4][2], B0[2][2], B1[2][2];
    const char* cA = (const char*)g.A + (size_t)cur.pm * tstep; const char* cB = (const char*)g.Bt + (size_t)cur.pn * tstep;
    S.a_ready(cur);
    if constexpr (SP2) {
        PG8_STAGE(PG8_SB(0, 0), cB, voffB); PG8_STAGE(PG8_SB(0, 1), cB + hstep, voffB); PG8_STAGE(PG8_SA(0, 0), cA, voffA); PG8_STAGE(PG8_SA(0, 1), cA + hstep, voffA);
        if (wr == 1) PG8_BAR;
        PG8_WAIT_V(2); PG8_BAR;
        PG8_STAGE(PG8_SB(1, 0), cB + kstep, voffB); PG8_STAGE(PG8_SA(1, 0), cA + kstep, voffA); PG8_STAGE(PG8_SB(1, 1), cB + hstep + kstep, voffB);
        PG8_WAIT_V(6); PG8_BAR;
    } else {
        PG8_STAGE(PG8_SB(0, 0), cB, voffB); PG8_STAGE(PG8_SA(0, 0), cA, voffA); PG8_STAGE(PG8_SB(0, 1), cB + hstep, voffB); PG8_STAGE(PG8_SA(0, 1), cA + hstep, voffA);
        if (wr == 1) PG8_BAR;
        PG8_WAIT_V(4); PG8_BAR;
        PG8_STAGE(PG8_SB(1, 0), cB + kstep, voffB); PG8_STAGE(PG8_SA(1, 0), cA + kstep, voffA); PG8_STAGE(PG8_SB(1, 1), cB + hstep + kstep, voffB);
        PG8_WAIT_V(6); PG8_BAR;
    }
    for (;;) {
        const bool has_next = S.next(ui + 1, nxt);
        const char* nA = has_next ? (const char*)g.A + (size_t)nxt.pm * tstep : cA; const char* nB = has_next ? (const char*)g.Bt + (size_t)nxt.pn * tstep : cB;
        for (int t = 0; t < nt; t += 2) {
            const bool last = (t == nt - 2);
            const char* a1 = cA + (size_t)(t + 1) * kstep;
            const char* a2 = last ? nA : cA + (size_t)(t + 2) * kstep; const char* b2 = last ? nB : cB + (size_t)(t + 2) * kstep;
            const char* a3 = a2 + kstep; const char* b3 = b2 + kstep;
            if (last && has_next) S.a_ready(nxt);
            if constexpr (SP2) {
            PG8_LDB(B0, 0, 0); PG8_LDB(B1, 0, 1); PG8_SCHED; PG8_LDA(At, 0, 0); PG8_STAGE(PG8_SA(1, 1), a1 + hstep, voffA);
            PG8_WAIT_V(8); PG8_WAIT_L(0); PG8_BAR; PG8_MMA(0, 0, At, B0); PG8_MMA(0, 1, At, B1); PG8_BAR; PG8_SCHED;
            PG8_LDA(At, 0, 1); PG8_STAGE(PG8_SB(0, 0), b2, voffB); PG8_STAGE(PG8_SB(0, 1), b2 + hstep, voffB); PG8_STAGE(PG8_SA(0, 0), a2, voffA);
            PG8_WAIT_V(8); PG8_WAIT_L(0); PG8_BAR; PG8_MMA(1, 0, At, B0); PG8_MMA(1, 1, At, B1); PG8_BAR; PG8_SCHED;
            PG8_LDB(B0, 1, 0); PG8_LDB(B1, 1, 1); PG8_SCHED; PG8_LDA(At, 1, 0); PG8_STAGE(PG8_SA(0, 1), a2 + hstep, voffA);
            PG8_WAIT_V(8); PG8_WAIT_L(0); PG8_BAR; PG8_MMA(0, 0, At, B0); PG8_MMA(0, 1, At, B1); PG8_BAR; PG8_SCHED;
            PG8_LDA(At, 1, 1); PG8_STAGE(PG8_SB(1, 0), b3, voffB); PG8_STAGE(PG8_SB(1, 1), b3 + hstep, voffB); PG8_STAGE(PG8_SA(1, 0), a3, voffA);
            PG8_WAIT_V(8); PG8_WAIT_L(0); PG8_BAR; PG8_MMA(1, 0, At, B0); PG8_MMA(1, 1, At, B1); PG8_BAR; PG8_SCHED;
            } else {
            PG8_LDB(B0, 0, 0); PG8_SCHED; PG8_LDA(At, 0, 0); PG8_STAGE(PG8_SA(1, 1), a1 + hstep, voffA);
            PG8_WAIT_L(8); PG8_BAR; PG8_WAIT_L(0); PG8_MMA(0, 0, At, B0); PG8_BAR; PG8_SCHED;
            PG8_LDB(B1, 0, 1); PG8_STAGE(PG8_SB(0, 0), b2, voffB);
            PG8_BAR; PG8_WAIT_L(0); PG8_MMA(0, 1, At, B1); PG8_BAR;
            PG8_LDA(At, 0, 1); PG8_STAGE(PG8_SA(0, 0), a2, voffA);
            PG8_BAR; PG8_WAIT_L(0); PG8_MMA(1, 0, At, B0); PG8_BAR; PG8_SCHED;
            PG8_STAGE(PG8_SB(0, 1), b2 + hstep, voffB);
            PG8_WAIT_V(6); PG8_BAR; PG8_MMA(1, 1, At, B1); PG8_BAR;
            PG8_LDB(B0, 1, 0); PG8_SCHED; PG8_LDA(At, 1, 0); PG8_STAGE(PG8_SA(0, 1), a2 + hstep, voffA);
            PG8_WAIT_L(8); PG8_BAR; PG8_WAIT_L(0); PG8_MMA(0, 0, At, B0); PG8_BAR; PG8_SCHED;
            PG8_LDB(B1, 1, 1); PG8_STAGE(PG8_SB(1, 0), b3, voffB);
            PG8_BAR; PG8_WAIT_L(0); PG8_MMA(0, 1, At, B1); PG8_BAR;
            PG8_LDA(At, 1, 1); PG8_STAGE(PG8_SA(1, 0), a3, voffA);
            PG8_BAR; PG8_WAIT_L(0); PG8_MMA(1, 0, At, B0); PG8_BAR; PG8_SCHED;
            PG8_STAGE(PG8_SB(1, 1), b3 + hstep, voffB);
            PG8_WAIT_V(6); PG8_BAR; PG8_MMA(1, 1, At, B1); PG8_BAR;
            }
        }
        if constexpr (ALIGN_EPI) { if (wr == 0) PG8_BAR; }
#if defined(EPI_TWICE)
        if constexpr (!Epi::AFTER_DRAIN) { _Pragma("unroll 1") for (int rep_ = 0; rep_ < 2; ++rep_) { E(acc, cur, wr, wc, fr, fq); asm volatile("" ::: "memory"); } S.done(cur); }
#else
        if constexpr (!Epi::AFTER_DRAIN) { E(acc, cur, wr, wc, fr, fq); S.done(cur); }
#endif
        if (!has_next) break;
#pragma unroll
        for (int a = 0; a < 2; ++a)
#pragma unroll
            for (int b = 0; b < 2; ++b)
#pragma unroll
                for (int m = 0; m < 4; ++m)
#pragma unroll
                    for (int n = 0; n < 2; ++n) acc[a][b][m][n] = (f32x4){0.f, 0.f, 0.f, 0.f};
        cur = nxt; cA = nA; cB = nB; ++ui;
        if constexpr (ALIGN_EPI) { if (wr == 1) PG8_BAR; }
    }
    PG8_WAIT_V(0);
    if constexpr (!ALIGN_EPI) { if (wr == 0) PG8_BAR; }
    PG8_BAR;
    if constexpr (Epi::AFTER_DRAIN) { E.fused(acc, cur, wr, wc, fr, fq, lds, wid, lane); S.done(cur); }
#undef PG8_SA
#undef PG8_SB
#undef PG8_STAGE
#undef PG8_LDA
#undef PG8_LDB
#undef PG8_MMA
#undef PG8_WAIT_V
#undef PG8_WAIT_L
#undef PG8_BAR
#undef PG8_SCHED
}
}

namespace att {
typedef unsigned short bf16;
typedef short bf16x8 __attribute__((ext_vector_type(8)));
constexpr int D = 128, NW = 8, QBLK = 32, KVBLK = 64, QB = NW * QBLK;
constexpr int SHM_V = KVBLK * D * 2, SHM_K = KVBLK * D * 2;
constexpr int LDS_WS = 2 * SHM_V + 2 * SHM_K;
constexpr int LDS_F = LDS_WS + NW * 64 * 4;
constexpr int LDS_OST = LDS_F + 4096 * 4;
constexpr int LDS_BYTES = LDS_OST + NW * 32 * 64 * 4;
constexpr float SCALE = 0.08838834764831845f;
constexpr float THR = 8.f;

#define KSWZ(row, colB) ((row) * 256 + ((colB) ^ (((row) & 7) << 4)))
#define SBAR() __builtin_amdgcn_sched_barrier(0)
__device__ __forceinline__ int v_st(int k, int c) { const int kk = (k & ~0xC) | ((k & 4) << 1) | ((k & 8) >> 1); return ((kk >> 3) * 4 + (c >> 5)) * 512 + ((kk & 7) * 32 + (c & 31)) * 2; }
__device__ __forceinline__ int v_rd_base(int lane) { return ((lane & 3) << 3) | (((lane >> 2) & 3) << 6) | (((lane >> 4) & 1) << 5) | (((lane >> 5) & 1) << 8); }
constexpr int v_rd_off(int d0, int ks, int half) { return d0 * 512 + ks * 4096 + half * 2048; }
__device__ __forceinline__ int crow(int r, int hi) { return (r & 3) + 8 * (r >> 2) + 4 * hi; }
__device__ __forceinline__ unsigned cvtpk(float lo, float hi) { unsigned r; asm volatile("v_cvt_pk_bf16_f32 %0, %1, %2" : "=v"(r) : "v"(lo), "v"(hi)); return r; }
__device__ __forceinline__ bf16x8 load8(const bf16* p) { return *reinterpret_cast<const bf16x8*>(p); }
__device__ __forceinline__ void mask_tile(f32x16& p0, f32x16& p1, int dq, unsigned W) {
    const float NEG = -__builtin_inff();
#pragma unroll
    for (int r = 0; r < 16; ++r) {
        const int c = (r & 3) + 8 * (r >> 2);
        if ((unsigned)(dq - c) >= W) p0[r] = NEG;
        if ((unsigned)(dq - c - 32) >= W) p1[r] = NEG;
    }
}
__device__ __forceinline__ void partialSM(f32x16& p0, f32x16& p1, float& m_reg, float& mn, float& alpha) {
    float pmax = p0[0]; for (int r = 1; r < 16; ++r) pmax = fmaxf(pmax, p0[r]); for (int r = 0; r < 16; ++r) pmax = fmaxf(pmax, p1[r]);
    { auto rr = __builtin_amdgcn_permlane32_swap(__float_as_uint(pmax), __float_as_uint(pmax), false, false);
      pmax = fmaxf(__uint_as_float(rr[0]), __uint_as_float(rr[1])); }
    constexpr float C2 = 1.4426950408889634f * SCALE;
    if (__builtin_expect(__all((pmax - m_reg) * SCALE <= THR), 1)) { mn = m_reg; alpha = 1.f; }
    else { mn = fmaxf(m_reg, pmax); alpha = __builtin_amdgcn_exp2f((m_reg - mn) * C2); m_reg = mn; }
    const float mnL = -mn * C2;
    for (int r = 0; r < 16; ++r) p0[r] = fmaf(p0[r], C2, mnL); for (int r = 0; r < 16; ++r) p1[r] = fmaf(p1[r], C2, mnL);
    for (int r = 0; r < 16; ++r) p0[r] = __builtin_amdgcn_exp2f(p0[r]);
}
__device__ __forceinline__ void finishSM(f32x16& p0, f32x16& p1, float alpha, float& l_reg, bf16x8& pa0, bf16x8& pa1, bf16x8& pa2, bf16x8& pa3) {
    for (int r = 0; r < 16; ++r) p1[r] = __builtin_amdgcn_exp2f(p1[r]);
    float ps = 0; for (int r = 0; r < 16; ++r) ps += p0[r]; for (int r = 0; r < 16; ++r) ps += p1[r];
    { auto rr = __builtin_amdgcn_permlane32_swap(__float_as_uint(ps), __float_as_uint(ps), false, false);
      ps = __uint_as_float(rr[0]) + __uint_as_float(rr[1]); }
    l_reg = l_reg * alpha + ps;
#define PK4(P, B_, OUT) do { unsigned a0 = cvtpk(P[B_+0], P[B_+1]), a1 = cvtpk(P[B_+2], P[B_+3]);                          \
        unsigned b0 = cvtpk(P[B_+4], P[B_+5]), b1 = cvtpk(P[B_+6], P[B_+7]);                                             \
        auto r0 = __builtin_amdgcn_permlane32_swap(a0, b0, false, false); auto r1 = __builtin_amdgcn_permlane32_swap(a1, b1, false, false); \
        u32x4 w = {r0[0], r1[0], r0[1], r1[1]}; OUT = *reinterpret_cast<bf16x8*>(&w); } while (0)
    PK4(p0, 0, pa0); PK4(p0, 8, pa1); PK4(p1, 0, pa2); PK4(p1, 8, pa3);
#undef PK4
}
template <int KB, bool SK, bool FOX>
__device__ __forceinline__ void qkt(f32x16& p0, f32x16& p1, const LAS char* K_lds, int r32, int hi, const bf16x8* qr, bool act, const LAS float* fs  ) {
    if (SK && !act) { const float NEG = -__builtin_inff();
#pragma unroll
        for (int r = 0; r < 16; ++r) { p0[r] = NEG; p1[r] = NEG; } return; }
    if constexpr (FOX) {
#pragma unroll
        for (int g = 0; g < 4; ++g) { const f32x4 a = *(const LAS f32x4*)(fs + 8 * g), b = *(const LAS f32x4*)(fs + 32 + 8 * g);
            p0[4 * g] = a[0]; p0[4 * g + 1] = a[1]; p0[4 * g + 2] = a[2]; p0[4 * g + 3] = a[3];
            p1[4 * g] = b[0]; p1[4 * g + 1] = b[1]; p1[4 * g + 2] = b[2]; p1[4 * g + 3] = b[3]; }
    } else { p0 = f32x16{}; p1 = f32x16{}; }
    const LAS char* kb[4];
#pragma unroll
    for (int dd = 0; dd < 4; ++dd) kb[dd] = K_lds + KB * SHM_K + KSWZ(r32, (dd * 16 + hi * 8) * 2);
#pragma unroll
    for (int d0 = 0; d0 < 8; ++d0) { const LAS char* a = kb[d0 & 3] + (d0 >> 2) * 128;
        bf16x8 b0 = *(const LAS bf16x8*)(a);
        bf16x8 b1 = *(const LAS bf16x8*)(a + 32 * 256);
        p0 = __builtin_amdgcn_mfma_f32_32x32x16_bf16(b0, qr[d0], p0, 0, 0, 0);
        p1 = __builtin_amdgcn_mfma_f32_32x32x16_bf16(b1, qr[d0], p1, 0, 0, 0); }
}
template <int VB, bool SK>
__device__ __forceinline__ void pv_tile(f32x16* o, int vb0, bf16x8 pa0, bf16x8 pa1, bf16x8 pa2, bf16x8 pa3, bool act) {
    if (SK && !act) return;
#define TRRD(dst, off) asm volatile("ds_read_b64_tr_b16 %0, %1 offset:%2" : "=&v"(dst) : "v"(vb0), "i"(off) : "memory")
#define PV_D0(d0) do { s16x4 l0, l1, l2, l3, h0, h1, h2, h3; constexpr int b_ = VB * SHM_V + v_rd_off(d0, 0, 0);   \
        TRRD(l0, b_); TRRD(h0, b_ + 2048); TRRD(l1, b_ + 4096); TRRD(h1, b_ + 6144); TRRD(l2, b_ + 8192); TRRD(h2, b_ + 10240); TRRD(l3, b_ + 12288); TRRD(h3, b_ + 14336); \
        asm volatile("s_waitcnt lgkmcnt(0)" ::: "memory"); SBAR();   \
        o[d0] = __builtin_amdgcn_mfma_f32_32x32x16_bf16(pa0, (bf16x8){l0[0], l0[1], l0[2], l0[3], h0[0], h0[1], h0[2], h0[3]}, o[d0], 0, 0, 0);   \
        o[d0] = __builtin_amdgcn_mfma_f32_32x32x16_bf16(pa1, (bf16x8){l1[0], l1[1], l1[2], l1[3], h1[0], h1[1], h1[2], h1[3]}, o[d0], 0, 0, 0);   \
        o[d0] = __builtin_amdgcn_mfma_f32_32x32x16_bf16(pa2, (bf16x8){l2[0], l2[1], l2[2], l2[3], h2[0], h2[1], h2[2], h2[3]}, o[d0], 0, 0, 0);   \
        o[d0] = __builtin_amdgcn_mfma_f32_32x32x16_bf16(pa3, (bf16x8){l3[0], l3[1], l3[2], l3[3], h3[0], h3[1], h3[2], h3[3]}, o[d0], 0, 0, 0); } while (0)
    PV_D0(0); PV_D0(1); PV_D0(2); PV_D0(3);
#undef PV_D0
#undef TRRD
}

template <size_t OQ, size_t OK, size_t OV, size_t OZ, size_t OO> struct Bases { const unsigned char* ws;
    __device__ __forceinline__ const bf16* Q() const { return (const bf16*)(ws + OQ); } __device__ __forceinline__ const bf16* K() const { return (const bf16*)(ws + OK); }
    __device__ __forceinline__ const bf16* V() const { return (const bf16*)(ws + OV); } __device__ __forceinline__ const bf16* Z() const { return (const bf16*)(ws + OZ); }
    __device__ __forceinline__ bf16* O() const { return (bf16*)(ws + OO); } };
struct BlockRef { unsigned qoff; unsigned kvoff; int P0; int jlo; const float* sinks; float qk; };
struct Seam { bf16x8 qr[8]; bf16x8 st_v0, st_v1, st_k0, st_k1; };
__device__ __forceinline__ int swa_jlo(int P0, int W) { const int lowk = P0 - W + 1; return lowk > 0 ? lowk / KVBLK : 0; }
#define UROW(p, k0) ((const char*)(p) + (size_t)((k0) + wid * 4) * (LDKV * 2))
#define VMW() asm volatile("s_waitcnt vmcnt(0)" ::: "memory")
#define VMWN(n) asm volatile("s_waitcnt vmcnt(%0)" :: "i"(n) : "memory")
#define SLOAD_H(Kp, Vp, k0) do { const char* vu_ = UROW(Vp, k0); const char* ku_ = UROW(Kp, k0);                                   \
                         S.st_v0 = *(const bf16x8*)(vu_ + kvlane); S.st_v1 = *(const bf16x8*)(vu_ + 32 * LDKV * 2 + kvlane);              \
                         S.st_k0 = *(const bf16x8*)(ku_ + kvlane); S.st_k1 = *(const bf16x8*)(ku_ + 32 * LDKV * 2 + kvlane); } while (0)
#define SWRITE_HK(bf) do { *(LAS bf16x8*)(K_lds + (bf) * SHM_K + kws) = S.st_k0; *(LAS bf16x8*)(K_lds + (bf) * SHM_K + kws + 32 * 256) = S.st_k1; } while (0)
#define SWRITE_HV(bf) do { *(LAS bf16x8*)(V_lds + (bf) * SHM_V + vst0) = S.st_v0; *(LAS bf16x8*)(V_lds + (bf) * SHM_V + vst1) = S.st_v1; } while (0)
#define SWRITE_H(bf) do { SWRITE_HV(bf); SWRITE_HK(bf); } while (0)
template <bool FOX, int LDQ, int LDKV, class BasesT>
__device__ __forceinline__ void attn_prime(const BasesT& T, const BlockRef& cur, int W, LAS char* lds, Seam& S) {
    const int tid = threadIdx.x, wid = __builtin_amdgcn_readfirstlane(tid >> 6), lane = tid & 63, r32 = lane & 31, hi = lane >> 5;
    const int sr = tid >> 4, sc = (tid & 15) * 8, kws = KSWZ(sr, sc * 2); LAS char* K_lds = lds + 2 * SHM_V;
    const unsigned kvlane = (unsigned)((lane >> 4) * LDKV + sc) * 2u, qlane = (unsigned)(r32 * LDQ + hi * 8) * 2u;
    const int kb0 = FOX ? ((cur.P0 + QB - 1) / KVBLK) * KVBLK : swa_jlo(cur.P0, W) * KVBLK;
    { const char* qu = (const char*)(T.Q() + cur.qoff) + (size_t)wid * (FOX ? QBLK * LDQ * 2 : D * 2);
      for (int d0 = 0; d0 < 8; ++d0) S.qr[d0] = *(const bf16x8*)(qu + d0 * 32 + qlane); }
    SLOAD_H(T.K() + cur.kvoff, T.V() + cur.kvoff, kb0); VMW(); SWRITE_HK(0);
    __syncthreads();
}
template <bool FOX, int LDQ, int LDKV, int LDO, class BasesT>
__device__ __forceinline__ void attn_block(const BasesT& T, const BlockRef& cur, const BlockRef& nxt, int skv, int W, LAS char* lds, Seam& S) {
    constexpr bool SK = WSKIP_ON && !FOX;
    const int tid = threadIdx.x, wid = __builtin_amdgcn_readfirstlane(tid >> 6), lane = tid & 63, r32 = lane & 31, hi = lane >> 5;
    const int j_lo = FOX ? cur.jlo : swa_jlo(cur.P0, W);
    int j_hi = (cur.P0 + (FOX ? QB : QBLK) - 1) / KVBLK + 1; if (j_hi > skv / KVBLK) j_hi = skv / KVBLK;
    int NT = j_hi - j_lo;
    const int kbn = FOX ? ((nxt.P0 + QB - 1) / KVBLK) * KVBLK : swa_jlo(nxt.P0, W) * KVBLK;
    const int qlo = cur.P0 + (FOX ? wid * QBLK : 0), qm = qlo + r32 - 4 * hi;
    LAS char* V_lds = lds; LAS char* K_lds = lds + 2 * SHM_V;
    LAS float* ws = (LAS float*)(lds + LDS_WS) + wid * 64; LAS float* li_l = ws; LAS float* al_l = ws + 32;
    const LAS float* Fs = (const LAS float*)(lds + LDS_F) + 4 * hi;
    float m_reg = -1e30f, l_reg = 0; f32x16 o[4] = {};
    const int sr = tid >> 4, sc = (tid & 15) * 8, vst0 = v_st(sr, sc), vst1 = v_st(32 + sr, sc), kws = KSWZ(sr, sc * 2);
    const unsigned kvlane = (unsigned)((lane >> 4) * LDKV + sc) * 2u, qlane = (unsigned)(r32 * LDQ + hi * 8) * 2u;
    const int vb0 = (int)(uintptr_t)V_lds + v_rd_base(lane);
    const unsigned kvo = cur.kvoff;
#define Kh (T.K() + kvo)
#define Vh (T.V() + kvo)
#define RESC(a) do { if (__any((a) < 1.f)) { if (hi == 0) al_l[r32] = (a); asm volatile("s_waitcnt lgkmcnt(0)" ::: "memory");              \
                     for (int d_ = 0; d_ < 4; ++d_) for (int r = 0; r < 16; ++r) o[d_][r] *= al_l[crow(r, hi)]; } } while (0)
#define KBASE(t) ((FOX ? (j_hi - 1 - (t)) : (j_lo + (t))) * KVBLK)
#define ACT(t) (KBASE(t) <= qlo + QBLK - 1 && KBASE(t) + KVBLK - 1 >= qlo - W + 1)
#define MASKT(P0_, P1_, t) do { const int kb_ = KBASE(t); if ((!SK || ACT(t)) && (kb_ + KVBLK - 1 > qlo || kb_ <= qlo + QBLK - 1 - W)) mask_tile(P0_, P1_, qm - kb_, (unsigned)W); } while (0)
    constexpr int NQL = 8;
#define SEAM_K0() do { VMWN(NQL); SWRITE_HK(0); SBAR(); } while (0)
    f32x16 pA0, pA1, pB0, pB1; float mnA, mnB, alA, alB; bf16x8 pa0, pa1, pa2, pa3;
    SWRITE_HV(0); SBAR();
    if (NT > 1) { SLOAD_H(Kh, Vh, KBASE(1)); }
    SBAR(); qkt<0, SK, FOX>(pA0, pA1, K_lds, r32, hi, S.qr, ACT(0), Fs + KBASE(0));
    MASKT(pA0, pA1, 0); partialSM(pA0, pA1, m_reg, mnA, alA);
    if (NT > 1) { VMW(); SWRITE_H(1); }
    __syncthreads();
#define HALF_STEP(PX0, PX1, mnX, alX, PY0, PY1, alY, t, KB, VB, SB) do {                                                      \
        SBAR(); qkt<KB, SK, FOX>(PX0, PX1, K_lds, r32, hi, S.qr, ACT(t), Fs + KBASE(t));                                     \
        finishSM(PY0, PY1, alY, l_reg, pa0, pa1, pa2, pa3); SBAR();                                                           \
        if ((t) + 1 < NT) { SLOAD_H(Kh, Vh, KBASE((t) + 1)); SBAR(); }                                                        \
        pv_tile<VB, SK>(o, vb0, pa0, pa1, pa2, pa3, ACT((t) - 1)); MASKT(PX0, PX1, (t)); partialSM(PX0, PX1, m_reg, mnX, alX);  \
        __syncthreads();                                                                                                      \
        if ((t) + 1 < NT) { VMW(); SWRITE_H(SB); }                                                                            \
        RESC(alX); __syncthreads(); } while (0)
    for (int t = 1; t + 1 < NT; t += 2) {
        HALF_STEP(pB0, pB1, mnB, alB, pA0, pA1, alA, t, 1, 0, 0);
        HALF_STEP(pA0, pA1, mnA, alA, pB0, pB1, alB, t + 1, 0, 1, 1);
        if constexpr (FOX) { if (t == 3 && NT > 6) {
            float mw = m_reg;
#pragma unroll
            for (int o_ = 1; o_ < 32; o_ <<= 1) mw = fminf(mw, __shfl_xor(mw, o_));
            if (lane == 0) li_l[0] = mw;
            asm volatile("s_waitcnt lgkmcnt(0)" ::: "memory"); __syncthreads();
            const LAS float* slot = (const LAS float*)(lds + LDS_WS); float mb = slot[0];
#pragma unroll
            for (int w_ = 1; w_ < NW; ++w_) mb = fminf(mb, slot[w_ * 64]);
            const LAS float* Fb = (const LAS float*)(lds + LDS_F);
            const unsigned long long alive = __ballot(Fb[64 * lane + 63] + cur.qk > mb - (40.0f / (1.4426950408889634f * SCALE) + 16.0f));
            int jd = alive ? (int)__builtin_ctzll(alive) : 63; if (jd < j_lo) jd = j_lo;
            int nt2 = j_hi - jd; if (nt2 < 6) nt2 = 6;
            if (nt2 < NT) NT = nt2;
        } }
    }
    const bool even = (NT & 1) == 0;
    if (even) { SBAR(); qkt<1, SK, FOX>(pB0, pB1, K_lds, r32, hi, S.qr, ACT(NT - 1), Fs + KBASE(NT - 1)); SBAR(); }
    SLOAD_H(T.K() + nxt.kvoff, T.V() + nxt.kvoff, kbn); SBAR();
    { const char* qu = (const char*)(T.Q() + nxt.qoff) + (size_t)wid * (FOX ? QBLK * LDQ * 2 : D * 2);
#pragma unroll
      for (int d0 = 0; d0 < 8; ++d0) S.qr[d0] = *(const bf16x8*)(qu + d0 * 32 + qlane); }
    SBAR();
    finishSM(pA0, pA1, alA, l_reg, pa0, pa1, pa2, pa3); SBAR();
    pv_tile<0, SK>(o, vb0, pa0, pa1, pa2, pa3, ACT(even ? NT - 2 : NT - 1));
    if (even) { MASKT(pB0, pB1, NT - 1); partialSM(pB0, pB1, m_reg, mnB, alB); __syncthreads(); RESC(alB);
        finishSM(pB0, pB1, alB, l_reg, pa0, pa1, pa2, pa3); SBAR(); pv_tile<1, SK>(o, vb0, pa0, pa1, pa2, pa3, ACT(NT - 1)); }
    SBAR(); SEAM_K0();
    const int c8 = lane & 7, rr = lane >> 3;
    u32x4 zq[2][4];
    { const char* Zu = (const char*)(T.Z() + cur.qoff) + (size_t)wid * (FOX ? QBLK * LDO * 2 : D * 2) + (unsigned)(rr * LDO + c8 * 8) * 2u;
#pragma unroll
      for (int h2 = 0; h2 < 2; ++h2)
#pragma unroll
          for (int j = 0; j < 4; ++j) zq[h2][j] = *(const u32x4*)(Zu + j * (8 * LDO * 2) + h2 * 128); }
    if constexpr (!FOX) l_reg += __builtin_amdgcn_exp2f(cur.sinks[wid] * 1.4426950408889634f - m_reg * (1.4426950408889634f * SCALE));
    if (hi == 0) li_l[r32] = l_reg; asm volatile("s_waitcnt lgkmcnt(0)" ::: "memory");
    float rli[16];
#pragma unroll
    for (int r = 0; r < 16; ++r) rli[r] = __builtin_amdgcn_rcpf(li_l[crow(r, hi)]);
    LAS float* ost = (LAS float*)(lds + LDS_OST) + wid * (32 * 64);
    char* Ou = (char*)(T.O() + cur.qoff) + (size_t)wid * (FOX ? QBLK * LDO * 2 : D * 2) + (unsigned)(rr * LDO + c8 * 8) * 2u;
#pragma unroll
    for (int h2 = 0; h2 < 2; ++h2) {
#pragma unroll
        for (int r = 0; r < 16; ++r) { const int row = crow(r, hi); ost[row * 64 + r32] = o[2 * h2][r] * rli[r]; ost[row * 64 + 32 + r32] = o[2 * h2 + 1][r] * rli[r]; }
        asm volatile("s_waitcnt lgkmcnt(0)" ::: "memory");
#pragma unroll
        for (int j = 0; j < 4; ++j) { const LAS float* sp = ost + (rr + 8 * j) * 64 + c8 * 8; const f32x4 a = *(const LAS f32x4*)sp, bq = *(const LAS f32x4*)(sp + 4); const u32x4 z = zq[h2][j];
            u32x4 w; w.x = cvtpk(a[0] * __uint_as_float(z.x << 16), a[1] * __uint_as_float(z.x & 0xffff0000u)); w.y = cvtpk(a[2] * __uint_as_float(z.y << 16), a[3] * __uint_as_float(z.y & 0xffff0000u));
            w.z = cvtpk(bq[0] * __uint_as_float(z.z << 16), bq[1] * __uint_as_float(z.z & 0xffff0000u)); w.w = cvtpk(bq[2] * __uint_as_float(z.w << 16), bq[3] * __uint_as_float(z.w & 0xffff0000u));
            *(u32x4*)(Ou + j * (8 * LDO * 2) + h2 * 128) = w; }
        asm volatile("s_waitcnt lgkmcnt(0)" ::: "memory");
    }
    __syncthreads();
#undef Kh
#undef Vh
#undef RESC
#undef KBASE
#undef ACT
#undef MASKT
#undef SEAM_K0
#undef HALF_STEP
}
#undef UROW
#undef VMW
#undef VMWN
#undef SLOAD_H
#undef SWRITE_HK
#undef SWRITE_HV
#undef SWRITE_H
#undef SBAR
#undef KSWZ
}

#define XB_TMO      128
#define XB_XCNT(j)  (256  + 64 * (j))
#define XB_XSUB(j)  (1280 + 64 * (j))
#define XB_XGEN(j)  (2304 + 64 * (j))
#define XB_TOP      3328
#define XB_TOPGEN   3392
#define XCD_BAR_WORDS 3456
#define XB_SPIN_CAP (1u << 18)

__device__ __forceinline__ unsigned xb_ld(unsigned* p)              { return __hip_atomic_load(p, __ATOMIC_RELAXED, __HIP_MEMORY_SCOPE_AGENT); }
__device__ __forceinline__ unsigned xb_add(unsigned* p, unsigned v) { return __hip_atomic_fetch_add(p, v, __ATOMIC_RELAXED, __HIP_MEMORY_SCOPE_AGENT); }
__device__ __forceinline__ unsigned xb_xcc_id() { return (unsigned)__builtin_amdgcn_s_getreg((3 << 11) | 20) & 0xFu; }
#define XB_SPIN(cond, bar) do { unsigned _sp = 0; while (cond) { __builtin_amdgcn_s_sleep(1); \
    if ((++_sp & 255u) == 0u) { if (xb_ld(&(bar)[XB_TMO])) break; if (_sp > XB_SPIN_CAP) { atomicAdd(&(bar)[XB_TMO], 1u); break; } } } } while (0)

struct XcdBarrier {
    unsigned* bar; unsigned x;
    volatile LAS unsigned* st;
};

__device__ __forceinline__ XcdBarrier xcd_barrier_post(unsigned* bar, volatile LAS unsigned* st) {
    XcdBarrier b; b.bar = bar; b.x = xb_xcc_id(); b.st = st;
    if (threadIdx.x == 0) (void)xb_add(&bar[XB_XCNT(b.x)], 1u);
    return b;
}
__device__ __forceinline__ void xcd_barrier_complete(unsigned* bar, unsigned x, unsigned& nloc, unsigned& nx) {
    const unsigned G = gridDim.x * gridDim.y * gridDim.z;
    unsigned sum, cnt, mine, sp = 0u;
    for (;;) {
        sum = 0u; cnt = 0u; mine = 0u;
#pragma unroll
        for (unsigned j = 0; j < 16; ++j) { const unsigned c = xb_ld(&bar[XB_XCNT(j)]); sum += c; cnt += (c > 0u) ? 1u : 0u; mine = (j == x) ? c : mine; }
        if (sum == G) break;
        __builtin_amdgcn_s_sleep(1);
        if ((++sp & 255u) == 0u) { if (xb_ld(&bar[XB_TMO])) break; if (sp > XB_SPIN_CAP) { atomicAdd(&bar[XB_TMO], 1u); break; } }
    }
    nloc = mine > 0u ? mine : 1u; nx = cnt > 0u ? cnt : 1u;
}

__device__ __forceinline__ void xcd_barrier(const XcdBarrier& b) {
    asm volatile("s_waitcnt vmcnt(0)" ::: "memory");
    __syncthreads();
    if (threadIdx.x == 0) {
        unsigned* bar = b.bar;
        __builtin_amdgcn_s_waitcnt(0);
        unsigned nloc = b.st[0], nx = b.st[1];
        if (nloc == 0u) { xcd_barrier_complete(bar, b.x, nloc, nx); b.st[0] = nloc; b.st[1] = nx; }
        const unsigned old = xb_add(&bar[XB_XSUB(b.x)], 1u);
        const unsigned gen = old / nloc;
        if (old + 1u == (gen + 1u) * nloc) {
            __builtin_amdgcn_fence(__ATOMIC_RELEASE, "agent");
            asm volatile("s_waitcnt vmcnt(0)" ::: "memory");
            const unsigned og = xb_add(&bar[XB_TOP], 1u);
            const unsigned tg = og / nx;
            if (og + 1u == (tg + 1u) * nx) xb_add(&bar[XB_TOPGEN], 1u);
            else XB_SPIN(xb_ld(&bar[XB_TOPGEN]) == tg, bar);
            __builtin_amdgcn_fence(__ATOMIC_ACQUIRE, "agent");
            xb_add(&bar[XB_XGEN(b.x)], 1u);
            asm volatile("s_waitcnt vmcnt(0)" ::: "memory");
        } else {
            XB_SPIN(xb_ld(&bar[XB_XGEN(b.x)]) == gen, bar);
            __builtin_amdgcn_fence(__ATOMIC_ACQUIRE, "agent");
            asm volatile("s_waitcnt vmcnt(0)" ::: "memory");
        }
    }
    __syncthreads();
}


constexpr size_t MiB = 1u << 20;
constexpr size_t WS_CTL = 0, CTL_ZERO_BYTES = 1 * MiB;
constexpr size_t WS_SLAB = 1 * MiB;
constexpr size_t WS_MOD = 3 * MiB;
constexpr size_t WS_ROPE = 4 * MiB;
constexpr size_t WS_LOGF = 6 * MiB;
constexpr size_t WS_WFT = 7 * MiB;
constexpr size_t WS_W1T = 8 * MiB;
constexpr size_t WS_W2T = 136 * MiB;
constexpr size_t WS_W3T = 168 * MiB;
constexpr size_t WS_WKVT = 232 * MiB;
constexpr size_t WS_W4T = 240 * MiB;
constexpr size_t WS_HB = 272 * MiB;
constexpr size_t WS_KVN = 336 * MiB;
constexpr size_t WS_Q = 400 * MiB, WS_K = 464 * MiB, WS_V = 528 * MiB, WS_Z = 592 * MiB;
constexpr size_t WS_OG = 656 * MiB;
constexpr size_t WS_H1 = 720 * MiB;
constexpr size_t WS_KV1 = 848 * MiB;
constexpr size_t WS_FDBG = 864 * MiB;
constexpr size_t WS_END = 866 * MiB;
constexpr int CW_BAR = 4096;
constexpr int CW_QUEUE = 8192;
constexpr int CW_NORM = 8448;

constexpr int LDS_BYTES = 155648;
constexpr int MISC_OFF = LDS_BYTES - 256;
constexpr int NWAVES = 8, NTHR = 512;
static_assert(att::LDS_BYTES <= MISC_OFF && 131072 <= MISC_OFF, "LDS map");

struct Params { const float* in[14]; float* out; unsigned char* ws; int ph_lo, ph_hi; };
enum { I_X = 0, I_C, I_NORMG, I_ADAW, I_ADAB, I_AWIN, I_ABF, I_AWOUT, I_KVG, I_KVW, I_BWIN, I_SINK, I_BWOUT, I_FING };

struct Frame { LAS unsigned char* lds; int tid, lane, wave, vcu, G; };

__device__ __forceinline__ float wave_sum(float v) {
#pragma unroll
    for (int o = 1; o < 64; o <<= 1) v += __shfl_xor(v, o);
    return v;
}
__device__ __forceinline__ unsigned f2bf(float f) { unsigned u = __builtin_bit_cast(unsigned, f); return (u + 0x7fffu + ((u >> 16) & 1u)) >> 16; }
__device__ __forceinline__ unsigned pk2(float lo, float hi) { return f2bf(lo) | (f2bf(hi) << 16); }
__device__ __forceinline__ float bf2f(unsigned short b) { return __uint_as_float((unsigned)b << 16); }

#if defined(TR128)
template <class RowMap>
__device__ __forceinline__ void transpose_item(const float* W, int ldw, int K, int k0, int c0, bf16_t* WT, RowMap rowmap, LAS float* scr, int lane) {
    const int kk = lane >> 3, nn = (lane & 7) * 4;
    f32x4 v[16];
#pragma unroll
    for (int i = 0; i < 16; ++i) v[i] = *(const GAS f32x4*)(W + (size_t)(k0 + 8 * i + kk) * ldw + c0 + nn);
#pragma unroll
    for (int i = 0; i < 16; ++i) { LAS float* s = scr + (8 * i + kk) * 33 + nn; s[0] = v[i][0]; s[1] = v[i][1]; s[2] = v[i][2]; s[3] = v[i][3]; }
    asm volatile("s_waitcnt lgkmcnt(0)" ::: "memory");
    const int c = lane & 15, nr = lane >> 4;
#pragma unroll
    for (int j = 0; j < 8; ++j) { const int n = nr + 4 * j; const LAS float* s = scr + (8 * c) * 33 + n;
        u32x4 o; o.x = pk2(s[0 * 33], s[1 * 33]); o.y = pk2(s[2 * 33], s[3 * 33]); o.z = pk2(s[4 * 33], s[5 * 33]); o.w = pk2(s[6 * 33], s[7 * 33]);
        *(GAS u32x4*)(WT + (size_t)rowmap(c0 + n) * K + k0 + 8 * c) = o; }
    asm volatile("s_waitcnt lgkmcnt(0)" ::: "memory");
}
#define TR_KB 128
#define TR_NB 32
#define TR_SCR (128 * 33)
#else
template <class RowMap>
__device__ __forceinline__ void transpose_item(const float* W, int ldw, int K, int k0, int c0, bf16_t* WT, RowMap rowmap, LAS float* scr, int lane) {
    const int kk = lane >> 4, nn = (lane & 15) * 4;
    f32x4 v[16];
#pragma unroll
    for (int i = 0; i < 16; ++i) v[i] = *(const GAS f32x4*)(W + (size_t)(k0 + 4 * i + kk) * ldw + c0 + nn);
#pragma unroll
    for (int i = 0; i < 16; ++i) { LAS float* s = scr + (4 * i + kk) * 65 + nn; s[0] = v[i][0]; s[1] = v[i][1]; s[2] = v[i][2]; s[3] = v[i][3]; }
    asm volatile("s_waitcnt lgkmcnt(0)" ::: "memory");
    const int c = lane & 7, nr = lane >> 3;
#pragma unroll
    for (int j = 0; j < 8; ++j) { const int n = nr + 8 * j; const LAS float* s = scr + (8 * c) * 65 + n;
        u32x4 o; o.x = pk2(s[0 * 65], s[1 * 65]); o.y = pk2(s[2 * 65], s[3 * 65]); o.z = pk2(s[4 * 65], s[5 * 65]); o.w = pk2(s[6 * 65], s[7 * 65]);
        *(GAS u32x4*)(WT + (size_t)rowmap(c0 + n) * K + k0 + 8 * c) = o; }
    asm volatile("s_waitcnt lgkmcnt(0)" ::: "memory");
}
#define TR_KB 64
#define TR_NB 64
#define TR_SCR (64 * 65)
#endif
struct RowId { __device__ __forceinline__ int operator()(int c) const { return c; } };
struct RowRope { int lim; __device__ __forceinline__ int operator()(int c) const { if (c >= lim) return c; const int j = c & 127, jj = j & 63; return (c & ~127) + 8 * (jj >> 2) + ((j >> 6) << 2) + (jj & 3); } };

__device__ __forceinline__ void p0_prologue(const Frame& F, const Params& P) {
    unsigned char* ws = P.ws;
#ifndef P0A_REP
#define P0A_REP 1
#endif
    _Pragma("unroll 1") for (int repa_ = 0; repa_ < P0A_REP; ++repa_)
    {
        LAS float* sc = (LAS float*)F.lds;
        LAS float* red = (LAS float*)(F.lds + 32768);
        const float* c = P.in[I_C];
        for (int i = F.tid; i < 2 * DM; i += NTHR) { const float v = c[i]; sc[i] = v / (1.0f + __expf(-v)); }
        __syncthreads();
        float* slab = (float*)(ws + WS_SLAB);
        for (int t = F.vcu; t < 768; t += F.G) {
            const int cg = t % 96, ks = t / 96, l = cg / 48, n0 = (cg % 48) * 256;
            const float* Wp = P.in[I_ADAW] + (size_t)l * DM * MOD + (size_t)(ks * 512 + F.wave * 64) * MOD + n0 + 4 * F.lane;
            const LAS float* s0 = sc + ks * 512 + F.wave * 64; const LAS float* s1 = s0 + DM;
            f32x4 a0 = (f32x4){0.f, 0.f, 0.f, 0.f}, a1 = a0;
#pragma unroll 16
            for (int kk = 0; kk < 64; ++kk) { const f32x4 w = *(const GAS f32x4*)(Wp + (size_t)kk * MOD); a0 += w * s0[kk]; a1 += w * s1[kk]; }
            *(LAS f32x4*)(red + (F.wave * 2 + 0) * 256 + 4 * F.lane) = a0; *(LAS f32x4*)(red + (F.wave * 2 + 1) * 256 + 4 * F.lane) = a1;
            __syncthreads();
            { const int b = F.tid >> 8, col = F.tid & 255; float s = 0.f;
#pragma unroll
              for (int w = 0; w < 8; ++w) s += red[(w * 2 + b) * 256 + col];
              slab[(size_t)((ks * 2 + l) * 2 + b) * MOD + n0 + col] = s; }
            __syncthreads();
        }
    }
    {
        LAS float* scr = (LAS float*)F.lds + F.wave * TR_SCR;
        const int gw = F.vcu * NWAVES + F.wave, NGW = F.G * NWAVES;
        constexpr int KBL = DM / TR_KB;
        constexpr int I1 = KBL * (N1 / TR_NB), I2 = KBL * (DM / TR_NB), IKV = KBL * (NKV2 / TR_NB), I3 = KBL * (N3 / TR_NB), I4 = I2;
        constexpr int NIT = I1 + I2 + IKV + I3 + I4;
        for (int it = gw; it < NIT; it += NGW) {
            int r = it;
            if (r < I2) { transpose_item(P.in[I_AWOUT], DM, DM, (r % KBL) * TR_KB, (r / KBL) * TR_NB, (bf16_t*)(ws + WS_W2T), RowId{}, scr, F.lane); continue; } r -= I2;
            if (r < IKV) { transpose_item(P.in[I_KVW], NKV2, DM, (r % KBL) * TR_KB, (r / KBL) * TR_NB, (bf16_t*)(ws + WS_WKVT), RowRope{KVW}, scr, F.lane); continue; } r -= IKV;
            if (r < I3) { transpose_item(P.in[I_BWIN], N3, DM, (r % KBL) * TR_KB, (r / KBL) * TR_NB, (bf16_t*)(ws + WS_W3T), RowRope{DM}, scr, F.lane); continue; } r -= I3;
            if (r < I4) { transpose_item(P.in[I_BWOUT], DM, DM, (r % KBL) * TR_KB, (r / KBL) * TR_NB, (bf16_t*)(ws + WS_W4T), RowId{}, scr, F.lane); continue; } r -= I4;
            transpose_item(P.in[I_AWIN], N1F, DM, (r % KBL) * TR_KB, (r / KBL) * TR_NB, (bf16_t*)(ws + WS_W1T), RowId{}, scr, F.lane);
        }
    }
    {
        const int gt = F.vcu * NTHR + F.tid, NGT = F.G * NTHR;
        bf16_t* wft = (bf16_t*)(ws + WS_WFT); const float* W = P.in[I_AWIN];
        for (int i = gt; i < NH * DM; i += NGT) { const int k = i >> 5, n = i & 31; wft[(size_t)n * DM + k] = (bf16_t)f2bf(W[(size_t)k * N1F + N1 + n]); }
        float* cs = (float*)(ws + WS_ROPE); float* sn = cs + SEQ * 64;
        for (int i = gt; i < SEQ * 64; i += NGT) {
            const int pos = i >> 6, j = i & 63;
            double th = 1.0; for (int q = 0; q < j; ++q) th *= 0.8659643233600653523531691834202299819398;
            const double t2 = th * th; double cc = 1.0, ss = th, tc = 1.0, ts = th;
#pragma unroll
            for (int q = 1; q <= 11; ++q) { tc *= t2 * (-1.0 / (double)((2 * q - 1) * (2 * q))); ts *= t2 * (-1.0 / (double)((2 * q) * (2 * q + 1))); cc += tc; ss += ts; }
            double rc = 1.0, rs = 0.0;
            for (int mbit = 0; mbit < 12; ++mbit) {
                if ((pos >> mbit) & 1) { const double nc = rc * cc - rs * ss, ns = rs * cc + rc * ss; rc = nc; rs = ns; }
                const double c2 = cc * cc - ss * ss, s2 = 2.0 * ss * cc; cc = c2; ss = s2;
            }
            cs[i] = (float)rc; sn[i] = (float)rs;
        }
    }
}

__device__ __forceinline__ void p1_norm0(const Frame& F, const Params& P) {
    unsigned char* ws = P.ws;
    const float* slab = (const float*)(ws + WS_SLAB); float* mod = (float*)(ws + WS_MOD);
    for (int i = F.vcu * NTHR + F.tid; i < 2 * 2 * MOD; i += F.G * NTHR) {
        const int n = i % MOD, lb = i / MOD, l = lb >> 1; float s = P.in[I_ADAB][l * MOD + n];
#pragma unroll
        for (int ks = 0; ks < 8; ++ks) s += slab[(size_t)(ks * 4 + lb) * MOD + n];
        mod[i] = s;
    }
    LAS float* gs = (LAS float*)F.lds; LAS float* sh = gs + DM;
    LAS float* red = sh + DM;
    bf16_t* h0 = (bf16_t*)(ws + WS_HB); const bf16_t* wft = (const bf16_t*)(ws + WS_WFT); float* logf = (float*)(ws + WS_LOGF);
    for (int rb = F.vcu; rb < M / 32; rb += F.G) {
        const int row0 = rb * 32, b = row0 / SEQ;
        __syncthreads();
        for (int k = F.tid; k < DM; k += NTHR) {
            float s_sh = P.in[I_ADAB][k], s_sc = P.in[I_ADAB][DM + k];
#pragma unroll
            for (int ks = 0; ks < 8; ++ks) { const float* sl = slab + (size_t)(ks * 4 + b) * MOD; s_sh += sl[k]; s_sc += sl[DM + k]; }
            gs[k] = P.in[I_NORMG][k] * (1.0f + s_sc); sh[k] = s_sh;
        }
        __syncthreads();
#pragma unroll 1
        for (int rr = 0; rr < 4; ++rr) {
            const int row = row0 + F.wave * 4 + rr;
            const GAS f32x4* xr = (const GAS f32x4*)(P.in[I_X] + (size_t)row * DM) + F.lane;
            f32x4 v[16]; float ss = 0.f;
#pragma unroll
            for (int j = 0; j < 16; ++j) { v[j] = __builtin_nontemporal_load(xr + 64 * j); ss += (v[j].x * v[j].x + v[j].y * v[j].y) + (v[j].z * v[j].z + v[j].w * v[j].w); }
            const float rstd = 1.0f / sqrtf(wave_sum(ss) * (1.0f / DM) + EPS);
            GAS u32x2* o8 = (GAS u32x2*)(h0 + (size_t)row * DM) + F.lane;
#pragma unroll
            for (int j = 0; j < 16; ++j) { const f32x4 g = *(const LAS f32x4*)(gs + 256 * j + 4 * F.lane), s = *(const LAS f32x4*)(sh + 256 * j + 4 * F.lane);
                const f32x4 y = v[j] * rstd * g + s; u32x2 w; w.x = pk2(y.x, y.y); w.y = pk2(y.z, y.w); o8[64 * j] = w; }
        }
        asm volatile("s_waitcnt vmcnt(0)" ::: "memory");
        __syncthreads();
        {
            const int r = F.lane & 31, hh = F.lane >> 5;
            const bf16_t* ap = wft + (size_t)r * DM + F.wave * 512 + 8 * hh;
            const bf16_t* bp = h0 + (size_t)(row0 + r) * DM + F.wave * 512 + 8 * hh;
            f32x16 acc = {};
#pragma unroll 8
            for (int k = 0; k < 512; k += 16) { const bf16x8 a = *(const GAS bf16x8*)(ap + k), bb = *(const GAS bf16x8*)(bp + k); acc = __builtin_amdgcn_mfma_f32_32x32x16_bf16(a, bb, acc, 0, 0, 0); }
#pragma unroll
            for (int q = 0; q < 16; ++q) red[(F.wave * 16 + q) * 64 + F.lane] = acc[q];
            __syncthreads();
#pragma unroll
            for (int qq = 0; qq < 2; ++qq) { const int q = 2 * F.wave + qq; float s = 0.f;
#pragma unroll
                for (int w = 0; w < 8; ++w) s += red[(w * 16 + q) * 64 + F.lane];
                const int n = (q & 3) + 8 * (q >> 2) + 4 * hh;
                const float xg = s + P.in[I_ABF][n];
                const float lf = fminf(xg, 0.f) - log1pf(__expf(-fabsf(xg)));
                logf[(size_t)(b * NH + n) * SEQ + (row0 % SEQ) + r] = lf; }
        }
    }
}

template <class DstPtr>
__device__ __forceinline__ void scan_logf(const Frame& F, const float* lf, DstPtr dst, float scale, LAS float* wsum) {
    unsigned lo_ = 32u * (unsigned)F.tid; asm volatile("" : "+v"(lo_));
    const f32x4 a = *(const GAS f32x4*)((const char*)lf + lo_), b = *(const GAS f32x4*)((const char*)lf + lo_ + 16);
    float v[8] = {a.x, a.y, a.z, a.w, b.x, b.y, b.z, b.w};
#pragma unroll
    for (int e = 1; e < 8; ++e) v[e] += v[e - 1];
    const float total = v[7]; float incl = total; int ln_ = (int)(lo_ >> 5) & 63;
#pragma unroll
    for (int o = 1; o < 64; o <<= 1) { const float n = __int_as_float(__builtin_amdgcn_ds_bpermute((ln_ - o) << 2, __float_as_int(incl))); if (ln_ >= o) incl += n; }
    if (ln_ == 63) wsum[F.wave] = incl;
    __syncthreads();
    float off = incl - total;
    for (int w = 0; w < F.wave; ++w) off += wsum[w];
#pragma unroll
    for (int e = 0; e < 8; ++e) dst[8 * F.tid + e] = scale * (off + v[e]);
    __syncthreads();
}

__device__ __forceinline__ att::BlockRef fox_ref(int n, int jlo, float qk) {
    const int qb = 15 - (n >> 6), bh = n & 63, b = bh >> 5, h = bh & 31; att::BlockRef r;
    r.kvoff = (unsigned)b * (SEQ * DM) + h * HD; r.qoff = r.kvoff + (unsigned)qb * (256u * DM); r.P0 = qb * 256; r.jlo = jlo; r.sinks = nullptr; r.qk = qk; return r;
}
__device__ __forceinline__ int fox_jlo(const Frame& F, int n, const unsigned* nrm, float& qk) {
    const int qb = 15 - (n >> 6), bh = n & 63, b = bh >> 5, h = bh & 31;
    const float* nq = (const float*)nrm + ((0 * 2 + b) * 32 + h) * 4; const float* nk = (const float*)nrm + ((1 * 2 + b) * 32 + h) * 4;
    const float q2 = (nq[0] + nq[1]) + (nq[2] + nq[3]), k2 = (nk[0] + nk[1]) + (nk[2] + nk[3]);
    qk = 1.03f * sqrtf(q2 * k2);
    const float X = 40.0f / (LOG2E * att::SCALE) + att::THR / att::SCALE + 2.0f * qk + 16.0f;
#if defined(PROBE_X)
    const float Xp = (float)(PROBE_X);
#define X Xp
#endif
    const LAS float* Fs = (const LAS float*)(F.lds + att::LDS_F);
    const float thresh = Fs[qb * 256] - X;
    const unsigned long long m = __ballot(Fs[64 * F.lane + 63] > thresh);
    return m ? __builtin_ctzll(m) : 63;
#if defined(PROBE_X)
#undef X
#endif
}
__device__ __forceinline__ void p3_fox(const Frame& F, const Params& P, LAS char* lds, volatile LAS unsigned* MISC) {
    unsigned char* ws = P.ws;
#define logf ((const float*)(ws + WS_LOGF))
#define qhead ((unsigned*)(ws + WS_CTL) + CW_QUEUE)
#define nrm ((const unsigned*)(ws + WS_CTL) + CW_NORM)
    att::Bases<WS_Q, WS_K, WS_V, WS_Z, WS_OG> T; T.ws = ws;
    int n_cur = F.vcu;
    if (F.tid == 0) MISC[16] = 256u + __hip_atomic_fetch_add(qhead, 1u, __ATOMIC_RELAXED, __HIP_MEMORY_SCOPE_AGENT);
    scan_logf(F, logf + (size_t)(n_cur & 63) * SEQ, (LAS float*)(F.lds + att::LDS_F), -SQRT_HD, (LAS float*)(F.lds + att::LDS_WS));
    int n_nxt = (int)MISC[16];
    att::Seam S;
    float qk_ = 0.f; const int jl0_ = fox_jlo(F, n_cur, nrm, qk_);
    att::BlockRef cur = fox_ref(n_cur, jl0_, qk_);
    att::attn_prime<true, DM, DM>(T, cur, 1 << 28, lds, S);
#pragma unroll 1
    for (;;) {
        const bool has_next = n_nxt < 1024;
        unsigned n_nn = 0u;
        if (F.tid == 0) n_nn = 256u + __hip_atomic_fetch_add(qhead, 1u, __ATOMIC_RELAXED, __HIP_MEMORY_SCOPE_AGENT);
        const att::BlockRef nxt = has_next ? fox_ref(n_nxt, 0, 0.f) : cur;
        att::attn_block<true, DM, DM, DM>(T, cur, nxt, SEQ, 1 << 28, lds, S);
        if (!has_next) break;
        if (F.tid == 0) MISC[16] = n_nn;
        if ((n_nxt & 63) != (n_cur & 63)) scan_logf(F, logf + (size_t)(n_nxt & 63) * SEQ, (LAS float*)(F.lds + att::LDS_F), -SQRT_HD, (LAS float*)(F.lds + att::LDS_WS));
        else __syncthreads();
        { float qk2_ = 0.f; const int jl_ = fox_jlo(F, n_nxt, nrm, qk2_); cur = fox_ref(n_nxt, jl_, qk2_); }
        n_cur = n_nxt; n_nxt = (int)MISC[16];
        __syncthreads();
    }
#undef logf
#undef qhead
#undef nrm
}
__device__ __forceinline__ att::BlockRef swa_ref(int rb, int b, int kvh, const float* sinks) {
    att::BlockRef r; r.qoff = ((unsigned)b * SEQ + (unsigned)rb * 32u) * DM + kvh * 8 * HD; r.kvoff = (unsigned)b * (SEQ * NKV2) + kvh * HD; r.P0 = rb * 32; r.jlo = 0; r.qk = 0.f; r.sinks = sinks + kvh * 8; return r;
}
__device__ __forceinline__ void p7_swa(const Frame& F, const Params& P, LAS char* lds) {
    unsigned char* ws = P.ws;
    { const int it = F.vcu;
        const int g8 = it >> 5, b = g8 >> 2, kvh = g8 & 3, i0 = (it & 31) * 4;
        att::Bases<WS_Q, WS_KV1, WS_KV1 + (size_t)KVW * 2, WS_Z, WS_OG> T; T.ws = ws;
        att::Seam S;
        att::BlockRef cur = swa_ref(i0, b, kvh, P.in[I_SINK]);
        att::attn_prime<false, DM, NKV2>(T, cur, 128, lds, S);
#pragma unroll 1
        for (int t = 0; t < 4; ++t) { const att::BlockRef nxt = (t < 3) ? swa_ref(i0 + t + 1, b, kvh, P.in[I_SINK]) : cur; att::attn_block<false, DM, NKV2, DM>(T, cur, nxt, SEQ, 128, lds, S); cur = nxt; }
    }
}

__device__ __forceinline__ void p5_norm1(const Frame& F, const Params& P) {
    unsigned char* ws = P.ws;
    const float* mod = (const float*)(ws + WS_MOD); const float* h1 = (const float*)(ws + WS_H1);
    bf16_t* hb = (bf16_t*)(ws + WS_HB); bf16_t* kvn = (bf16_t*)(ws + WS_KVN);
    LAS float* gs = (LAS float*)F.lds; LAS float* sh = gs + DM; LAS float* gk = sh + DM;
    for (int rb = F.vcu; rb < M / 32; rb += F.G) {
        const int row0 = rb * 32, b = row0 / SEQ;
        __syncthreads();
        for (int k = F.tid; k < DM; k += NTHR) { const float* m1 = mod + (size_t)(2 + b) * MOD; gs[k] = P.in[I_NORMG][DM + k] * (1.0f + m1[DM + k]); sh[k] = m1[k]; gk[k] = P.in[I_KVG][k]; }
        __syncthreads();
#pragma unroll 1
        for (int rr = 0; rr < 4; ++rr) {
            const int row = row0 + F.wave * 4 + rr;
            const GAS f32x4* xr = (const GAS f32x4*)(h1 + (size_t)row * DM) + F.lane;
            f32x4 v[16]; float ss = 0.f;
#pragma unroll
            for (int j = 0; j < 16; ++j) { v[j] = xr[64 * j]; ss += (v[j].x * v[j].x + v[j].y * v[j].y) + (v[j].z * v[j].z + v[j].w * v[j].w); }
            const float rstd = 1.0f / sqrtf(wave_sum(ss) * (1.0f / DM) + EPS);
            GAS u32x2* o1 = (GAS u32x2*)(hb + (size_t)row * DM) + F.lane; GAS u32x2* o2 = (GAS u32x2*)(kvn + (size_t)row * DM) + F.lane;
#pragma unroll
            for (int j = 0; j < 16; ++j) { const int kx = 256 * j + 4 * F.lane; const f32x4 g = *(const LAS f32x4*)(gs + kx), s = *(const LAS f32x4*)(sh + kx), k4 = *(const LAS f32x4*)(gk + kx);
                const f32x4 xn = v[j] * rstd, y = xn * g + s, z = xn * k4; u32x2 w; w.x = pk2(y.x, y.y); w.y = pk2(y.z, y.w); o1[64 * j] = w; w.x = pk2(z.x, z.y); w.y = pk2(z.z, z.w); o2[64 * j] = w;
                asm volatile("" ::: "memory"); }
        }
    }
}
__device__ __forceinline__ void p9_final(const Frame& F, const Params& P) {
    LAS float* gf = (LAS float*)F.lds;
    __syncthreads();
    for (int k = F.tid; k < DM; k += NTHR) gf[k] = P.in[I_FING][k];
    __syncthreads();
    const int gw = F.vcu * NWAVES + F.wave, NGW = F.G * NWAVES;
    for (int row = gw; row < M; row += NGW) {
        GAS f32x4* xr = (GAS f32x4*)(P.out + (size_t)row * DM) + F.lane;
        f32x4 v[16]; float ss = 0.f;
#pragma unroll
        for (int j = 0; j < 16; ++j) { v[j] = xr[64 * j]; ss += (v[j].x * v[j].x + v[j].y * v[j].y) + (v[j].z * v[j].z + v[j].w * v[j].w); }
        const float rstd = 1.0f / sqrtf(wave_sum(ss) * (1.0f / DM) + EPS);
#pragma unroll
        for (int j = 0; j < 16; ++j) xr[64 * j] = v[j] * rstd * *(const LAS f32x4*)(gf + 256 * j + 4 * F.lane);
    }
}


template <class E, class Sched>
__device__ __forceinline__ void naive_gemm_bf16(const Frame& F, const bf16_t* A, const bf16_t* Bt, int K, const Sched& S, const E& e, const float* cs, const float* sn) {
    const int r = F.lane & 31, hh = F.lane >> 5; pg8::Unit u;
    for (int i = 0; S.next(i, u); ++i) {
        const pg8::Dest d = e.dest(u); const int rowu = e.row_of(u);
        for (int t = F.wave; t < 64; t += NWAVES) {
            const int tr = t >> 3, tc = t & 7;
            const bf16_t* ap = A + ((size_t)u.pm * 256 + tr * 32 + r) * K + 8 * hh; const bf16_t* bp = Bt + ((size_t)u.pn * 256 + tc * 32 + r) * K + 8 * hh;
            f32x16 acc = {};
#pragma unroll 4
            for (int k = 0; k < K; k += 16) { const bf16x8 a = *(const GAS bf16x8*)(ap + k), b = *(const GAS bf16x8*)(bp + k); acc = __builtin_amdgcn_mfma_f32_32x32x16_bf16(a, b, acc, 0, 0, 0); }
#pragma unroll
            for (int q = 0; q < 16; ++q) {
                const int row = rowu + tr * 32 + (q & 3) + 8 * (q >> 2) + 4 * hh, p = tc * 32 + r; float v = acc[q];
                if (d.mode == 1) v = pg8::silu_f(v);
                const float partner = __shfl_xor(v, 4);
                if (d.mode == 2) { const int pos = row & 4095, j = 4 * ((p & 127) >> 3) + (p & 3); const float c = cs[pos * 64 + j], s = sn[pos * 64 + j]; v = (p & 4) ? (v * c + partner * s) : (v * c - partner * s); }
                d.p[(size_t)row * d.ld + p] = (bf16_t)f2bf(v);
            }
        }
    }
}
template <class Sched>
__device__ __forceinline__ void naive_gemm_resgate(const Frame& F, const bf16_t* A, const bf16_t* Bt, int K, const Sched& S, const pg8::EpiResGate& e) {
    const int r = F.lane & 31, hh = F.lane >> 5; pg8::Unit u;
    for (int i = 0; S.next(i, u); ++i)
        for (int t = F.wave; t < 64; t += NWAVES) {
            const int tr = t >> 3, tc = t & 7;
            const bf16_t* ap = A + ((size_t)u.pm * 256 + tr * 32 + r) * K + 8 * hh; const bf16_t* bp = Bt + ((size_t)u.pn * 256 + tc * 32 + r) * K + 8 * hh;
            f32x16 acc = {};
#pragma unroll 4
            for (int k = 0; k < K; k += 16) { const bf16x8 a = *(const GAS bf16x8*)(ap + k), b = *(const GAS bf16x8*)(bp + k); acc = __builtin_amdgcn_mfma_f32_32x32x16_bf16(a, b, acc, 0, 0, 0); }
#pragma unroll
            for (int q = 0; q < 16; ++q) { const int row = u.pm * 256 + tr * 32 + (q & 3) + 8 * (q >> 2) + 4 * hh, col = u.pn * 256 + tc * 32 + r; const size_t off = (size_t)row * 4096 + col;
                e.out[off] = e.base[off] + e.gate[(size_t)(row >> 12) * e.gate_ld + col] * acc[q]; }
        }
}
template <bool FOX>
__device__ __forceinline__ void naive_attn(const Frame& F, const Params& P) {
    unsigned char* ws = P.ws;
    const bf16_t* Q = (const bf16_t*)(ws + WS_Q); const bf16_t* Z = (const bf16_t*)(ws + WS_Z); bf16_t* OG = (bf16_t*)(ws + WS_OG);
    LAS float* Fl = (LAS float*)F.lds; LAS float* qs = Fl + 4096 + F.wave * 128; LAS float* wsum = Fl + 4096 + 8 * 128;
    for (int it = F.vcu; it < 256; it += F.G) {
        const int bh = it >> 2, s4 = it & 3, b = bh >> 5, h = bh & 31;
        __syncthreads();
        if (FOX) scan_logf(F, (const float*)(ws + WS_LOGF) + (size_t)bh * SEQ, Fl, 1.0f, wsum);
        const bf16_t* Kp; const bf16_t* Vp; int ldkv;
        if (FOX) { Kp = (const bf16_t*)(ws + WS_K) + (size_t)b * SEQ * DM + h * HD; Vp = (const bf16_t*)(ws + WS_V) + (size_t)b * SEQ * DM + h * HD; ldkv = DM; }
        else { Kp = (const bf16_t*)(ws + WS_KV1) + (size_t)b * SEQ * NKV2 + (h >> 3) * HD; Vp = Kp + KVW; ldkv = NKV2; }
        const float sink = FOX ? 0.f : P.in[I_SINK][h];
        for (int t = F.wave; t < SEQ / 4; t += NWAVES) {
            const int i = 4 * t + s4; const size_t qo = ((size_t)b * SEQ + i) * DM + h * HD;
            { const unsigned qq = *(const GAS unsigned*)(Q + qo + 2 * F.lane); qs[2 * F.lane] = __uint_as_float(qq << 16) * att::SCALE; qs[2 * F.lane + 1] = __uint_as_float(qq & 0xffff0000u) * att::SCALE; }
            asm volatile("s_waitcnt lgkmcnt(0)" ::: "memory");
            float m = -1e30f, l = 0.f, o0 = 0.f, o1 = 0.f;
            const int jst = FOX ? 0 : (i > 127 ? i - 127 : 0);
            for (int jc = jst; jc <= i; jc += 64) {
                const int j = jc + F.lane; const bool valid = j <= i; const int jl = valid ? j : i;
                const bf16_t* kr = Kp + (size_t)jl * ldkv; float dot = 0.f;
#pragma unroll 4
                for (int d = 0; d < 128; d += 8) { const u32x4 kk = *(const GAS u32x4*)(kr + d); const LAS float* qd = qs + d;
                    dot += __uint_as_float(kk.x << 16) * qd[0] + __uint_as_float(kk.x & 0xffff0000u) * qd[1] + __uint_as_float(kk.y << 16) * qd[2] + __uint_as_float(kk.y & 0xffff0000u) * qd[3]
                         + __uint_as_float(kk.z << 16) * qd[4] + __uint_as_float(kk.z & 0xffff0000u) * qd[5] + __uint_as_float(kk.w << 16) * qd[6] + __uint_as_float(kk.w & 0xffff0000u) * qd[7]; }
                float sv = dot; if (FOX) sv += Fl[i] - Fl[jl];
                if (!valid) sv = -__builtin_inff();
                float cm = sv;
#pragma unroll
                for (int o = 1; o < 64; o <<= 1) cm = fmaxf(cm, __shfl_xor(cm, o));
                const float mn = fmaxf(m, cm), alpha = __expf(m - mn), p = valid ? __expf(sv - mn) : 0.f;
                l = l * alpha + wave_sum(p); o0 *= alpha; o1 *= alpha; m = mn;
                const int nj = (i - jc + 1) < 64 ? (i - jc + 1) : 64;
                for (int jj = 0; jj < nj; ++jj) { const float pj = __shfl(p, jj); const bf16_t* vr = Vp + (size_t)(jc + jj) * ldkv; o0 += pj * bf2f(vr[F.lane]); o1 += pj * bf2f(vr[F.lane + 64]); }
            }
            if (!FOX) l += __expf(sink - m);
            const float rl = 1.0f / l;
            OG[qo + F.lane] = (bf16_t)f2bf(o0 * rl * bf2f(Z[qo + F.lane])); OG[qo + F.lane + 64] = (bf16_t)f2bf(o1 * rl * bf2f(Z[qo + F.lane + 64]));
        }
    }
}

constexpr int NPHASE = 10;
__global__ void __launch_bounds__(NTHR, 2) fwd(Params P) {
    extern __shared__ __attribute__((aligned(16))) unsigned char lds[];
#define MAKE_FRAME() Frame F; { unsigned t_ = threadIdx.x; asm volatile("" : "+v"(t_)); F.lds = (LAS unsigned char*)lds; F.tid = (int)t_; F.lane = F.tid & 63; F.wave = __builtin_amdgcn_readfirstlane(F.tid >> 6); \
        F.G = gridDim.x; const int bx_ = blockIdx.x; F.vcu = (F.G % 8 == 0) ? (bx_ % 8) * (F.G / 8) + bx_ / 8 : bx_; }
    volatile LAS unsigned* MISC = (volatile LAS unsigned*)((LAS unsigned char*)lds + MISC_OFF);
    for (int u = threadIdx.x; u < (LDS_BYTES - MISC_OFF) / 4; u += NTHR) MISC[u] = 0u;
    __syncthreads();
    unsigned char* ws = P.ws;
    const int lo = P.ph_lo, hi = P.ph_hi;
    if (hi - lo > 1) (void)xcd_barrier_post((unsigned*)(ws + WS_CTL) + CW_BAR, MISC + 8);
#ifndef PH_MASK
#define PH_MASK 0x3ff
#endif
#define IN(k) (((PH_MASK >> (k)) & 1) && lo <= (k) && (k) < hi)
#ifndef SEAM_TWICE
#define SEAM_TWICE 0
#endif
#define SEAM(k) do { if (IN(k) && IN((k) + 1)) { XcdBarrier bar_; bar_.bar = (unsigned*)(ws + WS_CTL) + CW_BAR; bar_.x = xb_xcc_id(); bar_.st = MISC + 8; xcd_barrier(bar_); if (SEAM_TWICE) xcd_barrier(bar_); } } while (0)
#ifndef REP_MASK
#define REP_MASK 0
#endif
#define REPS(k) _Pragma("unroll 1") for (int rep_ = 0; rep_ < (((REP_MASK >> (k)) & 1) ? 2 : 1); ++rep_)
#define cs ((const float*)(ws + WS_ROPE))
#define sn ((const float*)(ws + WS_ROPE) + SEQ * 64)
#define mod ((const float*)(ws + WS_MOD))

    if (IN(0)) { MAKE_FRAME(); REPS(0) { p0_prologue(F, P); } SEAM(0); }
    if (IN(1)) { MAKE_FRAME(); REPS(1) { p1_norm0(F, P); } SEAM(1); }
    if (IN(2)) { MAKE_FRAME();
        REPS(2) {
#ifndef GX_WGM
#define GX_WGM 4
#endif
#ifndef G1_WGM
#define G1_WGM 4
#endif
        pg8::StaticOrder S; S.init(M, N1, F.G, (int)blockIdx.x, G1_WGM);
        pg8::EpiStoreBf16<pg8::EpiQKVZ> E{{(bf16_t*)(ws + WS_Q), (WS_K - WS_Q) / 2}, cs, sn, (unsigned*)(ws + WS_CTL) + CW_NORM};
#if NAIVE_GEMM
        naive_gemm_bf16(F, (const bf16_t*)(ws + WS_HB), (const bf16_t*)(ws + WS_W1T), DM, S, E.e, cs, sn);
        if (blockIdx.x == 0) for (int i = F.tid; i < 512; i += NTHR) E.nrm[i] = __float_as_uint(1e12f);
#else
        pg8::Gemm g{(const bf16_t*)(ws + WS_HB), (const bf16_t*)(ws + WS_W1T), M, N1, DM};
#if defined(PROBE_NULL_EPI)
        { pg8::EpiNull EN; pg8::gemm_phase<pg8::EpiNull, pg8::StaticOrder, true, true>(F.lds, g, S, EN); }
#endif
        pg8::gemm_phase<pg8::EpiStoreBf16<pg8::EpiQKVZ>, pg8::StaticOrder, true, true>(F.lds, g, S, E);
#endif
        }
        SEAM(2);
    }
    if (IN(3)) { MAKE_FRAME();
        REPS(3) {
#if NAIVE_FOX
        naive_attn<true>(F, P);
#else
        p3_fox(F, P, (LAS char*)F.lds, MISC);
#endif
        }
        SEAM(3);
    }
    if (IN(4)) { MAKE_FRAME();
        REPS(4) {
        pg8::StaticOrder S; S.init(M, DM, F.G, (int)blockIdx.x, GX_WGM);
        pg8::EpiResGate E{P.in[I_X], (float*)(ws + WS_H1), mod + 2 * DM, MOD};
#if NAIVE_GEMM
        naive_gemm_resgate(F, (const bf16_t*)(ws + WS_OG), (const bf16_t*)(ws + WS_W2T), DM, S, E);
#else
        pg8::Gemm g{(const bf16_t*)(ws + WS_OG), (const bf16_t*)(ws + WS_W2T), M, DM, DM};
        pg8::gemm_phase<pg8::EpiResGate, pg8::StaticOrder, true, true>(F.lds, g, S, E);
#endif
        }
        SEAM(4);
    }
    if (IN(5)) { MAKE_FRAME(); REPS(5) { p5_norm1(F, P); } SEAM(5); }
    if (IN(6)) { MAKE_FRAME();
        REPS(6) {
        pg8::OrderQZKV S; S.init(F.G, (int)blockIdx.x, GX_WGM);
        pg8::EpiStoreBf16<pg8::EpiQZKV> E{{(bf16_t*)(ws + WS_Q), (bf16_t*)(ws + WS_Z), (bf16_t*)(ws + WS_KV1)}, cs, sn, nullptr};
#if NAIVE_GEMM
        naive_gemm_bf16(F, (const bf16_t*)(ws + WS_HB), (const bf16_t*)(ws + WS_W3T), DM, S, E.e, cs, sn);
#else
        pg8::Gemm g{(const bf16_t*)(ws + WS_HB), (const bf16_t*)(ws + WS_W3T), 2 * M, N3 + NKV2, DM};
        pg8::gemm_phase<pg8::EpiStoreBf16<pg8::EpiQZKV>, pg8::OrderQZKV, true, true>(F.lds, g, S, E);
#endif
        }
        SEAM(6);
    }
    if (IN(7)) { MAKE_FRAME();
        REPS(7) {
#if NAIVE_SWA
        naive_attn<false>(F, P);
#else
        p7_swa(F, P, (LAS char*)F.lds);
#endif
        }
        SEAM(7);
    }
    if (IN(8)) { MAKE_FRAME();
        REPS(8) {
        pg8::StaticOrder S; S.init(M, DM, F.G, (int)blockIdx.x, GX_WGM);
        pg8::EpiResGate E{(const float*)(ws + WS_H1), P.out, mod + 2 * MOD + 2 * DM, MOD};
#if NAIVE_GEMM
        naive_gemm_resgate(F, (const bf16_t*)(ws + WS_OG), (const bf16_t*)(ws + WS_W4T), DM, S, E);
#else
        pg8::Gemm g{(const bf16_t*)(ws + WS_OG), (const bf16_t*)(ws + WS_W4T), M, DM, DM};
        pg8::gemm_phase<pg8::EpiResGate, pg8::StaticOrder, true, true>(F.lds, g, S, E);
#endif
        }
        SEAM(8);
    }
    if (IN(9)) { MAKE_FRAME(); p9_final(F, P); }
#undef IN
#undef SEAM
#undef cs
#undef sn
#undef mod
}

extern "C" void kernel_launch(void* const* d_in, const int* in_sizes, int n_in, void* d_out, int out_size, void* d_ws, size_t ws_size, hipStream_t stream) {
    static int grid = 0;
    if (grid == 0) {
        if (n_in != 14 || out_size != M * DM || ws_size < WS_END) { fprintf(stderr, "kernel_launch: unexpected shapes (n_in %d, out %d, ws %zu)\n", n_in, out_size, ws_size); grid = -1; return; }
        int dev = 0, cus = 0, per_cu = 0;
        if (hipGetDevice(&dev) != hipSuccess || hipDeviceGetAttribute(&cus, hipDeviceAttributeMultiprocessorCount, dev) != hipSuccess) { grid = -1; return; }
        if (hipFuncSetAttribute((const void*)fwd, hipFuncAttributeMaxDynamicSharedMemorySize, LDS_BYTES) != hipSuccess) { fprintf(stderr, "kernel_launch: hipFuncSetAttribute failed\n"); grid = -1; return; }
        if (hipOccupancyMaxActiveBlocksPerMultiprocessor(&per_cu, (const void*)fwd, NTHR, LDS_BYTES) != hipSuccess || per_cu < 1) fprintf(stderr, "kernel_launch: occupancy query reports %d workgroups per CU\n", per_cu);
        (void)hipGetLastError();
        grid = cus;
        if (grid > 256) grid = 256;
    }
    if (grid < 0) return;
    (void)hipMemsetAsync((char*)d_ws + WS_CTL, 0, CTL_ZERO_BYTES, stream);
    Params p{};
    for (int i = 0; i < 14; ++i) p.in[i] = (const float*)d_in[i];
    p.out = (float*)d_out; p.ws = (unsigned char*)d_ws;
#if MK_N_LAUNCHES == 1
    p.ph_lo = 0; p.ph_hi = NPHASE;
    hipLaunchKernelGGL(fwd, dim3(grid), dim3(NTHR), LDS_BYTES, stream, p);
#else
    for (int k = 0; k < NPHASE; ++k) { p.ph_lo = k; p.ph_hi = k + 1; hipLaunchKernelGGL(fwd, dim3(grid), dim3(NTHR), LDS_BYTES, stream, p); }
#endif
    const hipError_t le = hipPeekAtLastError();
    if (le != hipSuccess) fprintf(stderr, "kernel_launch: launch failed: %s\n", hipGetErrorName(le));
}
```

```cpp
#include <hip/hip_runtime.h>
#include <cstdio>
#include <cstdint>

#ifndef MK_N_LAUNCHES
#define MK_N_LAUNCHES 1
#endif
#ifndef NT_OUT
#define NT_OUT 1
#endif
#ifndef P1_NT
#define P1_NT 1
#endif
#ifndef WSKIP_ON
#define WSKIP_ON 0
#endif
#ifndef FP8_G4
#define FP8_G4 1
#endif
#ifndef I8_G3
#define I8_G3 1
#endif
#ifndef I8_G1
#define I8_G1 1
#endif
#if I8_G3
#define FP8_G3 0
#endif
#ifndef FP8_G3
#define FP8_G3 1
#endif
#define F8_HSCALE 8.0f
#define F8_WSCALE 64.0f
#define F8_OSCALE 8.0f
#ifndef NAIVE_GEMM
#define NAIVE_GEMM 0
#endif
#ifndef NAIVE_FOX
#define NAIVE_FOX 0
#endif
#ifndef NAIVE_SWA
#define NAIVE_SWA 0
#endif

#define GAS __attribute__((address_space(1)))
#define LAS __attribute__((address_space(3)))
typedef float f32x16 __attribute__((ext_vector_type(16)));
typedef short s16x4 __attribute__((ext_vector_type(4)));
typedef unsigned u32x2 __attribute__((ext_vector_type(2)));

constexpr int DM = 4096, BATCH = 2, SEQ = 4096, M = BATCH * SEQ;
constexpr int NH = 32, HD = 128, NKV = 4, KVW = NKV * HD;
constexpr int N1 = 4 * DM;
constexpr int N1F = N1 + NH;
constexpr int N3 = 2 * DM, NKV2 = 2 * KVW;
constexpr int MOD = 3 * DM;
constexpr float EPS = 1e-6f;
constexpr float LOG2E = 1.4426950408889634f;
constexpr float SQRT_HD = 11.313708498984761f;

typedef unsigned short bf16_t;
typedef short bf16x8 __attribute__((ext_vector_type(8)));
typedef float f32x4 __attribute__((ext_vector_type(4)));
typedef unsigned u32x4 __attribute__((ext_vector_type(4)));

namespace pg8 {
#define PG8_LAS __attribute__((address_space(3)))
typedef unsigned short bf16_t;
typedef short bf16x8 __attribute__((ext_vector_type(8)));
typedef float f32x4 __attribute__((ext_vector_type(4)));
typedef unsigned u32x4 __attribute__((ext_vector_type(4)));
constexpr int BM = 256, BK = 64, HALF = 128, HTB = HALF * BK * 2  , STAGE_BYTES = 8 * HTB, NXCD = 8, WGM = 8;

__host__ __device__ __forceinline__ int lds_byte(int r, int c) { const int st = (r >> 4) * 2 + (c >> 5), rr = r & 15, cc = c & 31, ob = rr * 64 + cc * 2; return st * 1024 + (ob ^ (((ob >> 9) & 1) << 5)); }
__host__ __device__ __forceinline__ void stage_rc(int b, int& R, int& C) { const int st = b / 1024, sb = b % 1024, swz = sb ^ (((sb >> 9) & 1) << 5); R = (st >> 1) * 16 + swz / 64; C = (st & 1) * 32 + (swz % 64) / 2; }
__host__ __device__ __forceinline__ int perm32(int rho) { const int n = rho >> 4, i = rho & 15; return 8 * (i >> 2) + 4 * n + (i & 3); }

struct Unit { int pm, pn; };
struct Gemm { const bf16_t* A; const bf16_t* Bt; int M, N, K; };

struct StaticOrder {
    int nM, nN, nwg, G, c, wgm;
    __host__ __device__ void init(int M, int N, int G_, int c_, int wgm_ = WGM) { nM = M / BM; nN = N / BM; nwg = nM * nN; G = G_; c = c_; wgm = wgm_; }
    __host__ __device__ bool next(int i, Unit& u) const {
        const long L = (long)i * G + c; if (L >= nwg) return false;
        int wgid = (int)L; { const int q = nwg / NXCD, r = nwg % NXCD, xcd = wgid % NXCD, off = wgid / NXCD; wgid = (xcd < r ? xcd * (q + 1) : r * (q + 1) + (xcd - r) * q) + off; }
        const int nig = wgm * nN, gid = wgid / nig, fm = gid * wgm, gsz = (nM - fm) < wgm ? (nM - fm) : wgm;
        u.pm = fm + ((wgid % nig) % gsz); u.pn = (wgid % nig) / gsz; return true;
    }
    __device__ __forceinline__ void a_ready(const Unit&) const {}
    __device__ __forceinline__ void done(const Unit&) const {}
};

__device__ __forceinline__ unsigned cvt_pk_bf16(float lo, float hi) { unsigned r; asm volatile("v_cvt_pk_bf16_f32 %0, %1, %2" : "=v"(r) : "v"(lo), "v"(hi)); return r; }
__device__ __forceinline__ float silu_f(float v) { return v * __builtin_amdgcn_rcpf(1.0f + __builtin_amdgcn_exp2f(-1.4426950408889634f * v)); }
__device__ __forceinline__ f32x4 silu4(f32x4 v) { return (f32x4){silu_f(v[0]), silu_f(v[1]), silu_f(v[2]), silu_f(v[3])}; }

__device__ __forceinline__ void store16_wt(void* base, unsigned off, u32x4 v) {
    const __amdgpu_buffer_rsrc_t rs = __builtin_amdgcn_make_buffer_rsrc(base, 0, 0x7fffffff, 0x00020000);
    __builtin_amdgcn_raw_buffer_store_b128(v, rs, off, 0, 16);
}
struct Dest { bf16_t* p; int ld; int mode; };

struct EpiQKVZ {
    static constexpr bool PERM = true, AFTER_DRAIN = false;
    bf16_t* O; size_t split_stride; int t0;
    __device__ __forceinline__ Dest dest(const Unit& u) const { const int colt = u.pn * BM, t = (colt >> 12) + t0; Dest d; d.p = O + (size_t)t * split_stride + (colt & 4095); d.ld = 4096; d.mode = (t == 3) ? 1 : 0; return d; }
    __device__ __forceinline__ int row_of(const Unit& u) const { return u.pm * BM; }
};
struct EpiQZKV {
    static constexpr bool PERM = true, AFTER_DRAIN = false;
    bf16_t* Q1; bf16_t* Z1; bf16_t* KV1;
    __device__ __forceinline__ Dest dest(const Unit& u) const {
        Dest d;
        if (u.pn < 32) { const int colt = u.pn * BM; if (colt < 4096) { d.p = Q1 + colt; d.mode = 2; } else { d.p = Z1 + (colt - 4096); d.mode = 1; } d.ld = 4096; }
        else { const int colt = (u.pn - 32) * BM; d.p = KV1 + colt; d.ld = 1024; d.mode = (colt < 512) ? 2 : 0; }
        return d;
    }
    __device__ __forceinline__ int row_of(const Unit& u) const { return (u.pn < 32 ? u.pm : u.pm - 32) * BM; }
};
struct EpiQZ {
    bf16_t* Q1; bf16_t* Z1;
    __device__ __forceinline__ Dest dest(const Unit& u) const { Dest d; const int colt = u.pn * BM; if (colt < 4096) { d.p = Q1 + colt; d.mode = 2; } else { d.p = Z1 + (colt - 4096); d.mode = 1; } d.ld = 4096; return d; }
    __device__ __forceinline__ int row_of(const Unit& u) const { return u.pm * BM; }
};
struct EpiKV {
    bf16_t* KV1;
    __device__ __forceinline__ Dest dest(const Unit& u) const { Dest d; const int colt = u.pn * BM; d.p = KV1 + colt; d.ld = 1024; d.mode = (colt < 512) ? 2 : 0; return d; }
    __device__ __forceinline__ int row_of(const Unit& u) const { return u.pm * BM; }
};
typedef int i32x4e __attribute__((ext_vector_type(4)));
struct DqNone {};
struct DqI8 { const float* sa; const float* sw; };
template <class E, int OSC = 1, class DQ = DqNone> struct EpiStoreBf16 {
    static constexpr bool PERM = true, AFTER_DRAIN = false;
    E e; const float* cs; const float* sn; unsigned* nrm; DQ dq;
    __device__ __forceinline__ void operator()(const f32x4 (&acc)[2][2][4][2], const Unit& u, int wr, int wc, int fr, int fq) const {
        const Dest d = e.dest(u); const int row0 = e.row_of(u) + wr * 64 + fr; const int col0 = wc * 32 + 8 * fq;
        const int g4 = (4 * wc + fq) * 4;
        float nmax[2] = {0.f, 0.f};
        float rs_[2][4]; f32x4 cw_[2][2];
        if constexpr (sizeof(DQ) > 1) {
#pragma unroll
            for (int ai = 0; ai < 2; ++ai)
#pragma unroll
                for (int m = 0; m < 4; ++m) rs_[ai][m] = dq.sa[row0 + ai * HALF + m * 16];
#pragma unroll
            for (int bj = 0; bj < 2; ++bj) { const int gc = u.pn * BM + col0 + bj * HALF; cw_[bj][0] = *(const f32x4*)(dq.sw + gc); cw_[bj][1] = *(const f32x4*)(dq.sw + gc + 4); }
        }
#pragma unroll
        for (int ai = 0; ai < 2; ++ai)
#pragma unroll
            for (int m = 0; m < 4; ++m) { const int row = row0 + ai * HALF + m * 16; bf16_t* rowp = d.p + (size_t)row * d.ld + col0;
                f32x4 c4 = (f32x4){1.f, 1.f, 1.f, 1.f}, s4 = (f32x4){0.f, 0.f, 0.f, 0.f};
                if (d.mode == 2) { const int pos = row & 4095; c4 = *(const f32x4*)(cs + pos * 64 + g4); s4 = *(const f32x4*)(sn + pos * 64 + g4); }
#pragma unroll
                for (int bj = 0; bj < 2; ++bj) { f32x4 v0 = acc[ai][bj][m][0], v1 = acc[ai][bj][m][1];
                    if constexpr (OSC != 1) { v0 *= (1.0f / OSC); v1 *= (1.0f / OSC); }
                    if constexpr (sizeof(DQ) > 1) { const float rs = rs_[ai][m];
                        v0 = __builtin_convertvector(__builtin_bit_cast(i32x4e, v0), f32x4) * (cw_[bj][0] * rs); v1 = __builtin_convertvector(__builtin_bit_cast(i32x4e, v1), f32x4) * (cw_[bj][1] * rs); }
                    if (d.mode == 1) { v0 = silu4(v0); v1 = silu4(v1); }
                    if (d.mode == 2) { const f32x4 y1 = v0 * c4 - v1 * s4, y2 = v1 * c4 + v0 * s4; v0 = y1; v1 = y2; }
                    if (nrm) { float ss = (v0[0] * v0[0] + v0[1] * v0[1]) + (v0[2] * v0[2] + v0[3] * v0[3]) + (v1[0] * v1[0] + v1[1] * v1[1]) + (v1[2] * v1[2] + v1[3] * v1[3]);
                        ss += __shfl_xor(ss, 16); ss += __shfl_xor(ss, 32); nmax[bj] = fmaxf(nmax[bj], ss); }
                    u32x4 w; w.x = cvt_pk_bf16(v0[0], v0[1]); w.y = cvt_pk_bf16(v0[2], v0[3]); w.z = cvt_pk_bf16(v1[0], v1[1]); w.w = cvt_pk_bf16(v1[2], v1[3]);
#if defined(WT_OUT)
                    store16_wt(d.p, (unsigned)(((size_t)row * d.ld + col0 + bj * HALF) * 2), w); } }
#elif NT_OUT
                    __builtin_nontemporal_store(w, (u32x4*)(rowp + bj * HALF)); } }
#else
                    *(u32x4*)(rowp + bj * HALF) = w; } }
#endif
        if (nrm) { const int colt = u.pn * BM, t = colt >> 12;
            if (t < 2) {
#pragma unroll
                for (int bj = 0; bj < 2; ++bj) { float mx = nmax[bj];
#pragma unroll
                    for (int o = 1; o < 16; o <<= 1) mx = fmaxf(mx, __shfl_xor(mx, o));
                    if (fr == 0 && fq == 0) atomicMax(nrm + ((((t * 2 + ((u.pm * BM) >> 12)) * 32) + ((colt & 4095) >> 7) + bj) * 4 + wc), __float_as_uint(mx)); } } }
    }
};
#ifndef RES_NT
#define RES_NT 0
#endif
#if RES_NT
#define RES_LOAD(p) __builtin_nontemporal_load(p)
#else
#define RES_LOAD(p) (*(p))
#endif
struct EpiResGate {
    static constexpr bool PERM = false, AFTER_DRAIN = false;
    const float* base; float* out; const float* gate; int gate_ld; bool nt_base; float osc;
    __device__ __forceinline__ void operator()(const f32x4 (&acc)[2][2][4][2], const Unit& u, int wr, int wc, int fr, int fq) const {
        const int row0 = u.pm * BM + wr * 64 + fr, col0 = u.pn * BM + wc * 32 + 4 * fq; const float* gp = gate + (size_t)((u.pm * BM) >> 12) * gate_ld + col0;
        f32x4 gv[2][2];
#pragma unroll
        for (int bj = 0; bj < 2; ++bj)
#pragma unroll
            for (int n = 0; n < 2; ++n) gv[bj][n] = *(const f32x4*)(gp + bj * HALF + n * 16) * osc;
#pragma unroll
        for (int ai = 0; ai < 2; ++ai)
#pragma unroll
            for (int m = 0; m < 4; ++m) { const size_t off = (size_t)(row0 + ai * HALF + m * 16) * 4096 + col0;
#pragma unroll
                for (int bj = 0; bj < 2; ++bj)
#pragma unroll
                    for (int n = 0; n < 2; ++n) { const f32x4 bs = nt_base ? __builtin_nontemporal_load((const f32x4*)(base + off + bj * HALF + n * 16)) : *(const f32x4*)(base + off + bj * HALF + n * 16); const f32x4 r_ = bs + gv[bj][n] * acc[ai][bj][m][n];
#if defined(WT_OUT)
                        store16_wt(out, (unsigned)((off + bj * HALF + n * 16) * 4), __builtin_bit_cast(u32x4, r_)); } }
#else
                        *(f32x4*)(out + off + bj * HALF + n * 16) = r_; } }
#endif
    }
};
struct EpiNull {
    static constexpr bool PERM = true, AFTER_DRAIN = false;
    __device__ __forceinline__ void operator()(const f32x4 (&acc)[2][2][4][2], const Unit&, int, int, int, int) const {
#pragma unroll
        for (int ai = 0; ai < 2; ++ai)
#pragma unroll
            for (int bj = 0; bj < 2; ++bj)
#pragma unroll
                for (int m = 0; m < 4; ++m) asm volatile("" :: "v"(acc[ai][bj][m][0]), "v"(acc[ai][bj][m][1]));
    }
};
struct OrderQZ8 {
    StaticOrder so; bool custom; int xcd, slot;
    __device__ void init(int G_, int c_, int wgm_) { so.init(8192, 8192, G_, c_, wgm_); custom = (G_ == 256); xcd = c_ & 7; slot = c_ >> 3; }
    __device__ bool next(int i, Unit& u) const {
        if (!custom) return so.next(i, u);
        int off; if (i < 3) off = i * 32 + slot; else { if (!(slot & 1) || i >= 5) return false; off = 96 + (i - 3) * 16 + (slot >> 1); }
        u.pm = 4 * xcd + (off & 3); u.pn = off >> 2; return true;
    }
    __device__ __forceinline__ void a_ready(const Unit&) const {}
    __device__ __forceinline__ void done(const Unit&) const {}
};
struct OrderKV {
    StaticOrder so; bool custom; int xcd, slot;
    __device__ void init(int G_, int c_, int wgm_) { so.init(8192, 1024, G_, c_, wgm_); custom = (G_ == 256); xcd = c_ & 7; slot = c_ >> 3; }
    __device__ bool next(int i, Unit& u) const {
        if (!custom) return so.next(i, u);
        if (i > 0 || (slot & 1)) return false;
        const int r = slot >> 1; u.pm = 4 * xcd + (r & 3); u.pn = r >> 2; return true;
    }
    __device__ __forceinline__ void a_ready(const Unit&) const {}
    __device__ __forceinline__ void done(const Unit&) const {}
};
struct OrderQZKV {
    StaticOrder so; int G, c;
    __device__ void init(int G_, int c_, int wgm_) { so.init(8192, 8192, G_, c_, wgm_); G = G_; c = c_; }
    __device__ bool next(int i, Unit& u) const {
        if (so.next(i, u)) return true;
        const long L = (long)i * G + c - 1024; if (L < 0 || L >= 128) return false;
        u.pm = 32 + (int)(L >> 2); u.pn = 32 + (int)(L & 3); return true;
    }
    __device__ __forceinline__ void a_ready(const Unit&) const {}
    __device__ __forceinline__ void done(const Unit&) const {}
};

#ifndef F8_ASM
#define F8_ASM 1
#endif
typedef int i32x4_ __attribute__((ext_vector_type(4)));
typedef int i32x8_ __attribute__((ext_vector_type(8)));
__device__ __forceinline__ i32x8_ cat8(bf16x8 a, bf16x8 b) { const i32x4_ x = __builtin_bit_cast(i32x4_, a), y = __builtin_bit_cast(i32x4_, b); return __builtin_shufflevector(x, y, 0, 1, 2, 3, 4, 5, 6, 7); }
template <class Epi, class Sched, bool ALIGN_EPI = false, bool SP2 = false, bool F8 = false, bool I8 = false>
__device__ __forceinline__ void gemm_phase(PG8_LAS unsigned char* lds, const Gemm g, const Sched& S, const Epi& E) {
    const int tid = threadIdx.x, wid = __builtin_amdgcn_readfirstlane(tid >> 6), lane = tid & 63, wr = wid >> 2, wc = wid & 3, fr = lane & 15, fq = lane >> 4;
    const int K = g.K, nt = K / BK;
    unsigned voffA[2], voffB[2];
#pragma unroll
    for (int i = 0; i < 2; ++i) { int R, C; stage_rc(tid * 16 + i * 8192, R, C); const int Rb = Epi::PERM ? ((R & ~31) + perm32(R & 31)) : R;
        voffA[i] = (unsigned)(R * K + C) * 2u; voffB[i] = (unsigned)(Rb * K + C) * 2u; }
    const size_t kstep = (size_t)(BK * 2);
    const size_t hstep = (size_t)HALF * K * 2;
    const size_t tstep = 2 * hstep;
    const unsigned ldsw = (unsigned)wid * 1024u;
    const int aoff = lds_byte(wr * 64 + fr, fq * 8), boff = lds_byte(wc * 32 + fr, fq * 8);
#define PG8_SA(b, h) (((b) * 2 + (h)) * HTB)
#define PG8_SB(b, h) ((4 + (b) * 2 + (h)) * HTB)
#define PG8_STAGE(bufoff, gbase, voff) do { _Pragma("unroll") for (int _i = 0; _i < 2; ++_i) \
        __builtin_amdgcn_global_load_lds((const unsigned*)((const char*)(gbase) + (voff)[_i]), (PG8_LAS unsigned*)(lds + (bufoff) + ldsw + _i * 8192), 16, 0, 0); } while (0)
#define PG8_LDA(dst, b, h) do { _Pragma("unroll") for (int m = 0; m < 4; ++m) _Pragma("unroll") for (int k = 0; k < 2; ++k) dst[m][k] = *(const PG8_LAS bf16x8*)(lds + PG8_SA(b, h) + aoff + m * 2048 + k * 1024); } while (0)
#define PG8_LDB(dst, b, h) do { _Pragma("unroll") for (int n = 0; n < 2; ++n) _Pragma("unroll") for (int k = 0; k < 2; ++k) dst[n][k] = *(const PG8_LAS bf16x8*)(lds + PG8_SB(b, h) + boff + n * 2048 + k * 1024); } while (0)
#define PG8_MMA(ai, bj, At, Bt) do { __builtin_amdgcn_s_setprio(1); _Pragma("unroll") for (int m = 0; m < 4; ++m) _Pragma("unroll") for (int n = 0; n < 2; ++n) { \
        if constexpr (F8) { if (F8_ASM) asm volatile("v_mfma_scale_f32_16x16x128_f8f6f4 %0, %1, %2, %0, %3, %3 op_sel_hi:[0,0,0]" : "+v"(acc[ai][bj][m][n]) : "v"(cat8(Bt[n][0], Bt[n][1])), "v"(cat8(At[m][0], At[m][1])), "v"(f8sc)); \
            else acc[ai][bj][m][n] = __builtin_amdgcn_mfma_scale_f32_16x16x128_f8f6f4(cat8(Bt[n][0], Bt[n][1]), cat8(At[m][0], At[m][1]), acc[ai][bj][m][n], 0, 0, 0, 0x7f7f7f7f, 0, 0x7f7f7f7f); } \
        else if constexpr (I8) { _Pragma("unroll") for (int k = 0; k < 2; ++k) acc[ai][bj][m][n] = __builtin_bit_cast(f32x4, __builtin_amdgcn_mfma_i32_16x16x64_i8(__builtin_bit_cast(i32x4_, Bt[n][k]), __builtin_bit_cast(i32x4_, At[m][k]), __builtin_bit_cast(i32x4_, acc[ai][bj][m][n]), 0, 0, 0)); } \
        else { _Pragma("unroll") for (int k = 0; k < 2; ++k) acc[ai][bj][m][n] = __builtin_amdgcn_mfma_f32_16x16x32_bf16(Bt[n][k], At[m][k], acc[ai][bj][m][n], 0, 0, 0); } } __builtin_amdgcn_s_setprio(0); } while (0)
#define PG8_WAIT_V(n) asm volatile("s_waitcnt vmcnt(" #n ")" ::: "memory")
#define PG8_WAIT_L(n) asm volatile("s_waitcnt lgkmcnt(" #n ")" ::: "memory")
#define PG8_BAR __builtin_amdgcn_s_barrier()
#define PG8_SCHED __builtin_amdgcn_sched_barrier(0)
    Unit cur, nxt; int ui = 0;
    if (!S.next(0, cur)) return;
    const int f8sc = 0x7f7f7f7f; (void)f8sc;
    f32x4 acc[2][2][4][2];
#pragma unroll
    for (int a = 0; a < 2; ++a)
#pragma unroll
        for (int b = 0; b < 2; ++b)
#pragma unroll
            for (int m = 0; m < 4; ++m)
#pragma unroll
                for (int n = 0; n < 2; ++n) acc[a][b][m][n] = (f32x4){0.f, 0.f, 0.f, 0.f};
    bf16x8 At[4][2], B0[2][2], B1[2][2];
    const char* cA = (const char*)g.A + (size_t)cur.pm * tstep; const char* cB = (const char*)g.Bt + (size_t)cur.pn * tstep;
    S.a_ready(cur);
    if constexpr (SP2) {
        PG8_STAGE(PG8_SB(0, 0), cB, voffB); PG8_STAGE(PG8_SB(0, 1), cB + hstep, voffB); PG8_STAGE(PG8_SA(0, 0), cA, voffA); PG8_STAGE(PG8_SA(0, 1), cA + hstep, voffA);
        if (wr == 1) PG8_BAR;
        PG8_WAIT_V(2); PG8_BAR;
        PG8_STAGE(PG8_SB(1, 0), cB + kstep, voffB); PG8_STAGE(PG8_SA(1, 0), cA + kstep, voffA); PG8_STAGE(PG8_SB(1, 1), cB + hstep + kstep, voffB);
        PG8_WAIT_V(6); PG8_BAR;
    } else {
        PG8_STAGE(PG8_SB(0, 0), cB, voffB); PG8_STAGE(PG8_SA(0, 0), cA, voffA); PG8_STAGE(PG8_SB(0, 1), cB + hstep, voffB); PG8_STAGE(PG8_SA(0, 1), cA + hstep, voffA);
        if (wr == 1) PG8_BAR;
        PG8_WAIT_V(4); PG8_BAR;
        PG8_STAGE(PG8_SB(1, 0), cB + kstep, voffB); PG8_STAGE(PG8_SA(1, 0), cA + kstep, voffA); PG8_STAGE(PG8_SB(1, 1), cB + hstep + kstep, voffB);
        PG8_WAIT_V(6); PG8_BAR;
    }
    for (;;) {
        const bool has_next = S.next(ui + 1, nxt);
        const char* nA = has_next ? (const char*)g.A + (size_t)nxt.pm * tstep : cA; const char* nB = has_next ? (const char*)g.Bt + (size_t)nxt.pn * tstep : cB;
        for (int t = 0; t < nt; t += 2) {
            const bool last = (t == nt - 2);
            const char* a1 = cA + (size_t)(t + 1) * kstep;
            const char* a2 = last ? nA : cA + (size_t)(t + 2) * kstep; const char* b2 = last ? nB : cB + (size_t)(t + 2) * kstep;
            const char* a3 = a2 + kstep; const char* b3 = b2 + kstep;
            if (last && has_next) S.a_ready(nxt);
            if constexpr (SP2) {
            PG8_LDB(B0, 0, 0); PG8_LDB(B1, 0, 1); PG8_SCHED; PG8_LDA(At, 0, 0); PG8_STAGE(PG8_SA(1, 1), a1 + hstep, voffA);
            PG8_WAIT_V(8); PG8_WAIT_L(0); PG8_BAR; PG8_MMA(0, 0, At, B0); PG8_MMA(0, 1, At, B1); PG8_BAR; PG8_SCHED;
            PG8_LDA(At, 0, 1); PG8_STAGE(PG8_SB(0, 0), b2, voffB); PG8_STAGE(PG8_SB(0, 1), b2 + hstep, voffB); PG8_STAGE(PG8_SA(0, 0), a2, voffA);
            PG8_WAIT_V(8); PG8_WAIT_L(0); PG8_BAR; PG8_MMA(1, 0, At, B0); PG8_MMA(1, 1, At, B1); PG8_BAR; PG8_SCHED;
            PG8_LDB(B0, 1, 0); PG8_LDB(B1, 1, 1); PG8_SCHED; PG8_LDA(At, 1, 0); PG8_STAGE(PG8_SA(0, 1), a2 + hstep, voffA);
            PG8_WAIT_V(8); PG8_WAIT_L(0); PG8_BAR; PG8_MMA(0, 0, At, B0); PG8_MMA(0, 1, At, B1); PG8_BAR; PG8_SCHED;
            PG8_LDA(At, 1, 1); PG8_STAGE(PG8_SB(1, 0), b3, voffB); PG8_STAGE(PG8_SB(1, 1), b3 + hstep, voffB); PG8_STAGE(PG8_SA(1, 0), a3, voffA);
            PG8_WAIT_V(8); PG8_WAIT_L(0); PG8_BAR; PG8_MMA(1, 0, At, B0); PG8_MMA(1, 1, At, B1); PG8_BAR; PG8_SCHED;
            } else {
            PG8_LDB(B0, 0, 0); PG8_SCHED; PG8_LDA(At, 0, 0); PG8_STAGE(PG8_SA(1, 1), a1 + hstep, voffA);
            PG8_WAIT_L(8); PG8_BAR; PG8_WAIT_L(0); PG8_MMA(0, 0, At, B0); PG8_BAR; PG8_SCHED;
            PG8_LDB(B1, 0, 1); PG8_STAGE(PG8_SB(0, 0), b2, voffB);
            PG8_BAR; PG8_WAIT_L(0); PG8_MMA(0, 1, At, B1); PG8_BAR;
            PG8_LDA(At, 0, 1); PG8_STAGE(PG8_SA(0, 0), a2, voffA);
            PG8_BAR; PG8_WAIT_L(0); PG8_MMA(1, 0, At, B0); PG8_BAR; PG8_SCHED;
            PG8_STAGE(PG8_SB(0, 1), b2 + hstep, voffB);
            PG8_WAIT_V(6); PG8_BAR; PG8_MMA(1, 1, At, B1); PG8_BAR;
            PG8_LDB(B0, 1, 0); PG8_SCHED; PG8_LDA(At, 1, 0); PG8_STAGE(PG8_SA(0, 1), a2 + hstep, voffA);
            PG8_WAIT_L(8); PG8_BAR; PG8_WAIT_L(0); PG8_MMA(0, 0, At, B0); PG8_BAR; PG8_SCHED;
            PG8_LDB(B1, 1, 1); PG8_STAGE(PG8_SB(1, 0), b3, voffB);
            PG8_BAR; PG8_WAIT_L(0); PG8_MMA(0, 1, At, B1); PG8_BAR;
            PG8_LDA(At, 1, 1); PG8_STAGE(PG8_SA(1, 0), a3, voffA);
            PG8_BAR; PG8_WAIT_L(0); PG8_MMA(1, 0, At, B0); PG8_BAR; PG8_SCHED;
            PG8_STAGE(PG8_SB(1, 1), b3 + hstep, voffB);
            PG8_WAIT_V(6); PG8_BAR; PG8_MMA(1, 1, At, B1); PG8_BAR;
            }
        }
        if constexpr (F8) { if (F8_ASM) asm volatile("s_nop 15\n\ts_nop 15" ::: "memory"); }
        if constexpr (ALIGN_EPI) { if (wr == 0) PG8_BAR; }
#if defined(EPI_TWICE)
        if constexpr (!Epi::AFTER_DRAIN) { _Pragma("unroll 1") for (int rep_ = 0; rep_ < 2; ++rep_) { E(acc, cur, wr, wc, fr, fq); asm volatile("" ::: "memory"); } S.done(cur); }
#else
        if constexpr (!Epi::AFTER_DRAIN) { E(acc, cur, wr, wc, fr, fq); S.done(cur); }
#endif
        if (!has_next) break;
#pragma unroll
        for (int a = 0; a < 2; ++a)
#pragma unroll
            for (int b = 0; b < 2; ++b)
#pragma unroll
                for (int m = 0; m < 4; ++m)
#pragma unroll
                    for (int n = 0; n < 2; ++n) acc[a][b][m][n] = (f32x4){0.f, 0.f, 0.f, 0.f};
        cur = nxt; cA = nA; cB = nB; ++ui;
        if constexpr (ALIGN_EPI) { if (wr == 1) PG8_BAR; }
    }
    PG8_WAIT_V(0);
    if constexpr (!ALIGN_EPI) { if (wr == 0) PG8_BAR; }
    PG8_BAR;
    if constexpr (Epi::AFTER_DRAIN) { E.fused(acc, cur, wr, wc, fr, fq, lds, wid, lane); S.done(cur); }
#undef PG8_SA
#undef PG8_SB
#undef PG8_STAGE
#undef PG8_LDA
#undef PG8_LDB
#undef PG8_MMA
#undef PG8_WAIT_V
#undef PG8_WAIT_L
#undef PG8_BAR
#undef PG8_SCHED
}
}

#ifndef ATT_NTQ
#define ATT_NTQ 0
#endif
#ifndef ATT_PRIO
#define ATT_PRIO 0
#endif
namespace att {
typedef unsigned short bf16;
typedef short bf16x8 __attribute__((ext_vector_type(8)));
constexpr int D = 128, NW = 8, QBLK = 32, KVBLK = 64, QB = NW * QBLK;
constexpr int SHM_V = KVBLK * D * 2, SHM_K = KVBLK * D * 2;
constexpr int LDS_WS = 2 * SHM_V + 2 * SHM_K;
constexpr int LDS_F = LDS_WS + NW * 64 * 4;
constexpr int LDS_OST = LDS_F + 4096 * 4;
constexpr int LDS_BYTES = LDS_OST + NW * 32 * 64 * 4;
constexpr float SCALE = 0.08838834764831845f;
constexpr float THR = 8.f;

#define KSWZ(row, colB) ((row) * 256 + ((colB) ^ (((row) & 7) << 4)))
#define SBAR() __builtin_amdgcn_sched_barrier(0)
__device__ __forceinline__ int v_st(int k, int c) { const int kk = (k & ~0xC) | ((k & 4) << 1) | ((k & 8) >> 1); return ((kk >> 3) * 4 + (c >> 5)) * 512 + ((kk & 7) * 32 + (c & 31)) * 2; }
__device__ __forceinline__ int v_rd_base(int lane) { return ((lane & 3) << 3) | (((lane >> 2) & 3) << 6) | (((lane >> 4) & 1) << 5) | (((lane >> 5) & 1) << 8); }
constexpr int v_rd_off(int d0, int ks, int half) { return d0 * 512 + ks * 4096 + half * 2048; }
__device__ __forceinline__ int crow(int r, int hi) { return (r & 3) + 8 * (r >> 2) + 4 * hi; }
__device__ __forceinline__ unsigned cvtpk(float lo, float hi) { unsigned r; asm volatile("v_cvt_pk_bf16_f32 %0, %1, %2" : "=v"(r) : "v"(lo), "v"(hi)); return r; }
__device__ __forceinline__ bf16x8 load8(const bf16* p) { return *reinterpret_cast<const bf16x8*>(p); }
__device__ __forceinline__ void mask_tile(f32x16& p0, f32x16& p1, int dq, unsigned W) {
    const float NEG = -__builtin_inff();
#pragma unroll
    for (int r = 0; r < 16; ++r) {
        const int c = (r & 3) + 8 * (r >> 2);
        if ((unsigned)(dq - c) >= W) p0[r] = NEG;
        if ((unsigned)(dq - c - 32) >= W) p1[r] = NEG;
    }
}
__device__ __forceinline__ void partialSM(f32x16& p0, f32x16& p1, float& m_reg, float& mn, float& alpha, bool& dead) {
    float pmax = p0[0]; for (int r = 1; r < 16; ++r) pmax = fmaxf(pmax, p0[r]); for (int r = 0; r < 16; ++r) pmax = fmaxf(pmax, p1[r]);
    { auto rr = __builtin_amdgcn_permlane32_swap(__float_as_uint(pmax), __float_as_uint(pmax), false, false);
      pmax = fmaxf(__uint_as_float(rr[0]), __uint_as_float(rr[1])); }
    constexpr float C2 = 1.4426950408889634f * SCALE;
    dead = __all((pmax - m_reg) * C2 < -40.0f);
    if (dead) { mn = m_reg; alpha = 1.f; return; }
    if (__builtin_expect(__all((pmax - m_reg) * SCALE <= THR), 1)) { mn = m_reg; alpha = 1.f; }
    else { mn = fmaxf(m_reg, pmax); alpha = __builtin_amdgcn_exp2f((m_reg - mn) * C2); m_reg = mn; }
    const float mnL = -mn * C2;
    for (int r = 0; r < 16; ++r) p0[r] = fmaf(p0[r], C2, mnL); for (int r = 0; r < 16; ++r) p1[r] = fmaf(p1[r], C2, mnL);
    for (int r = 0; r < 16; ++r) p0[r] = __builtin_amdgcn_exp2f(p0[r]);
}
__device__ __forceinline__ void finishSM(f32x16& p0, f32x16& p1, float alpha, float& l_reg, bf16x8& pa0, bf16x8& pa1, bf16x8& pa2, bf16x8& pa3) {
    for (int r = 0; r < 16; ++r) p1[r] = __builtin_amdgcn_exp2f(p1[r]);
    float ps = 0; for (int r = 0; r < 16; ++r) ps += p0[r]; for (int r = 0; r < 16; ++r) ps += p1[r];
    { auto rr = __builtin_amdgcn_permlane32_swap(__float_as_uint(ps), __float_as_uint(ps), false, false);
      ps = __uint_as_float(rr[0]) + __uint_as_float(rr[1]); }
    l_reg = l_reg * alpha + ps;
#define PK4(P, B_, OUT) do { unsigned a0 = cvtpk(P[B_+0], P[B_+1]), a1 = cvtpk(P[B_+2], P[B_+3]);                          \
        unsigned b0 = cvtpk(P[B_+4], P[B_+5]), b1 = cvtpk(P[B_+6], P[B_+7]);                                             \
        auto r0 = __builtin_amdgcn_permlane32_swap(a0, b0, false, false); auto r1 = __builtin_amdgcn_permlane32_swap(a1, b1, false, false); \
        u32x4 w = {r0[0], r1[0], r0[1], r1[1]}; OUT = *reinterpret_cast<bf16x8*>(&w); } while (0)
    PK4(p0, 0, pa0); PK4(p0, 8, pa1); PK4(p1, 0, pa2); PK4(p1, 8, pa3);
#undef PK4
}
template <int KB, bool SK, bool FOX>
__device__ __forceinline__ void qkt(f32x16& p0, f32x16& p1, const LAS char* K_lds, int r32, int hi, const bf16x8* qr, bool act, const LAS float* fs  ) {
    if (SK && !act) { const float NEG = -__builtin_inff();
#pragma unroll
        for (int r = 0; r < 16; ++r) { p0[r] = NEG; p1[r] = NEG; } return; }
    if constexpr (FOX) {
#pragma unroll
        for (int g = 0; g < 4; ++g) { const f32x4 a = *(const LAS f32x4*)(fs + 8 * g), b = *(const LAS f32x4*)(fs + 32 + 8 * g);
            p0[4 * g] = a[0]; p0[4 * g + 1] = a[1]; p0[4 * g + 2] = a[2]; p0[4 * g + 3] = a[3];
            p1[4 * g] = b[0]; p1[4 * g + 1] = b[1]; p1[4 * g + 2] = b[2]; p1[4 * g + 3] = b[3]; }
    } else { p0 = f32x16{}; p1 = f32x16{}; }
    const LAS char* kb[4];
#pragma unroll
    for (int dd = 0; dd < 4; ++dd) kb[dd] = K_lds + KB * SHM_K + KSWZ(r32, (dd * 16 + hi * 8) * 2);
#pragma unroll
    for (int d0 = 0; d0 < 8; ++d0) { const LAS char* a = kb[d0 & 3] + (d0 >> 2) * 128;
        bf16x8 b0 = *(const LAS bf16x8*)(a);
        bf16x8 b1 = *(const LAS bf16x8*)(a + 32 * 256);
        if (ATT_PRIO) __builtin_amdgcn_s_setprio(1);
        p0 = __builtin_amdgcn_mfma_f32_32x32x16_bf16(b0, qr[d0], p0, 0, 0, 0);
        p1 = __builtin_amdgcn_mfma_f32_32x32x16_bf16(b1, qr[d0], p1, 0, 0, 0);
        if (ATT_PRIO) __builtin_amdgcn_s_setprio(0); }
}
template <int VB, bool SK>
__device__ __forceinline__ void pv_tile(f32x16* o, int vb0, bf16x8 pa0, bf16x8 pa1, bf16x8 pa2, bf16x8 pa3, bool act) {
    if (SK && !act) return;
#define TRRD(dst, off) asm volatile("ds_read_b64_tr_b16 %0, %1 offset:%2" : "=&v"(dst) : "v"(vb0), "i"(off) : "memory")
#define PV_D0(d0) do { s16x4 l0, l1, l2, l3, h0, h1, h2, h3; constexpr int b_ = VB * SHM_V + v_rd_off(d0, 0, 0);   \
        TRRD(l0, b_); TRRD(h0, b_ + 2048); TRRD(l1, b_ + 4096); TRRD(h1, b_ + 6144); TRRD(l2, b_ + 8192); TRRD(h2, b_ + 10240); TRRD(l3, b_ + 12288); TRRD(h3, b_ + 14336); \
        asm volatile("s_waitcnt lgkmcnt(0)" ::: "memory"); SBAR(); if (ATT_PRIO) __builtin_amdgcn_s_setprio(1);   \
        o[d0] = __builtin_amdgcn_mfma_f32_32x32x16_bf16(pa0, (bf16x8){l0[0], l0[1], l0[2], l0[3], h0[0], h0[1], h0[2], h0[3]}, o[d0], 0, 0, 0);   \
        o[d0] = __builtin_amdgcn_mfma_f32_32x32x16_bf16(pa1, (bf16x8){l1[0], l1[1], l1[2], l1[3], h1[0], h1[1], h1[2], h1[3]}, o[d0], 0, 0, 0);   \
        o[d0] = __builtin_amdgcn_mfma_f32_32x32x16_bf16(pa2, (bf16x8){l2[0], l2[1], l2[2], l2[3], h2[0], h2[1], h2[2], h2[3]}, o[d0], 0, 0, 0);   \
        o[d0] = __builtin_amdgcn_mfma_f32_32x32x16_bf16(pa3, (bf16x8){l3[0], l3[1], l3[2], l3[3], h3[0], h3[1], h3[2], h3[3]}, o[d0], 0, 0, 0); if (ATT_PRIO) __builtin_amdgcn_s_setprio(0); } while (0)
    PV_D0(0); PV_D0(1); PV_D0(2); PV_D0(3);
#undef PV_D0
#undef TRRD
}

template <size_t OQ, size_t OK, size_t OV, size_t OZ, size_t OO> struct Bases { const unsigned char* ws;
    __device__ __forceinline__ const bf16* Q() const { return (const bf16*)(ws + OQ); } __device__ __forceinline__ const bf16* K() const { return (const bf16*)(ws + OK); }
    __device__ __forceinline__ const bf16* V() const { return (const bf16*)(ws + OV); } __device__ __forceinline__ const bf16* Z() const { return (const bf16*)(ws + OZ); }
    __device__ __forceinline__ bf16* O() const { return (bf16*)(ws + OO); } };
struct BlockRef { unsigned qoff; unsigned kvoff; int P0; int jlo; const float* sinks; float qk; };
struct Seam { bf16x8 qr[8]; bf16x8 st_v0, st_v1, st_k0, st_k1; };
__device__ __forceinline__ int swa_jlo(int P0, int W) { const int lowk = P0 - W + 1; return lowk > 0 ? lowk / KVBLK : 0; }
#define UROW(p, k0) ((const char*)(p) + (size_t)((k0) + wid * 4) * (LDKV * 2))
#define VMW() asm volatile("s_waitcnt vmcnt(0)" ::: "memory")
#define VMWN(n) asm volatile("s_waitcnt vmcnt(%0)" :: "i"(n) : "memory")
#define SLOAD_H(Kp, Vp, k0) do { const char* vu_ = UROW(Vp, k0); const char* ku_ = UROW(Kp, k0);                                   \
                         S.st_v0 = *(const bf16x8*)(vu_ + kvlane); S.st_v1 = *(const bf16x8*)(vu_ + 32 * LDKV * 2 + kvlane);              \
                         S.st_k0 = *(const bf16x8*)(ku_ + kvlane); S.st_k1 = *(const bf16x8*)(ku_ + 32 * LDKV * 2 + kvlane); } while (0)
#define SWRITE_HK(bf) do { *(LAS bf16x8*)(K_lds + (bf) * SHM_K + kws) = S.st_k0; *(LAS bf16x8*)(K_lds + (bf) * SHM_K + kws + 32 * 256) = S.st_k1; } while (0)
#define SWRITE_HV(bf) do { *(LAS bf16x8*)(V_lds + (bf) * SHM_V + vst0) = S.st_v0; *(LAS bf16x8*)(V_lds + (bf) * SHM_V + vst1) = S.st_v1; } while (0)
#define SWRITE_H(bf) do { SWRITE_HV(bf); SWRITE_HK(bf); } while (0)
template <bool FOX, int LDQ, int LDKV, class BasesT>
__device__ __forceinline__ void attn_prime(const BasesT& T, const BlockRef& cur, int W, LAS char* lds, Seam& S) {
    const int tid = threadIdx.x, wid = __builtin_amdgcn_readfirstlane(tid >> 6), lane = tid & 63, r32 = lane & 31, hi = lane >> 5;
    const int sr = tid >> 4, sc = (tid & 15) * 8, kws = KSWZ(sr, sc * 2); LAS char* K_lds = lds + 2 * SHM_V;
    const unsigned kvlane = (unsigned)((lane >> 4) * LDKV + sc) * 2u, qlane = (unsigned)(r32 * LDQ + hi * 8) * 2u;
    const int kb0 = FOX ? ((cur.P0 + QB - 1) / KVBLK) * KVBLK : swa_jlo(cur.P0, W) * KVBLK;
    { const char* qu = (const char*)(T.Q() + cur.qoff) + (size_t)wid * (FOX ? QBLK * LDQ * 2 : D * 2);
      for (int d0 = 0; d0 < 8; ++d0) S.qr[d0] = ATT_NTQ ? __builtin_nontemporal_load((const bf16x8*)(qu + d0 * 32 + qlane)) : *(const bf16x8*)(qu + d0 * 32 + qlane); }
    SLOAD_H(T.K() + cur.kvoff, T.V() + cur.kvoff, kb0); VMW(); SWRITE_HK(0);
    __syncthreads();
}
template <bool FOX, int LDQ, int LDKV, int LDO, class BasesT>
__device__ __forceinline__ void attn_block(const BasesT& T, const BlockRef& cur, const BlockRef& nxt, int skv, int W, LAS char* lds, Seam& S) {
    constexpr bool SK = WSKIP_ON && !FOX;
    const int tid = threadIdx.x, wid = __builtin_amdgcn_readfirstlane(tid >> 6), lane = tid & 63, r32 = lane & 31, hi = lane >> 5;
    const int j_lo = FOX ? cur.jlo : swa_jlo(cur.P0, W);
    int j_hi = (cur.P0 + (FOX ? QB : QBLK) - 1) / KVBLK + 1; if (j_hi > skv / KVBLK) j_hi = skv / KVBLK;
    int NT = j_hi - j_lo;
    const int kbn = FOX ? ((nxt.P0 + QB - 1) / KVBLK) * KVBLK : swa_jlo(nxt.P0, W) * KVBLK;
    const int qlo = cur.P0 + (FOX ? wid * QBLK : 0), qm = qlo + r32 - 4 * hi;
    LAS char* V_lds = lds; LAS char* K_lds = lds + 2 * SHM_V;
    LAS float* ws = (LAS float*)(lds + LDS_WS) + wid * 64; LAS float* li_l = ws; LAS float* al_l = ws + 32;
    const LAS float* Fs = (const LAS float*)(lds + LDS_F) + 4 * hi;
    float m_reg = -1e30f, l_reg = 0; f32x16 o[4] = {};
    const int sr = tid >> 4, sc = (tid & 15) * 8, vst0 = v_st(sr, sc), vst1 = v_st(32 + sr, sc), kws = KSWZ(sr, sc * 2);
    const unsigned kvlane = (unsigned)((lane >> 4) * LDKV + sc) * 2u, qlane = (unsigned)(r32 * LDQ + hi * 8) * 2u;
    const int vb0 = (int)(uintptr_t)V_lds + v_rd_base(lane);
    const unsigned kvo = cur.kvoff;
#define Kh (T.K() + kvo)
#define Vh (T.V() + kvo)
#define RESC(a) do { if (__any((a) < 1.f)) { if (hi == 0) al_l[r32] = (a); asm volatile("s_waitcnt lgkmcnt(0)" ::: "memory");              \
                     for (int d_ = 0; d_ < 4; ++d_) for (int r = 0; r < 16; ++r) o[d_][r] *= al_l[crow(r, hi)]; } } while (0)
#define KBASE(t) ((FOX ? (j_hi - 1 - (t)) : (j_lo + (t))) * KVBLK)
#define ACT(t) (KBASE(t) <= qlo + QBLK - 1 && KBASE(t) + KVBLK - 1 >= qlo - W + 1)
#define MASKT(P0_, P1_, t) do { const int kb_ = KBASE(t); if ((!SK || ACT(t)) && (kb_ + KVBLK - 1 > qlo || kb_ <= qlo + QBLK - 1 - W)) mask_tile(P0_, P1_, qm - kb_, (unsigned)W); } while (0)
    constexpr int NQL = 8;
#define SEAM_K0() do { VMWN(NQL); SWRITE_HK(0); SBAR(); } while (0)
    f32x16 pA0, pA1, pB0, pB1; float mnA, mnB, alA, alB; bf16x8 pa0, pa1, pa2, pa3;
    SWRITE_HV(0); SBAR();
    if (NT > 1) { SLOAD_H(Kh, Vh, KBASE(1)); }
    SBAR(); qkt<0, SK, FOX>(pA0, pA1, K_lds, r32, hi, S.qr, ACT(0), Fs + KBASE(0));
    bool deadA = false, deadB = false;
    MASKT(pA0, pA1, 0); partialSM(pA0, pA1, m_reg, mnA, alA, deadA);
    if (NT > 1) { VMW(); SWRITE_H(1); }
    __syncthreads();
#define HALF_STEP(PX0, PX1, mnX, alX, deadX, PY0, PY1, alY, deadY, t, KB, VB, SB) do {                                                      \
        SBAR(); qkt<KB, SK, FOX>(PX0, PX1, K_lds, r32, hi, S.qr, ACT(t), Fs + KBASE(t));                                     \
        if (!deadY) finishSM(PY0, PY1, alY, l_reg, pa0, pa1, pa2, pa3); SBAR();                                               \
        if ((t) + 1 < NT) { SLOAD_H(Kh, Vh, KBASE((t) + 1)); SBAR(); }                                                        \
        if (!deadY) pv_tile<VB, SK>(o, vb0, pa0, pa1, pa2, pa3, ACT((t) - 1)); MASKT(PX0, PX1, (t)); partialSM(PX0, PX1, m_reg, mnX, alX, deadX);  \
        __syncthreads();                                                                                                      \
        if ((t) + 1 < NT) { VMW(); SWRITE_H(SB); }                                                                            \
        RESC(alX); __syncthreads(); } while (0)
    for (int t = 1; t + 1 < NT; t += 2) {
        HALF_STEP(pB0, pB1, mnB, alB, deadB, pA0, pA1, alA, deadA, t, 1, 0, 0);
        HALF_STEP(pA0, pA1, mnA, alA, deadA, pB0, pB1, alB, deadB, t + 1, 0, 1, 1);
        if constexpr (FOX) { if (t == 3 && NT > 6) {
            float mw = m_reg;
#pragma unroll
            for (int o_ = 1; o_ < 32; o_ <<= 1) mw = fminf(mw, __shfl_xor(mw, o_));
            if (lane == 0) li_l[0] = mw;
            asm volatile("s_waitcnt lgkmcnt(0)" ::: "memory"); __syncthreads();
            const LAS float* slot = (const LAS float*)(lds + LDS_WS); float mb = slot[0];
#pragma unroll
            for (int w_ = 1; w_ < NW; ++w_) mb = fminf(mb, slot[w_ * 64]);
            const LAS float* Fb = (const LAS float*)(lds + LDS_F);
            const unsigned long long alive = __ballot(Fb[64 * lane + 63] + cur.qk > mb - (40.0f / (1.4426950408889634f * SCALE) + 16.0f));
            int jd = alive ? (int)__builtin_ctzll(alive) : 63; if (jd < j_lo) jd = j_lo;
            int nt2 = j_hi - jd; if (nt2 < 6) nt2 = 6;
            if (nt2 < NT) NT = nt2;
        } }
    }
    const bool even = (NT & 1) == 0;
    if (even) { SBAR(); qkt<1, SK, FOX>(pB0, pB1, K_lds, r32, hi, S.qr, ACT(NT - 1), Fs + KBASE(NT - 1)); SBAR(); }
    SLOAD_H(T.K() + nxt.kvoff, T.V() + nxt.kvoff, kbn); SBAR();
    { const char* qu = (const char*)(T.Q() + nxt.qoff) + (size_t)wid * (FOX ? QBLK * LDQ * 2 : D * 2);
#pragma unroll
      for (int d0 = 0; d0 < 8; ++d0) S.qr[d0] = ATT_NTQ ? __builtin_nontemporal_load((const bf16x8*)(qu + d0 * 32 + qlane)) : *(const bf16x8*)(qu + d0 * 32 + qlane); }
    SBAR();
    if (!deadA) finishSM(pA0, pA1, alA, l_reg, pa0, pa1, pa2, pa3); SBAR();
    if (!deadA) pv_tile<0, SK>(o, vb0, pa0, pa1, pa2, pa3, ACT(even ? NT - 2 : NT - 1));
    if (even) { MASKT(pB0, pB1, NT - 1); partialSM(pB0, pB1, m_reg, mnB, alB, deadB); __syncthreads(); RESC(alB);
        if (!deadB) { finishSM(pB0, pB1, alB, l_reg, pa0, pa1, pa2, pa3); SBAR(); pv_tile<1, SK>(o, vb0, pa0, pa1, pa2, pa3, ACT(NT - 1)); } }
    SBAR(); SEAM_K0();
    const int c8 = lane & 7, rr = lane >> 3;
    u32x4 zq[2][4];
    { const char* Zu = (const char*)(T.Z() + cur.qoff) + (size_t)wid * (FOX ? QBLK * LDO * 2 : D * 2) + (unsigned)(rr * LDO + c8 * 8) * 2u;
#pragma unroll
      for (int h2 = 0; h2 < 2; ++h2)
#pragma unroll
          for (int j = 0; j < 4; ++j) zq[h2][j] = ATT_NTQ ? __builtin_nontemporal_load((const u32x4*)(Zu + j * (8 * LDO * 2) + h2 * 128)) : *(const u32x4*)(Zu + j * (8 * LDO * 2) + h2 * 128); }
    if constexpr (!FOX) l_reg += __builtin_amdgcn_exp2f(cur.sinks[wid] * 1.4426950408889634f - m_reg * (1.4426950408889634f * SCALE));
    if (hi == 0) li_l[r32] = l_reg; asm volatile("s_waitcnt lgkmcnt(0)" ::: "memory");
    float rli[16];
#pragma unroll
    for (int r = 0; r < 16; ++r) rli[r] = __builtin_amdgcn_rcpf(li_l[crow(r, hi)]) * ((!FOX && FP8_G4) ? F8_OSCALE : 1.0f);
    LAS float* ost = (LAS float*)(lds + LDS_OST) + wid * (32 * 64);
    char* Ou = (char*)(T.O() + cur.qoff) + (size_t)wid * (FOX ? QBLK * LDO * 2 : D * 2) + (unsigned)(rr * LDO + c8 * 8) * 2u;
    char* Ou8 = (char*)T.O() + cur.qoff + (size_t)wid * D + (unsigned)(rr * LDO + c8 * 8); (void)Ou8;
#pragma unroll
    for (int h2 = 0; h2 < 2; ++h2) {
#pragma unroll
        for (int r = 0; r < 16; ++r) { const int row = crow(r, hi); ost[row * 64 + r32] = o[2 * h2][r] * rli[r]; ost[row * 64 + 32 + r32] = o[2 * h2 + 1][r] * rli[r]; }
        asm volatile("s_waitcnt lgkmcnt(0)" ::: "memory");
#pragma unroll
        for (int j = 0; j < 4; ++j) { const LAS float* sp = ost + (rr + 8 * j) * 64 + c8 * 8; const f32x4 a = *(const LAS f32x4*)sp, bq = *(const LAS f32x4*)(sp + 4); const u32x4 z = zq[h2][j];
            u32x4 w; w.x = cvtpk(a[0] * __uint_as_float(z.x << 16), a[1] * __uint_as_float(z.x & 0xffff0000u)); w.y = cvtpk(a[2] * __uint_as_float(z.y << 16), a[3] * __uint_as_float(z.y & 0xffff0000u));
            w.z = cvtpk(bq[0] * __uint_as_float(z.z << 16), bq[1] * __uint_as_float(z.z & 0xffff0000u)); w.w = cvtpk(bq[2] * __uint_as_float(z.w << 16), bq[3] * __uint_as_float(z.w & 0xffff0000u));
            if constexpr (!FOX && FP8_G4) {
#define C8_(v) __builtin_amdgcn_fmed3f((v), -448.0f, 448.0f)
                u32x2 w8; { int t_ = __builtin_amdgcn_cvt_pk_fp8_f32(C8_(a[0] * __uint_as_float(z.x << 16)), C8_(a[1] * __uint_as_float(z.x & 0xffff0000u)), 0, false);
                            t_ = __builtin_amdgcn_cvt_pk_fp8_f32(C8_(a[2] * __uint_as_float(z.y << 16)), C8_(a[3] * __uint_as_float(z.y & 0xffff0000u)), t_, true); w8.x = (unsigned)t_; }
                          { int t_ = __builtin_amdgcn_cvt_pk_fp8_f32(C8_(bq[0] * __uint_as_float(z.z << 16)), C8_(bq[1] * __uint_as_float(z.z & 0xffff0000u)), 0, false);
                            t_ = __builtin_amdgcn_cvt_pk_fp8_f32(C8_(bq[2] * __uint_as_float(z.w << 16)), C8_(bq[3] * __uint_as_float(z.w & 0xffff0000u)), t_, true); w8.y = (unsigned)t_; }
#undef C8_
                *(u32x2*)(Ou8 + j * (8 * LDO) + h2 * 64) = w8;
            } else
            *(u32x4*)(Ou + j * (8 * LDO * 2) + h2 * 128) = w; }
        asm volatile("s_waitcnt lgkmcnt(0)" ::: "memory");
    }
    __syncthreads();
#undef Kh
#undef Vh
#undef RESC
#undef KBASE
#undef ACT
#undef MASKT
#undef SEAM_K0
#undef HALF_STEP
}
#undef UROW
#undef VMW
#undef VMWN
#undef SLOAD_H
#undef SWRITE_HK
#undef SWRITE_HV
#undef SWRITE_H
#undef SBAR
#undef KSWZ
}

#define XB_TMO      128
#define XB_XCNT(j)  (256  + 64 * (j))
#define XB_XSUB(j)  (1280 + 64 * (j))
#define XB_XGEN(j)  (2304 + 64 * (j))
#define XB_TOP      3328
#define XB_TOPGEN   3392
#define XCD_BAR_WORDS 3456
#define XB_SPIN_CAP (1u << 18)
#ifndef BAR_FLAT
#define BAR_FLAT 0
#endif

__device__ __forceinline__ unsigned xb_ld(unsigned* p)              { return __hip_atomic_load(p, __ATOMIC_RELAXED, __HIP_MEMORY_SCOPE_AGENT); }
__device__ __forceinline__ unsigned xb_add(unsigned* p, unsigned v) { return __hip_atomic_fetch_add(p, v, __ATOMIC_RELAXED, __HIP_MEMORY_SCOPE_AGENT); }
__device__ __forceinline__ unsigned xb_xcc_id() { return (unsigned)__builtin_amdgcn_s_getreg((3 << 11) | 20) & 0xFu; }
#define XB_SPIN(cond, bar) do { unsigned _sp = 0; while (cond) { __builtin_amdgcn_s_sleep(1); \
    if ((++_sp & 255u) == 0u) { if (xb_ld(&(bar)[XB_TMO])) break; if (_sp > XB_SPIN_CAP) { atomicAdd(&(bar)[XB_TMO], 1u); break; } } } } while (0)

struct XcdBarrier {
    unsigned* bar; unsigned x;
    volatile LAS unsigned* st;
};

__device__ __forceinline__ XcdBarrier xcd_barrier_post(unsigned* bar, volatile LAS unsigned* st) {
    XcdBarrier b; b.bar = bar; b.x = xb_xcc_id(); b.st = st;
    if (threadIdx.x == 0) (void)xb_add(&bar[XB_XCNT(b.x)], 1u);
    return b;
}
__device__ __forceinline__ void xcd_barrier_complete(unsigned* bar, unsigned x, unsigned& nloc, unsigned& nx) {
    const unsigned G = gridDim.x * gridDim.y * gridDim.z;
    unsigned sum, cnt, mine, sp = 0u;
    for (;;) {
        sum = 0u; cnt = 0u; mine = 0u;
#pragma unroll
        for (unsigned j = 0; j < 16; ++j) { const unsigned c = xb_ld(&bar[XB_XCNT(j)]); sum += c; cnt += (c > 0u) ? 1u : 0u; mine = (j == x) ? c : mine; }
        if (sum == G) break;
        __builtin_amdgcn_s_sleep(1);
        if ((++sp & 255u) == 0u) { if (xb_ld(&bar[XB_TMO])) break; if (sp > XB_SPIN_CAP) { atomicAdd(&bar[XB_TMO], 1u); break; } }
    }
    nloc = mine > 0u ? mine : 1u; nx = cnt > 0u ? cnt : 1u;
}

__device__ __forceinline__ void xcd_barrier(const XcdBarrier& b) {
    asm volatile("s_waitcnt vmcnt(0)" ::: "memory");
    __syncthreads();
    if (threadIdx.x == 0) {
        unsigned* bar = b.bar;
        __builtin_amdgcn_s_waitcnt(0);
        unsigned nloc = b.st[0], nx = b.st[1];
        if (nloc == 0u) { xcd_barrier_complete(bar, b.x, nloc, nx); b.st[0] = nloc; b.st[1] = nx; }
        const unsigned old = xb_add(&bar[XB_XSUB(b.x)], 1u);
        const unsigned gen = old / nloc;
        if (old + 1u == (gen + 1u) * nloc) {
            __builtin_amdgcn_fence(__ATOMIC_RELEASE, "agent");
            asm volatile("s_waitcnt vmcnt(0)" ::: "memory");
            const unsigned og = xb_add(&bar[XB_TOP], 1u);
            const unsigned tg = og / nx;
            if (og + 1u == (tg + 1u) * nx) xb_add(&bar[XB_TOPGEN], 1u);
            else XB_SPIN(xb_ld(&bar[XB_TOPGEN]) == tg, bar);
            __builtin_amdgcn_fence(__ATOMIC_ACQUIRE, "agent");
            if (!BAR_FLAT) xb_add(&bar[XB_XGEN(b.x)], 1u);
            asm volatile("s_waitcnt vmcnt(0)" ::: "memory");
        } else {
            if (BAR_FLAT) XB_SPIN(xb_ld(&bar[XB_TOPGEN]) == gen, bar);
            else XB_SPIN(xb_ld(&bar[XB_XGEN(b.x)]) == gen, bar);
            __builtin_amdgcn_fence(__ATOMIC_ACQUIRE, "agent");
            asm volatile("s_waitcnt vmcnt(0)" ::: "memory");
        }
    }
    __syncthreads();
}


constexpr size_t MiB = 1u << 20;
constexpr size_t WS_CTL = 0, CTL_ZERO_BYTES = 1 * MiB;
constexpr size_t WS_SLAB = 1 * MiB;
constexpr size_t WS_MOD = 3 * MiB;
constexpr size_t WS_ROPE = 4 * MiB;
constexpr size_t WS_LOGF = 6 * MiB;
constexpr size_t WS_WFT = 7 * MiB;
constexpr size_t WS_W1T = 8 * MiB;
constexpr size_t WS_W2T = 136 * MiB;
constexpr size_t WS_W3T = 168 * MiB;
constexpr size_t WS_WKVT = 232 * MiB;
constexpr size_t WS_W4T = 240 * MiB;
constexpr size_t WS_HB = 272 * MiB;
constexpr size_t WS_KVN = 336 * MiB;
constexpr size_t WS_Q = 400 * MiB, WS_K = 464 * MiB, WS_V = 528 * MiB, WS_Z = 592 * MiB;
constexpr size_t WS_OG = 656 * MiB;
constexpr size_t WS_H1 = 720 * MiB;
constexpr size_t WS_KV1 = 848 * MiB;
constexpr size_t WS_FDBG = 864 * MiB;
constexpr size_t WS_W3I = 866 * MiB;
constexpr size_t WS_W1I = 898 * MiB;
constexpr size_t WS_H0I = 930 * MiB;
constexpr size_t WS_END = 962 * MiB;
constexpr size_t WS_SW = 256 * 1024;
constexpr size_t WS_SA1 = 384 * 1024;
constexpr size_t WS_SA0 = 448 * 1024;
constexpr int CW_BAR = 4096;
constexpr int CW_QUEUE = 8192;
constexpr int CW_NORM = 8448;

constexpr int LDS_BYTES = 155648;
constexpr int MISC_OFF = LDS_BYTES - 256;
constexpr int NWAVES = 8, NTHR = 512;
static_assert(att::LDS_BYTES <= MISC_OFF && 131072 <= MISC_OFF, "LDS map");

struct Params { const float* in[14]; float* out; unsigned char* ws; int ph_lo, ph_hi; };
enum { I_X = 0, I_C, I_NORMG, I_ADAW, I_ADAB, I_AWIN, I_ABF, I_AWOUT, I_KVG, I_KVW, I_BWIN, I_SINK, I_BWOUT, I_FING };

struct Frame { LAS unsigned char* lds; int tid, lane, wave, vcu, G; };

__device__ __forceinline__ float wave_sum(float v) {
#pragma unroll
    for (int o = 1; o < 64; o <<= 1) v += __shfl_xor(v, o);
    return v;
}
__device__ __forceinline__ unsigned f2bf(float f) { unsigned u = __builtin_bit_cast(unsigned, f); return (u + 0x7fffu + ((u >> 16) & 1u)) >> 16; }
__device__ __forceinline__ unsigned pk2(float lo, float hi) { return f2bf(lo) | (f2bf(hi) << 16); }
__device__ __forceinline__ float bf2f(unsigned short b) { return __uint_as_float((unsigned)b << 16); }

#ifndef EMUI8_G1
#define EMUI8_G1 0
#endif
#ifndef EMUI8_SMOOTH
#define EMUI8_SMOOTH 0
#endif
#ifndef EMUI8_C1
#define EMUI8_C1 (1 << 30)
#endif
#ifndef EMUI8_C0
#define EMUI8_C0 0
#endif
#ifndef EMUI8_G3
#define EMUI8_G3 0
#endif
#ifndef EMU8_G3
#define EMU8_G3 0
#endif
typedef float f32x2_ __attribute__((ext_vector_type(2)));
__device__ __forceinline__ void rnd8_2(float& a, float& b, float sc) { const int w = __builtin_amdgcn_cvt_pk_fp8_f32(a * sc, b * sc, 0, false); const f32x2_ r = __builtin_amdgcn_cvt_pk_f32_fp8(w, false); a = r[0] / sc; b = r[1] / sc; }
#ifndef P0_NT
#define P0_NT 1
#endif
#ifndef P0_NTS
#define P0_NTS 0
#endif
#if P0_NT
#define P0_LOAD(p) __builtin_nontemporal_load(p)
#else
#define P0_LOAD(p) (*(p))
#endif
#if P0_NTS
#define P0_STORE(p, v) __builtin_nontemporal_store(v, p)
#else
#define P0_STORE(p, v) (*(p) = (v))
#endif
#if defined(TR128)
template <class RowMap>
__device__ __forceinline__ void transpose_item(const float* W, int ldw, int K, int k0, int c0, bf16_t* WT, RowMap rowmap, LAS float* scr, int lane) {
    const int kk = lane >> 3, nn = (lane & 7) * 4;
    f32x4 v[16];
#pragma unroll
    for (int i = 0; i < 16; ++i) v[i] = *(const GAS f32x4*)(W + (size_t)(k0 + 8 * i + kk) * ldw + c0 + nn);
#pragma unroll
    for (int i = 0; i < 16; ++i) { LAS float* s = scr + (8 * i + kk) * 33 + nn; s[0] = v[i][0]; s[1] = v[i][1]; s[2] = v[i][2]; s[3] = v[i][3]; }
    asm volatile("s_waitcnt lgkmcnt(0)" ::: "memory");
    const int c = lane & 15, nr = lane >> 4;
#pragma unroll
    for (int j = 0; j < 8; ++j) { const int n = nr + 4 * j; const LAS float* s = scr + (8 * c) * 33 + n;
        u32x4 o; o.x = pk2(s[0 * 33], s[1 * 33]); o.y = pk2(s[2 * 33], s[3 * 33]); o.z = pk2(s[4 * 33], s[5 * 33]); o.w = pk2(s[6 * 33], s[7 * 33]);
        *(GAS u32x4*)(WT + (size_t)rowmap(c0 + n) * K + k0 + 8 * c) = o; }
    asm volatile("s_waitcnt lgkmcnt(0)" ::: "memory");
}
#define TR_KB 128
#define TR_NB 32
#define TR_SCR (128 * 33)
#else
template <class RowMap, bool EMU8 = false, bool EMUI8 = false>
__device__ __forceinline__ void transpose_item(const float* W, int ldw, int K, int k0, int c0, bf16_t* WT, RowMap rowmap, LAS float* scr, int lane) {
    const int kk = lane >> 4, nn = (lane & 15) * 4;
    f32x4 v[16];
#pragma unroll
    for (int i = 0; i < 16; ++i) v[i] = P0_LOAD((const GAS f32x4*)(W + (size_t)(k0 + 4 * i + kk) * ldw + c0 + nn));
#pragma unroll
    for (int i = 0; i < 16; ++i) { LAS float* s = scr + (4 * i + kk) * 65 + nn; s[0] = v[i][0]; s[1] = v[i][1]; s[2] = v[i][2]; s[3] = v[i][3]; }
    asm volatile("s_waitcnt lgkmcnt(0)" ::: "memory");
    const int c = lane & 7, nr = lane >> 3;
#pragma unroll
    for (int j = 0; j < 8; ++j) { const int n = nr + 8 * j; const LAS float* s = scr + (8 * c) * 65 + n;
        float e_[8];
#pragma unroll
        for (int q_ = 0; q_ < 8; ++q_) e_[q_] = s[q_ * 65];
        if (EMU8) { rnd8_2(e_[0], e_[1], 64.f); rnd8_2(e_[2], e_[3], 64.f); rnd8_2(e_[4], e_[5], 64.f); rnd8_2(e_[6], e_[7], 64.f); }
#if EMUI8_G1 || EMUI8_G3
        if (EMUI8 && (c0 + n) >= EMUI8_C0 && (c0 + n) < EMUI8_C1) {
#pragma unroll
            for (int q_ = 0; q_ < 8; ++q_) e_[q_] = rintf(__builtin_amdgcn_fmed3f(e_[q_] * (127.0f * 64.0f / 4.2f), -127.0f, 127.0f)) * (4.2f / (127.0f * 64.0f)); }
#endif
        u32x4 o; o.x = pk2(e_[0], e_[1]); o.y = pk2(e_[2], e_[3]); o.z = pk2(e_[4], e_[5]); o.w = pk2(e_[6], e_[7]);
        P0_STORE((GAS u32x4*)(WT + (size_t)rowmap(c0 + n) * K + k0 + 8 * c), o); }
    asm volatile("s_waitcnt lgkmcnt(0)" ::: "memory");
}
__device__ __forceinline__ unsigned pk4_fp8(float a, float b, float c, float d) { a = __builtin_amdgcn_fmed3f(a, -448.0f, 448.0f); b = __builtin_amdgcn_fmed3f(b, -448.0f, 448.0f); c = __builtin_amdgcn_fmed3f(c, -448.0f, 448.0f); d = __builtin_amdgcn_fmed3f(d, -448.0f, 448.0f);
    int w = __builtin_amdgcn_cvt_pk_fp8_f32(a, b, 0, false); w = __builtin_amdgcn_cvt_pk_fp8_f32(c, d, w, true); return (unsigned)w; }
template <class RowMap>
__device__ __forceinline__ void transpose_item8(const float* W, int ldw, int K, int k0, int c0, unsigned char* WT8, RowMap rowmap, float sc, LAS float* scr, int lane) {
    const int kk = lane >> 4, nn = (lane & 15) * 4;
    f32x4 v[16];
#pragma unroll
    for (int i = 0; i < 16; ++i) v[i] = P0_LOAD((const GAS f32x4*)(W + (size_t)(k0 + 4 * i + kk) * ldw + c0 + nn));
#pragma unroll
    for (int i = 0; i < 16; ++i) { LAS float* s = scr + (4 * i + kk) * 65 + nn; s[0] = v[i][0]; s[1] = v[i][1]; s[2] = v[i][2]; s[3] = v[i][3]; }
    asm volatile("s_waitcnt lgkmcnt(0)" ::: "memory");
    const int c = lane & 7, nr = lane >> 3;
#pragma unroll
    for (int j = 0; j < 8; ++j) { const int n = nr + 8 * j; const LAS float* s = scr + (8 * c) * 65 + n;
        u32x2 o; o.x = pk4_fp8(s[0 * 65] * sc, s[1 * 65] * sc, s[2 * 65] * sc, s[3 * 65] * sc); o.y = pk4_fp8(s[4 * 65] * sc, s[5 * 65] * sc, s[6 * 65] * sc, s[7 * 65] * sc);
        *(GAS u32x2*)(WT8 + (size_t)rowmap(c0 + n) * K + k0 + 8 * c) = o; }
    asm volatile("s_waitcnt lgkmcnt(0)" ::: "memory");
}
#define TR_KB 64
#define TR_NB 64
#define TR_SCR (64 * 65)
#endif
__device__ __forceinline__ unsigned pk4_i8(float a, float b, float c, float d) {
    const int ia = (int)rintf(__builtin_amdgcn_fmed3f(a, -127.f, 127.f)), ib = (int)rintf(__builtin_amdgcn_fmed3f(b, -127.f, 127.f)), ic = (int)rintf(__builtin_amdgcn_fmed3f(c, -127.f, 127.f)), id = (int)rintf(__builtin_amdgcn_fmed3f(d, -127.f, 127.f));
    return (unsigned)(ia & 255) | ((unsigned)(ib & 255) << 8) | ((unsigned)(ic & 255) << 16) | ((unsigned)id << 24);
}
#ifndef RQ_ROWS
#define RQ_ROWS 4
#endif
__device__ __forceinline__ void requant_rows(const Frame& F, const bf16_t* src, unsigned char* dst, float* sw, int nrows) {
    const int gw = F.vcu * NWAVES + F.wave, NGW = F.G * NWAVES;
#pragma unroll 1
    for (int row = gw; row < nrows; row += RQ_ROWS * NGW) {
        u32x4 v[RQ_ROWS][8];
#pragma unroll
        for (int r = 0; r < RQ_ROWS; ++r) { const GAS u32x4* sp = (const GAS u32x4*)(src + (size_t)(row + r * NGW) * DM) + F.lane;
#pragma unroll
            for (int j = 0; j < 8; ++j) v[r][j] = __builtin_nontemporal_load(sp + 64 * j); }
#pragma unroll
        for (int r = 0; r < RQ_ROWS; ++r) { unsigned am = 0u;
#pragma unroll
            for (int j = 0; j < 8; ++j)
#pragma unroll
                for (int e = 0; e < 4; ++e) { const unsigned w_ = v[r][j][e]; const unsigned a_ = (w_ << 16) & 0x7fffffffu, b_ = w_ & 0x7fff0000u; am = am > a_ ? am : a_; am = am > b_ ? am : b_; }
#pragma unroll
            for (int o = 1; o < 64; o <<= 1) { const unsigned n_ = (unsigned)__shfl_xor((int)am, o); am = am > n_ ? am : n_; }
            const float mx = __uint_as_float(am); const float qs = mx > 0.f ? 127.0f / mx : 0.f;
            if (F.lane == 0) sw[row + r * NGW] = mx * (1.0f / 127.0f);
            GAS u32x2* dp = (GAS u32x2*)(dst + (size_t)(row + r * NGW) * DM) + F.lane;
#pragma unroll
            for (int j = 0; j < 8; ++j) { u32x2 o;
                o.x = pk4_i8(__uint_as_float(v[r][j].x << 16) * qs, __uint_as_float(v[r][j].x & 0xffff0000u) * qs, __uint_as_float(v[r][j].y << 16) * qs, __uint_as_float(v[r][j].y & 0xffff0000u) * qs);
                o.y = pk4_i8(__uint_as_float(v[r][j].z << 16) * qs, __uint_as_float(v[r][j].z & 0xffff0000u) * qs, __uint_as_float(v[r][j].w << 16) * qs, __uint_as_float(v[r][j].w & 0xffff0000u) * qs);
                dp[64 * j] = o; } }
    }
}
struct RowId { __device__ __forceinline__ int operator()(int c) const { return c; } };
struct RowRope { int lim; __device__ __forceinline__ int operator()(int c) const { if (c >= lim) return c; const int j = c & 127, jj = j & 63; return (c & ~127) + 8 * (jj >> 2) + ((j >> 6) << 2) + (jj & 3); } };

__device__ __forceinline__ void p0_prologue(const Frame& F, const Params& P) {
    unsigned char* ws = P.ws;
#ifndef P0A_REP
#define P0A_REP 1
#endif
    _Pragma("unroll 1") for (int repa_ = 0; repa_ < P0A_REP; ++repa_)
    {
        LAS float* sc = (LAS float*)F.lds;
        LAS float* red = (LAS float*)(F.lds + 32768);
        const float* c = P.in[I_C];
        for (int i = F.tid; i < 2 * DM; i += NTHR) { const float v = c[i]; sc[i] = v / (1.0f + __expf(-v)); }
        __syncthreads();
        float* slab = (float*)(ws + WS_SLAB);
        for (int t = F.vcu; t < 768; t += F.G) {
            const int cg = t % 96, ks = t / 96, l = cg / 48, n0 = (cg % 48) * 256;
            const float* Wp = P.in[I_ADAW] + (size_t)l * DM * MOD + (size_t)(ks * 512 + F.wave * 64) * MOD + n0 + 4 * F.lane;
            const LAS float* s0 = sc + ks * 512 + F.wave * 64; const LAS float* s1 = s0 + DM;
            f32x4 a0 = (f32x4){0.f, 0.f, 0.f, 0.f}, a1 = a0;
#ifndef ADA_UNROLL
#define ADA_UNROLL 16
#endif
#if defined(ADA_DMA)
            { LAS unsigned char* dbuf = F.lds + 49152 + F.wave * 8192;
              const char* gsrc = (const char*)Wp;
#define ADA_ISSUE(c_) do { _Pragma("unroll") for (int r_ = 0; r_ < 4; ++r_) \
                __builtin_amdgcn_global_load_lds((const unsigned*)(gsrc + (size_t)((c_) * 4 + r_) * (MOD * 4)), (LAS unsigned*)(dbuf + ((c_) & 1) * 4096 + r_ * 1024), 16, 0, 0); } while (0)
              ADA_ISSUE(0); ADA_ISSUE(1);
#pragma unroll 1
              for (int c_ = 0; c_ < 16; ++c_) {
                  if (c_ < 15) asm volatile("s_waitcnt vmcnt(4)" ::: "memory"); else asm volatile("s_waitcnt vmcnt(0)" ::: "memory");
                  const LAS unsigned char* bb = dbuf + (c_ & 1) * 4096 + F.lane * 16;
#pragma unroll
                  for (int r_ = 0; r_ < 4; ++r_) { const f32x4 w = *(const LAS f32x4*)(bb + r_ * 1024); a0 += w * s0[c_ * 4 + r_]; a1 += w * s1[c_ * 4 + r_]; }
                  asm volatile("s_waitcnt lgkmcnt(0)" ::: "memory");
                  if (c_ + 2 < 16) ADA_ISSUE(c_ + 2);
              }
#undef ADA_ISSUE
            }
#else
#pragma unroll ADA_UNROLL
            for (int kk = 0; kk < 64; ++kk) { const f32x4 w = P0_LOAD((const GAS f32x4*)(Wp + (size_t)kk * MOD)); a0 += w * s0[kk]; a1 += w * s1[kk]; }
#endif
            *(LAS f32x4*)(red + (F.wave * 2 + 0) * 256 + 4 * F.lane) = a0; *(LAS f32x4*)(red + (F.wave * 2 + 1) * 256 + 4 * F.lane) = a1;
            __syncthreads();
            { const int b = F.tid >> 8, col = F.tid & 255; float s = 0.f;
#pragma unroll
              for (int w = 0; w < 8; ++w) s += red[(w * 2 + b) * 256 + col];
              slab[(size_t)((ks * 2 + l) * 2 + b) * MOD + n0 + col] = s; }
            __syncthreads();
        }
    }
    {
        LAS float* scr = (LAS float*)F.lds + F.wave * TR_SCR;
        const int gw = F.vcu * NWAVES + F.wave, NGW = F.G * NWAVES;
        constexpr int KBL = DM / TR_KB;
        constexpr int I1 = KBL * (N1 / TR_NB), I2 = KBL * (DM / TR_NB), IKV = KBL * (NKV2 / TR_NB), I3 = KBL * (N3 / TR_NB), I4 = I2;
        constexpr int NIT = I1 + I2 + IKV + I3 + I4;
        for (int it = gw; it < NIT; it += NGW) {
            int r = it;
            if (r < I2) { transpose_item(P.in[I_AWOUT], DM, DM, (r % KBL) * TR_KB, (r / KBL) * TR_NB, (bf16_t*)(ws + WS_W2T), RowId{}, scr, F.lane); continue; } r -= I2;
            if (r < IKV) { transpose_item(P.in[I_KVW], NKV2, DM, (r % KBL) * TR_KB, (r / KBL) * TR_NB, (bf16_t*)(ws + WS_WKVT), RowRope{KVW}, scr, F.lane); continue; } r -= IKV;
#if I8_G3
            if (r < I3) { transpose_item(P.in[I_BWIN], N3, DM, (r % KBL) * TR_KB, (r / KBL) * TR_NB, (bf16_t*)(ws + WS_W3T), RowRope{DM}, scr, F.lane); continue; } r -= I3;
#elif FP8_G3
            if (r < I3) { transpose_item8(P.in[I_BWIN], N3, DM, (r % KBL) * TR_KB, (r / KBL) * TR_NB, ws + WS_W3T, RowRope{DM}, F8_WSCALE, scr, F.lane); continue; } r -= I3;
#else
            if (r < I3) { transpose_item<RowRope, EMU8_G3 != 0, EMUI8_G3 != 0>(P.in[I_BWIN], N3, DM, (r % KBL) * TR_KB, (r / KBL) * TR_NB, (bf16_t*)(ws + WS_W3T), RowRope{DM}, scr, F.lane); continue; } r -= I3;
#endif
#if FP8_G4
            if (r < I4) { transpose_item8(P.in[I_BWOUT], DM, DM, (r % KBL) * TR_KB, (r / KBL) * TR_NB, ws + WS_W4T, RowId{}, F8_WSCALE, scr, F.lane); continue; } r -= I4;
#else
            if (r < I4) { transpose_item(P.in[I_BWOUT], DM, DM, (r % KBL) * TR_KB, (r / KBL) * TR_NB, (bf16_t*)(ws + WS_W4T), RowId{}, scr, F.lane); continue; } r -= I4;
#endif
            transpose_item<RowId, false, EMUI8_G1 != 0>(P.in[I_AWIN], N1F, DM, (r % KBL) * TR_KB, (r / KBL) * TR_NB, (bf16_t*)(ws + WS_W1T), RowId{}, scr, F.lane);
        }
    }
    {
        const int gt = F.vcu * NTHR + F.tid, NGT = F.G * NTHR;
        bf16_t* wft = (bf16_t*)(ws + WS_WFT); const float* W = P.in[I_AWIN];
        for (int i = gt; i < NH * DM; i += NGT) { const int k = i >> 5, n = i & 31; wft[(size_t)n * DM + k] = (bf16_t)f2bf(W[(size_t)k * N1F + N1 + n]); }
        float* cs = (float*)(ws + WS_ROPE); float* sn = cs + SEQ * 64;
        for (int i = gt; i < SEQ * 64; i += NGT) {
            const int pos = i >> 6, j = i & 63;
            double th = 1.0; for (int q = 0; q < j; ++q) th *= 0.8659643233600653523531691834202299819398;
            const double t2 = th * th; double cc = 1.0, ss = th, tc = 1.0, ts = th;
#pragma unroll
            for (int q = 1; q <= 11; ++q) { tc *= t2 * (-1.0 / (double)((2 * q - 1) * (2 * q))); ts *= t2 * (-1.0 / (double)((2 * q) * (2 * q + 1))); cc += tc; ss += ts; }
            double rc = 1.0, rs = 0.0;
            for (int mbit = 0; mbit < 12; ++mbit) {
                if ((pos >> mbit) & 1) { const double nc = rc * cc - rs * ss, ns = rs * cc + rc * ss; rc = nc; rs = ns; }
                const double c2 = cc * cc - ss * ss, s2 = 2.0 * ss * cc; cc = c2; ss = s2;
            }
            cs[i] = (float)rc; sn[i] = (float)rs;
        }
    }
}

__device__ __forceinline__ void p1_norm0(const Frame& F, const Params& P) {
    unsigned char* ws = P.ws;
    const float* slab = (const float*)(ws + WS_SLAB); float* mod = (float*)(ws + WS_MOD);
    for (int i = F.vcu * NTHR + F.tid; i < 2 * 2 * MOD; i += F.G * NTHR) {
        const int n = i % MOD, lb = i / MOD, l = lb >> 1; float s = P.in[I_ADAB][l * MOD + n];
#pragma unroll
        for (int ks = 0; ks < 8; ++ks) s += slab[(size_t)(ks * 4 + lb) * MOD + n];
        mod[i] = s;
    }
    LAS float* gs = (LAS float*)F.lds; LAS float* sh = gs + DM;
    LAS float* red = sh + DM;
    bf16_t* h0 = (bf16_t*)(ws + WS_HB); const bf16_t* wft = (const bf16_t*)(ws + WS_WFT); float* logf = (float*)(ws + WS_LOGF);
    for (int rb = F.vcu; rb < M / 32; rb += F.G) {
        const int row0 = rb * 32, b = row0 / SEQ;
        __syncthreads();
        for (int k = F.tid; k < DM; k += NTHR) {
            float s_sh = P.in[I_ADAB][k], s_sc = P.in[I_ADAB][DM + k];
#pragma unroll
            for (int ks = 0; ks < 8; ++ks) { const float* sl = slab + (size_t)(ks * 4 + b) * MOD; s_sh += sl[k]; s_sc += sl[DM + k]; }
            gs[k] = P.in[I_NORMG][k] * (1.0f + s_sc); sh[k] = s_sh;
#if EMUI8_G1 && EMUI8_SMOOTH
            { float o_sc = P.in[I_ADAB][DM + k];
#pragma unroll
              for (int ks = 0; ks < 8; ++ks) o_sc += (slab + (size_t)(ks * 4 + (1 - b)) * MOD)[DM + k];
              ((LAS float*)F.lds + 16384)[k] = fmaxf(fmaxf(fabsf(P.in[I_NORMG][k] * (1.0f + s_sc)), fabsf(P.in[I_NORMG][k] * (1.0f + o_sc))), 1e-3f); }
#endif
        }
        __syncthreads();
#pragma unroll 1
        for (int rr = 0; rr < 4; ++rr) {
            const int row = row0 + F.wave * 4 + rr;
            const GAS f32x4* xr = (const GAS f32x4*)(P.in[I_X] + (size_t)row * DM) + F.lane;
            f32x4 v[16]; float ss = 0.f;
#pragma unroll
            for (int j = 0; j < 16; ++j) { v[j] = P1_NT ? __builtin_nontemporal_load(xr + 64 * j) : xr[64 * j]; ss += (v[j].x * v[j].x + v[j].y * v[j].y) + (v[j].z * v[j].z + v[j].w * v[j].w); }
            const float rstd = 1.0f / sqrtf(wave_sum(ss) * (1.0f / DM) + EPS);
            GAS u32x2* o8 = (GAS u32x2*)(h0 + (size_t)row * DM) + F.lane;
#if EMUI8_G1 && !defined(EMUI8_NOA)
            float amax_ = 0.f;
#pragma unroll
            for (int j = 0; j < 16; ++j) { const f32x4 g = *(const LAS f32x4*)(gs + 256 * j + 4 * F.lane), s = *(const LAS f32x4*)(sh + 256 * j + 4 * F.lane);
                f32x4 y = v[j] * rstd * g + s;
#if EMUI8_SMOOTH
                y = y / *(const LAS f32x4*)((LAS float*)F.lds + 16384 + 256 * j + 4 * F.lane);
#endif
                amax_ = fmaxf(fmaxf(amax_, fmaxf(fabsf(y.x), fabsf(y.y))), fmaxf(fabsf(y.z), fabsf(y.w))); asm volatile("" ::: "memory"); }
#pragma unroll
            for (int o_ = 1; o_ < 64; o_ <<= 1) amax_ = fmaxf(amax_, __shfl_xor(amax_, o_));
            const float qs_ = 127.0f / amax_, iq_ = amax_ / 127.0f;
#pragma unroll
            for (int j = 0; j < 16; ++j) { const f32x4 g = *(const LAS f32x4*)(gs + 256 * j + 4 * F.lane), s = *(const LAS f32x4*)(sh + 256 * j + 4 * F.lane);
#if EMUI8_SMOOTH
                const f32x4 ck_ = *(const LAS f32x4*)((LAS float*)F.lds + 16384 + 256 * j + 4 * F.lane);
#else
                const f32x4 ck_ = (f32x4){1.f, 1.f, 1.f, 1.f};
#endif
                const f32x4 y0_ = (v[j] * rstd * g + s) / ck_ * qs_;
                const f32x4 y = (f32x4){rintf(y0_.x), rintf(y0_.y), rintf(y0_.z), rintf(y0_.w)} * iq_ * ck_; u32x2 w; w.x = pk2(y.x, y.y); w.y = pk2(y.z, y.w); o8[64 * j] = w; asm volatile("" ::: "memory"); }
#elif I8_G1
            float amax_ = 0.f;
#pragma unroll
            for (int j = 0; j < 16; ++j) { const f32x4 g = *(const LAS f32x4*)(gs + 256 * j + 4 * F.lane), s = *(const LAS f32x4*)(sh + 256 * j + 4 * F.lane);
                const f32x4 y = v[j] * rstd * g + s; amax_ = fmaxf(fmaxf(amax_, fmaxf(fabsf(y.x), fabsf(y.y))), fmaxf(fabsf(y.z), fabsf(y.w))); asm volatile("" ::: "memory"); }
#pragma unroll
            for (int o_ = 1; o_ < 64; o_ <<= 1) amax_ = fmaxf(amax_, __shfl_xor(amax_, o_));
            const float qs_ = amax_ > 0.f ? 127.0f / amax_ : 0.f;
            if (F.lane == 0) ((float*)(ws + WS_SA0))[row] = amax_ * (1.0f / 127.0f);
            GAS unsigned* o4 = (GAS unsigned*)(ws + WS_H0I + (size_t)row * DM) + F.lane;
#pragma unroll
            for (int j = 0; j < 16; ++j) { const f32x4 g = *(const LAS f32x4*)(gs + 256 * j + 4 * F.lane), s = *(const LAS f32x4*)(sh + 256 * j + 4 * F.lane);
                const f32x4 y = v[j] * rstd * g + s; u32x2 w; w.x = pk2(y.x, y.y); w.y = pk2(y.z, y.w); o8[64 * j] = w; o4[64 * j] = pk4_i8(y.x * qs_, y.y * qs_, y.z * qs_, y.w * qs_); asm volatile("" ::: "memory"); }
#else
#pragma unroll
            for (int j = 0; j < 16; ++j) { const f32x4 g = *(const LAS f32x4*)(gs + 256 * j + 4 * F.lane), s = *(const LAS f32x4*)(sh + 256 * j + 4 * F.lane);
                const f32x4 y = v[j] * rstd * g + s; u32x2 w; w.x = pk2(y.x, y.y); w.y = pk2(y.z, y.w); o8[64 * j] = w; }
#endif
        }
        asm volatile("s_waitcnt vmcnt(0)" ::: "memory");
        __syncthreads();
        {
            const int r = F.lane & 31, hh = F.lane >> 5;
            const bf16_t* ap = wft + (size_t)r * DM + F.wave * 512 + 8 * hh;
            const bf16_t* bp = h0 + (size_t)(row0 + r) * DM + F.wave * 512 + 8 * hh;
            f32x16 acc = {};
#pragma unroll 8
            for (int k = 0; k < 512; k += 16) { const bf16x8 a = *(const GAS bf16x8*)(ap + k), bb = *(const GAS bf16x8*)(bp + k); acc = __builtin_amdgcn_mfma_f32_32x32x16_bf16(a, bb, acc, 0, 0, 0); }
#pragma unroll
            for (int q = 0; q < 16; ++q) red[(F.wave * 16 + q) * 64 + F.lane] = acc[q];
            __syncthreads();
#pragma unroll
            for (int qq = 0; qq < 2; ++qq) { const int q = 2 * F.wave + qq; float s = 0.f;
#pragma unroll
                for (int w = 0; w < 8; ++w) s += red[(w * 16 + q) * 64 + F.lane];
                const int n = (q & 3) + 8 * (q >> 2) + 4 * hh;
                const float xg = s + P.in[I_ABF][n];
                const float lf = fminf(xg, 0.f) - log1pf(__expf(-fabsf(xg)));
                logf[(size_t)(b * NH + n) * SEQ + (row0 % SEQ) + r] = lf; }
        }
    }
#if I8_G3
    requant_rows(F, (const bf16_t*)(ws + WS_W3T), ws + WS_W3I, (float*)(ws + WS_SW), 8192);
#endif
#if I8_G1
    requant_rows(F, (const bf16_t*)(ws + WS_W1T), ws + WS_W1I, (float*)(ws + WS_SW) + 8192, 8192);
#endif
}

template <class DstPtr>
__device__ __forceinline__ void scan_logf(const Frame& F, const float* lf, DstPtr dst, float scale, LAS float* wsum) {
    unsigned lo_ = 32u * (unsigned)F.tid; asm volatile("" : "+v"(lo_));
    const f32x4 a = *(const GAS f32x4*)((const char*)lf + lo_), b = *(const GAS f32x4*)((const char*)lf + lo_ + 16);
    float v[8] = {a.x, a.y, a.z, a.w, b.x, b.y, b.z, b.w};
#pragma unroll
    for (int e = 1; e < 8; ++e) v[e] += v[e - 1];
    const float total = v[7]; float incl = total; int ln_ = (int)(lo_ >> 5) & 63;
#pragma unroll
    for (int o = 1; o < 64; o <<= 1) { const float n = __int_as_float(__builtin_amdgcn_ds_bpermute((ln_ - o) << 2, __float_as_int(incl))); if (ln_ >= o) incl += n; }
    if (ln_ == 63) wsum[F.wave] = incl;
    __syncthreads();
    float off = incl - total;
    for (int w = 0; w < F.wave; ++w) off += wsum[w];
#pragma unroll
    for (int e = 0; e < 8; ++e) dst[8 * F.tid + e] = scale * (off + v[e]);
    __syncthreads();
}

#ifndef FOX_ORDER
#define FOX_ORDER 0
#endif
__device__ __forceinline__ int fox_qb(int n) { return FOX_ORDER ? 15 - (((n >> 8) << 2) | (n & 3)) : 15 - (n >> 6); }
__device__ __forceinline__ int fox_bh(int n) { return FOX_ORDER ? (n & 255) >> 2 : n & 63; }
__device__ __forceinline__ att::BlockRef fox_ref(int n, int jlo, float qk) {
    const int qb = fox_qb(n), bh = fox_bh(n), b = bh >> 5, h = bh & 31; att::BlockRef r;
    r.kvoff = (unsigned)b * (SEQ * DM) + h * HD; r.qoff = r.kvoff + (unsigned)qb * (256u * DM); r.P0 = qb * 256; r.jlo = jlo; r.sinks = nullptr; r.qk = qk; return r;
}
__device__ __forceinline__ int fox_jlo(const Frame& F, int n, const unsigned* nrm, float& qk) {
    const int qb = fox_qb(n), bh = fox_bh(n), b = bh >> 5, h = bh & 31;
    const float* nq = (const float*)nrm + ((0 * 2 + b) * 32 + h) * 4; const float* nk = (const float*)nrm + ((1 * 2 + b) * 32 + h) * 4;
    const float q2 = (nq[0] + nq[1]) + (nq[2] + nq[3]), k2 = (nk[0] + nk[1]) + (nk[2] + nk[3]);
    qk = 1.03f * sqrtf(q2 * k2);
    const float X = 40.0f / (LOG2E * att::SCALE) + att::THR / att::SCALE + 2.0f * qk + 16.0f;
#if defined(PROBE_X)
    const float Xp = (float)(PROBE_X);
#define X Xp
#endif
    const LAS float* Fs = (const LAS float*)(F.lds + att::LDS_F);
    const float thresh = Fs[qb * 256] - X;
    const unsigned long long m = __ballot(Fs[64 * F.lane + 63] > thresh);
    return m ? __builtin_ctzll(m) : 63;
#if defined(PROBE_X)
#undef X
#endif
}
__device__ __forceinline__ void p3_fox(const Frame& F, const Params& P, LAS char* lds, volatile LAS unsigned* MISC) {
    unsigned char* ws = P.ws;
#define logf ((const float*)(ws + WS_LOGF))
#define qhead ((unsigned*)(ws + WS_CTL) + CW_QUEUE)
#define nrm ((const unsigned*)(ws + WS_CTL) + CW_NORM)
    att::Bases<WS_Q, WS_K, WS_V, WS_Z, WS_OG> T; T.ws = ws;
    int n_cur = F.vcu;
    if (F.tid == 0) MISC[16] = 256u + __hip_atomic_fetch_add(qhead, 1u, __ATOMIC_RELAXED, __HIP_MEMORY_SCOPE_AGENT);
    scan_logf(F, logf + (size_t)fox_bh(n_cur) * SEQ, (LAS float*)(F.lds + att::LDS_F), -SQRT_HD, (LAS float*)(F.lds + att::LDS_WS));
    int n_nxt = (int)MISC[16];
    att::Seam S;
    float qk_ = 0.f; const int jl0_ = fox_jlo(F, n_cur, nrm, qk_);
    att::BlockRef cur = fox_ref(n_cur, jl0_, qk_);
    att::attn_prime<true, DM, DM>(T, cur, 1 << 28, lds, S);
#pragma unroll 1
    for (;;) {
        const bool has_next = n_nxt < 1024;
        const att::BlockRef nxt = has_next ? fox_ref(n_nxt, 0, 0.f) : cur;
        att::attn_block<true, DM, DM, DM>(T, cur, nxt, SEQ, 1 << 28, lds, S);
        if (!has_next) break;
        unsigned n_nn = 0u;
        if (F.tid == 0) n_nn = 256u + __hip_atomic_fetch_add(qhead, 1u, __ATOMIC_RELAXED, __HIP_MEMORY_SCOPE_AGENT);
        if (fox_bh(n_nxt) != fox_bh(n_cur)) scan_logf(F, logf + (size_t)fox_bh(n_nxt) * SEQ, (LAS float*)(F.lds + att::LDS_F), -SQRT_HD, (LAS float*)(F.lds + att::LDS_WS));
        { float qk2_ = 0.f; const int jl_ = fox_jlo(F, n_nxt, nrm, qk2_); cur = fox_ref(n_nxt, jl_, qk2_); }
        if (F.tid == 0) MISC[16] = n_nn;
        __syncthreads();
        n_cur = n_nxt; n_nxt = (int)MISC[16];
        __syncthreads();
    }
#undef logf
#undef qhead
#undef nrm
}
__device__ __forceinline__ att::BlockRef swa_ref(int rb, int b, int kvh, const float* sinks) {
    att::BlockRef r; r.qoff = ((unsigned)b * SEQ + (unsigned)rb * 32u) * DM + kvh * 8 * HD; r.kvoff = (unsigned)b * (SEQ * NKV2) + kvh * HD; r.P0 = rb * 32; r.jlo = 0; r.qk = 0.f; r.sinks = sinks + kvh * 8; return r;
}
__device__ __forceinline__ void p7_swa(const Frame& F, const Params& P, LAS char* lds) {
    unsigned char* ws = P.ws;
    { const int it = F.vcu;
        const int g8 = it >> 5, b = g8 >> 2, kvh = g8 & 3, i0 = (it & 31) * 4;
        att::Bases<WS_Q, WS_KV1, WS_KV1 + (size_t)KVW * 2, WS_Z, WS_OG> T; T.ws = ws;
        att::Seam S;
        att::BlockRef cur = swa_ref(i0, b, kvh, P.in[I_SINK]);
        att::attn_prime<false, DM, NKV2>(T, cur, 128, lds, S);
#pragma unroll 1
        for (int t = 0; t < 4; ++t) { const att::BlockRef nxt = (t < 3) ? swa_ref(i0 + t + 1, b, kvh, P.in[I_SINK]) : cur; att::attn_block<false, DM, NKV2, DM>(T, cur, nxt, SEQ, 128, lds, S); cur = nxt; }
    }
}

__device__ __forceinline__ void p5_norm1(const Frame& F, const Params& P) {
    unsigned char* ws = P.ws;
    const float* mod = (const float*)(ws + WS_MOD); const float* h1 = (const float*)(ws + WS_H1);
    bf16_t* hb = (bf16_t*)(ws + WS_HB); bf16_t* kvn = (bf16_t*)(ws + WS_KVN);
    LAS float* gs = (LAS float*)F.lds; LAS float* sh = gs + DM; LAS float* gk = sh + DM;
    for (int rb = F.vcu; rb < M / 32; rb += F.G) {
        const int row0 = rb * 32, b = row0 / SEQ;
        __syncthreads();
        for (int k = F.tid; k < DM; k += NTHR) { const float* m1 = mod + (size_t)(2 + b) * MOD; gs[k] = P.in[I_NORMG][DM + k] * (1.0f + m1[DM + k]); sh[k] = m1[k]; gk[k] = P.in[I_KVG][k]; }
        __syncthreads();
#pragma unroll 1
        for (int rr = 0; rr < 4; ++rr) {
            const int row = row0 + F.wave * 4 + rr;
            const GAS f32x4* xr = (const GAS f32x4*)(h1 + (size_t)row * DM) + F.lane;
            f32x4 v[16]; float ss = 0.f;
#pragma unroll
            for (int j = 0; j < 16; ++j) { v[j] = xr[64 * j]; ss += (v[j].x * v[j].x + v[j].y * v[j].y) + (v[j].z * v[j].z + v[j].w * v[j].w); }
            const float rstd = 1.0f / sqrtf(wave_sum(ss) * (1.0f / DM) + EPS);
            GAS u32x2* o1 = (GAS u32x2*)(hb + (size_t)row * DM) + F.lane; GAS u32x2* o2 = (GAS u32x2*)(kvn + (size_t)row * DM) + F.lane;
#if EMUI8_G3 || I8_G3
            float am5_ = 0.f;
#pragma unroll
            for (int j = 0; j < 16; ++j) { const int kx = 256 * j + 4 * F.lane; const f32x4 g = *(const LAS f32x4*)(gs + kx), s = *(const LAS f32x4*)(sh + kx); const f32x4 y = v[j] * rstd * g + s;
                am5_ = fmaxf(fmaxf(am5_, fmaxf(fabsf(y.x), fabsf(y.y))), fmaxf(fabsf(y.z), fabsf(y.w))); asm volatile("" ::: "memory"); }
#pragma unroll
            for (int o_ = 1; o_ < 64; o_ <<= 1) am5_ = fmaxf(am5_, __shfl_xor(am5_, o_));
            const float qs5_ = am5_ > 0.f ? 127.0f / am5_ : 0.f, iq5_ = am5_ / 127.0f; (void)iq5_;
#if I8_G3
            if (F.lane == 0) ((float*)(ws + WS_SA1))[row] = iq5_;
#endif
#endif
#pragma unroll
            for (int j = 0; j < 16; ++j) { const int kx = 256 * j + 4 * F.lane; const f32x4 g = *(const LAS f32x4*)(gs + kx), s = *(const LAS f32x4*)(sh + kx), k4 = *(const LAS f32x4*)(gk + kx);
                const f32x4 xn = v[j] * rstd, z = xn * k4; f32x4 y = xn * g + s; u32x2 w;
#if I8_G3
                { ((GAS unsigned*)((unsigned char*)hb + (size_t)row * DM))[64 * j + F.lane] = pk4_i8(y.x * qs5_, y.y * qs5_, y.z * qs5_, y.w * qs5_); w.x = pk2(z.x, z.y); w.y = pk2(z.z, z.w); o2[64 * j] = w; asm volatile("" ::: "memory"); continue; }
#elif FP8_G3
                { ((GAS unsigned*)((unsigned char*)hb + (size_t)row * DM))[64 * j + F.lane] = pk4_fp8(y.x * F8_HSCALE, y.y * F8_HSCALE, y.z * F8_HSCALE, y.w * F8_HSCALE); w.x = pk2(z.x, z.y); w.y = pk2(z.z, z.w); o2[64 * j] = w; asm volatile("" ::: "memory"); continue; }
#endif
#if EMUI8_G3
                { const f32x4 yq_ = y * qs5_; y = (f32x4){rintf(yq_.x), rintf(yq_.y), rintf(yq_.z), rintf(yq_.w)} * iq5_; }
#endif
                if (EMU8_G3) { float y0_ = y.x, y1_ = y.y, y2_ = y.z, y3_ = y.w; rnd8_2(y0_, y1_, 8.f); rnd8_2(y2_, y3_, 8.f); y = (f32x4){y0_, y1_, y2_, y3_}; } w.x = pk2(y.x, y.y); w.y = pk2(y.z, y.w); o1[64 * j] = w; w.x = pk2(z.x, z.y); w.y = pk2(z.z, z.w); o2[64 * j] = w;
                asm volatile("" ::: "memory"); }
        }
    }
}
#ifndef OUT_NT
#define OUT_NT 0
#endif
__device__ __forceinline__ void p9_final(const Frame& F, const Params& P) {
    LAS float* gf = (LAS float*)F.lds;
    __syncthreads();
    for (int k = F.tid; k < DM; k += NTHR) gf[k] = P.in[I_FING][k];
    __syncthreads();
    const int gw = F.vcu * NWAVES + F.wave, NGW = F.G * NWAVES;
    for (int row = gw; row < M; row += NGW) {
        GAS f32x4* xr = (GAS f32x4*)(P.out + (size_t)row * DM) + F.lane;
        f32x4 v[16]; float ss = 0.f;
#pragma unroll
        for (int j = 0; j < 16; ++j) { v[j] = xr[64 * j]; ss += (v[j].x * v[j].x + v[j].y * v[j].y) + (v[j].z * v[j].z + v[j].w * v[j].w); }
        const float rstd = 1.0f / sqrtf(wave_sum(ss) * (1.0f / DM) + EPS);
#pragma unroll
        for (int j = 0; j < 16; ++j) { const f32x4 y_ = v[j] * rstd * *(const LAS f32x4*)(gf + 256 * j + 4 * F.lane);
#if OUT_NT
            __builtin_nontemporal_store(y_, xr + 64 * j); }
#else
            xr[64 * j] = y_; }
#endif
    }
}


template <class E, class Sched>
__device__ __forceinline__ void naive_gemm_bf16(const Frame& F, const bf16_t* A, const bf16_t* Bt, int K, const Sched& S, const E& e, const float* cs, const float* sn) {
    const int r = F.lane & 31, hh = F.lane >> 5; pg8::Unit u;
    for (int i = 0; S.next(i, u); ++i) {
        const pg8::Dest d = e.dest(u); const int rowu = e.row_of(u);
        for (int t = F.wave; t < 64; t += NWAVES) {
            const int tr = t >> 3, tc = t & 7;
            const bf16_t* ap = A + ((size_t)u.pm * 256 + tr * 32 + r) * K + 8 * hh; const bf16_t* bp = Bt + ((size_t)u.pn * 256 + tc * 32 + r) * K + 8 * hh;
            f32x16 acc = {};
#pragma unroll 4
            for (int k = 0; k < K; k += 16) { const bf16x8 a = *(const GAS bf16x8*)(ap + k), b = *(const GAS bf16x8*)(bp + k); acc = __builtin_amdgcn_mfma_f32_32x32x16_bf16(a, b, acc, 0, 0, 0); }
#pragma unroll
            for (int q = 0; q < 16; ++q) {
                const int row = rowu + tr * 32 + (q & 3) + 8 * (q >> 2) + 4 * hh, p = tc * 32 + r; float v = acc[q];
                if (d.mode == 1) v = pg8::silu_f(v);
                const float partner = __shfl_xor(v, 4);
                if (d.mode == 2) { const int pos = row & 4095, j = 4 * ((p & 127) >> 3) + (p & 3); const float c = cs[pos * 64 + j], s = sn[pos * 64 + j]; v = (p & 4) ? (v * c + partner * s) : (v * c - partner * s); }
                d.p[(size_t)row * d.ld + p] = (bf16_t)f2bf(v);
            }
        }
    }
}
template <class Sched>
__device__ __forceinline__ void naive_gemm_resgate(const Frame& F, const bf16_t* A, const bf16_t* Bt, int K, const Sched& S, const pg8::EpiResGate& e) {
    const int r = F.lane & 31, hh = F.lane >> 5; pg8::Unit u;
    for (int i = 0; S.next(i, u); ++i)
        for (int t = F.wave; t < 64; t += NWAVES) {
            const int tr = t >> 3, tc = t & 7;
            const bf16_t* ap = A + ((size_t)u.pm * 256 + tr * 32 + r) * K + 8 * hh; const bf16_t* bp = Bt + ((size_t)u.pn * 256 + tc * 32 + r) * K + 8 * hh;
            f32x16 acc = {};
#pragma unroll 4
            for (int k = 0; k < K; k += 16) { const bf16x8 a = *(const GAS bf16x8*)(ap + k), b = *(const GAS bf16x8*)(bp + k); acc = __builtin_amdgcn_mfma_f32_32x32x16_bf16(a, b, acc, 0, 0, 0); }
#pragma unroll
            for (int q = 0; q < 16; ++q) { const int row = u.pm * 256 + tr * 32 + (q & 3) + 8 * (q >> 2) + 4 * hh, col = u.pn * 256 + tc * 32 + r; const size_t off = (size_t)row * 4096 + col;
                e.out[off] = e.base[off] + e.gate[(size_t)(row >> 12) * e.gate_ld + col] * acc[q]; }
        }
}
template <bool FOX>
__device__ __forceinline__ void naive_attn(const Frame& F, const Params& P) {
    unsigned char* ws = P.ws;
    const bf16_t* Q = (const bf16_t*)(ws + WS_Q); const bf16_t* Z = (const bf16_t*)(ws + WS_Z); bf16_t* OG = (bf16_t*)(ws + WS_OG);
    LAS float* Fl = (LAS float*)F.lds; LAS float* qs = Fl + 4096 + F.wave * 128; LAS float* wsum = Fl + 4096 + 8 * 128;
    for (int it = F.vcu; it < 256; it += F.G) {
        const int bh = it >> 2, s4 = it & 3, b = bh >> 5, h = bh & 31;
        __syncthreads();
        if (FOX) scan_logf(F, (const float*)(ws + WS_LOGF) + (size_t)bh * SEQ, Fl, 1.0f, wsum);
        const bf16_t* Kp; const bf16_t* Vp; int ldkv;
        if (FOX) { Kp = (const bf16_t*)(ws + WS_K) + (size_t)b * SEQ * DM + h * HD; Vp = (const bf16_t*)(ws + WS_V) + (size_t)b * SEQ * DM + h * HD; ldkv = DM; }
        else { Kp = (const bf16_t*)(ws + WS_KV1) + (size_t)b * SEQ * NKV2 + (h >> 3) * HD; Vp = Kp + KVW; ldkv = NKV2; }
        const float sink = FOX ? 0.f : P.in[I_SINK][h];
        for (int t = F.wave; t < SEQ / 4; t += NWAVES) {
            const int i = 4 * t + s4; const size_t qo = ((size_t)b * SEQ + i) * DM + h * HD;
            { const unsigned qq = *(const GAS unsigned*)(Q + qo + 2 * F.lane); qs[2 * F.lane] = __uint_as_float(qq << 16) * att::SCALE; qs[2 * F.lane + 1] = __uint_as_float(qq & 0xffff0000u) * att::SCALE; }
            asm volatile("s_waitcnt lgkmcnt(0)" ::: "memory");
            float m = -1e30f, l = 0.f, o0 = 0.f, o1 = 0.f;
            const int jst = FOX ? 0 : (i > 127 ? i - 127 : 0);
            for (int jc = jst; jc <= i; jc += 64) {
                const int j = jc + F.lane; const bool valid = j <= i; const int jl = valid ? j : i;
                const bf16_t* kr = Kp + (size_t)jl * ldkv; float dot = 0.f;
#pragma unroll 4
                for (int d = 0; d < 128; d += 8) { const u32x4 kk = *(const GAS u32x4*)(kr + d); const LAS float* qd = qs + d;
                    dot += __uint_as_float(kk.x << 16) * qd[0] + __uint_as_float(kk.x & 0xffff0000u) * qd[1] + __uint_as_float(kk.y << 16) * qd[2] + __uint_as_float(kk.y & 0xffff0000u) * qd[3]
                         + __uint_as_float(kk.z << 16) * qd[4] + __uint_as_float(kk.z & 0xffff0000u) * qd[5] + __uint_as_float(kk.w << 16) * qd[6] + __uint_as_float(kk.w & 0xffff0000u) * qd[7]; }
                float sv = dot; if (FOX) sv += Fl[i] - Fl[jl];
                if (!valid) sv = -__builtin_inff();
                float cm = sv;
#pragma unroll
                for (int o = 1; o < 64; o <<= 1) cm = fmaxf(cm, __shfl_xor(cm, o));
                const float mn = fmaxf(m, cm), alpha = __expf(m - mn), p = valid ? __expf(sv - mn) : 0.f;
                l = l * alpha + wave_sum(p); o0 *= alpha; o1 *= alpha; m = mn;
                const int nj = (i - jc + 1) < 64 ? (i - jc + 1) : 64;
                for (int jj = 0; jj < nj; ++jj) { const float pj = __shfl(p, jj); const bf16_t* vr = Vp + (size_t)(jc + jj) * ldkv; o0 += pj * bf2f(vr[F.lane]); o1 += pj * bf2f(vr[F.lane + 64]); }
            }
            if (!FOX) l += __expf(sink - m);
            const float rl = 1.0f / l;
            OG[qo + F.lane] = (bf16_t)f2bf(o0 * rl * bf2f(Z[qo + F.lane])); OG[qo + F.lane + 64] = (bf16_t)f2bf(o1 * rl * bf2f(Z[qo + F.lane + 64]));
        }
    }
}

constexpr int NPHASE = 10;
__global__ void __launch_bounds__(NTHR, 2) fwd(Params P) {
    extern __shared__ __attribute__((aligned(16))) unsigned char lds[];
#define MAKE_FRAME() Frame F; { unsigned t_ = threadIdx.x; asm volatile("" : "+v"(t_)); F.lds = (LAS unsigned char*)lds; F.tid = (int)t_; F.lane = F.tid & 63; F.wave = __builtin_amdgcn_readfirstlane(F.tid >> 6); \
        F.G = gridDim.x; const int bx_ = blockIdx.x; F.vcu = (F.G % 8 == 0) ? (bx_ % 8) * (F.G / 8) + bx_ / 8 : bx_; }
    volatile LAS unsigned* MISC = (volatile LAS unsigned*)((LAS unsigned char*)lds + MISC_OFF);
    for (int u = threadIdx.x; u < (LDS_BYTES - MISC_OFF) / 4; u += NTHR) MISC[u] = 0u;
    __syncthreads();
    unsigned char* ws = P.ws;
    const int lo = P.ph_lo, hi = P.ph_hi;
    if (hi - lo > 1) (void)xcd_barrier_post((unsigned*)(ws + WS_CTL) + CW_BAR, MISC + 8);
#ifndef PH_MASK
#define PH_MASK 0x3ff
#endif
#define IN(k) (((PH_MASK >> (k)) & 1) && lo <= (k) && (k) < hi)
#ifndef SEAM_TWICE
#define SEAM_TWICE 0
#endif
#define SEAM(k) do { if (IN(k) && IN((k) + 1)) { XcdBarrier bar_; bar_.bar = (unsigned*)(ws + WS_CTL) + CW_BAR; bar_.x = xb_xcc_id(); bar_.st = MISC + 8; xcd_barrier(bar_); if (SEAM_TWICE) xcd_barrier(bar_); } } while (0)
#ifndef REP_MASK
#define REP_MASK 0
#endif
#define REPS(k) _Pragma("unroll 1") for (int rep_ = 0; rep_ < (((REP_MASK >> (k)) & 1) ? 2 : 1); ++rep_)
#define cs ((const float*)(ws + WS_ROPE))
#define sn ((const float*)(ws + WS_ROPE) + SEQ * 64)
#define mod ((const float*)(ws + WS_MOD))

    if (IN(0)) { MAKE_FRAME(); REPS(0) { p0_prologue(F, P); } SEAM(0); }
    if (IN(1)) { MAKE_FRAME(); REPS(1) { p1_norm0(F, P); } SEAM(1); }
    if (IN(2)) { MAKE_FRAME();
        REPS(2) {
#ifndef G_ALIGN
#define G_ALIGN true
#endif
#ifndef G_SP2
#define G_SP2 true
#endif
#ifndef GX_WGM
#define GX_WGM 4
#endif
#ifndef G1_WGM
#define G1_WGM 4
#endif
#ifndef STAGGER_TICKS
#define STAGGER_TICKS 0
#endif
        if (STAGGER_TICKS) { const unsigned long long t0_ = __builtin_amdgcn_s_memrealtime(), w_ = (unsigned long long)((F.vcu >> 5) * STAGGER_TICKS); while (__builtin_amdgcn_s_memrealtime() - t0_ < w_) __builtin_amdgcn_s_sleep(2); }
        pg8::StaticOrder S; S.init(M, N1, F.G, (int)blockIdx.x, G1_WGM);
        pg8::EpiStoreBf16<pg8::EpiQKVZ> E{{(bf16_t*)(ws + WS_Q), (WS_K - WS_Q) / 2, 0}, cs, sn, (unsigned*)(ws + WS_CTL) + CW_NORM};
#if NAIVE_GEMM
        naive_gemm_bf16(F, (const bf16_t*)(ws + WS_HB), (const bf16_t*)(ws + WS_W1T), DM, S, E.e, cs, sn);
        if (blockIdx.x == 0) for (int i = F.tid; i < 512; i += NTHR) E.nrm[i] = __float_as_uint(1e12f);
#else
        pg8::Gemm g{(const bf16_t*)(ws + WS_HB), (const bf16_t*)(ws + WS_W1T), M, N1, DM};
#if defined(PROBE_NULL_EPI)
        { pg8::EpiNull EN; pg8::gemm_phase<pg8::EpiNull, pg8::StaticOrder, G_ALIGN, G_SP2>(F.lds, g, S, EN); }
#endif
#if I8_G1
        { pg8::StaticOrder S8; S8.init(M, 2 * DM, F.G, (int)blockIdx.x, G1_WGM);
          pg8::EpiStoreBf16<pg8::EpiQKVZ, 1, pg8::DqI8> E8{{(bf16_t*)(ws + WS_Q), (WS_K - WS_Q) / 2, 0}, cs, sn, (unsigned*)(ws + WS_CTL) + CW_NORM, {(const float*)(ws + WS_SA0), (const float*)(ws + WS_SW) + 8192}};
          pg8::Gemm g8{(const bf16_t*)(ws + WS_H0I), (const bf16_t*)(ws + WS_W1I), M, 2 * DM, DM / 2};
          pg8::gemm_phase<pg8::EpiStoreBf16<pg8::EpiQKVZ, 1, pg8::DqI8>, pg8::StaticOrder, G_ALIGN, G_SP2, false, true>(F.lds, g8, S8, E8);
          pg8::EpiStoreBf16<pg8::EpiQKVZ> Ev{{(bf16_t*)(ws + WS_Q), (WS_K - WS_Q) / 2, 2}, cs, sn, nullptr};
          pg8::Gemm gv{(const bf16_t*)(ws + WS_HB), (const bf16_t*)(ws + WS_W1T) + (size_t)(2 * DM) * DM, M, 2 * DM, DM};
          pg8::gemm_phase<pg8::EpiStoreBf16<pg8::EpiQKVZ>, pg8::StaticOrder, G_ALIGN, G_SP2>(F.lds, gv, S8, Ev); }
#else
        pg8::gemm_phase<pg8::EpiStoreBf16<pg8::EpiQKVZ>, pg8::StaticOrder, G_ALIGN, G_SP2>(F.lds, g, S, E);
#endif
#endif
        }
        SEAM(2);
    }
    if (IN(3)) { MAKE_FRAME();
        REPS(3) {
#if NAIVE_FOX
        naive_attn<true>(F, P);
#else
        p3_fox(F, P, (LAS char*)F.lds, MISC);
#endif
        }
        SEAM(3);
    }
    if (IN(4)) { MAKE_FRAME();
        REPS(4) {
        pg8::StaticOrder S; S.init(M, DM, F.G, (int)blockIdx.x, GX_WGM);
        #ifndef RES_NT4
#define RES_NT4 0
#endif
        pg8::EpiResGate E{P.in[I_X], (float*)(ws + WS_H1), mod + 2 * DM, MOD, RES_NT4 != 0, 1.0f};
#if NAIVE_GEMM
        naive_gemm_resgate(F, (const bf16_t*)(ws + WS_OG), (const bf16_t*)(ws + WS_W2T), DM, S, E);
#else
        pg8::Gemm g{(const bf16_t*)(ws + WS_OG), (const bf16_t*)(ws + WS_W2T), M, DM, DM};
#if defined(PROBE_NULL_EPI4)
        { pg8::EpiNull EN; pg8::gemm_phase<pg8::EpiNull, pg8::StaticOrder, G_ALIGN, G_SP2>(F.lds, g, S, EN); }
#endif
        pg8::gemm_phase<pg8::EpiResGate, pg8::StaticOrder, G_ALIGN, G_SP2>(F.lds, g, S, E);
#endif
        }
        SEAM(4);
    }
    if (IN(5)) { MAKE_FRAME(); REPS(5) { p5_norm1(F, P); } SEAM(5); }
    if (IN(6)) { MAKE_FRAME();
        REPS(6) {
#if I8_G3 && !NAIVE_GEMM
        { pg8::OrderQZ8 S; S.init(F.G, (int)blockIdx.x, GX_WGM);
          pg8::EpiStoreBf16<pg8::EpiQZ, 1, pg8::DqI8> E{{(bf16_t*)(ws + WS_Q), (bf16_t*)(ws + WS_Z)}, cs, sn, nullptr, {(const float*)(ws + WS_SA1), (const float*)(ws + WS_SW)}};
          pg8::Gemm g{(const bf16_t*)(ws + WS_HB), (const bf16_t*)(ws + WS_W3I), M, N3, DM / 2};
          pg8::gemm_phase<pg8::EpiStoreBf16<pg8::EpiQZ, 1, pg8::DqI8>, pg8::OrderQZ8, G_ALIGN, G_SP2, false, true>(F.lds, g, S, E); }
        { pg8::OrderKV S; S.init(F.G, (int)blockIdx.x, GX_WGM);
          pg8::EpiStoreBf16<pg8::EpiKV> E{{(bf16_t*)(ws + WS_KV1)}, cs, sn, nullptr};
          pg8::Gemm g{(const bf16_t*)(ws + WS_KVN), (const bf16_t*)(ws + WS_WKVT), M, NKV2, DM};
          pg8::gemm_phase<pg8::EpiStoreBf16<pg8::EpiKV>, pg8::OrderKV, G_ALIGN, G_SP2>(F.lds, g, S, E); }
#elif FP8_G3 && !NAIVE_GEMM
        { pg8::OrderQZ8 S; S.init(F.G, (int)blockIdx.x, GX_WGM);
          pg8::EpiStoreBf16<pg8::EpiQZ, (int)(F8_HSCALE * F8_WSCALE)> E{{(bf16_t*)(ws + WS_Q), (bf16_t*)(ws + WS_Z)}, cs, sn, nullptr};
          pg8::Gemm g{(const bf16_t*)(ws + WS_HB), (const bf16_t*)(ws + WS_W3T), M, N3, DM / 2};
          pg8::gemm_phase<pg8::EpiStoreBf16<pg8::EpiQZ, (int)(F8_HSCALE * F8_WSCALE)>, pg8::OrderQZ8, G_ALIGN, G_SP2, true>(F.lds, g, S, E); }
        { pg8::OrderKV S; S.init(F.G, (int)blockIdx.x, GX_WGM);
          pg8::EpiStoreBf16<pg8::EpiKV> E{{(bf16_t*)(ws + WS_KV1)}, cs, sn, nullptr};
          pg8::Gemm g{(const bf16_t*)(ws + WS_KVN), (const bf16_t*)(ws + WS_WKVT), M, NKV2, DM};
          pg8::gemm_phase<pg8::EpiStoreBf16<pg8::EpiKV>, pg8::OrderKV, G_ALIGN, G_SP2>(F.lds, g, S, E); }
#else
        pg8::OrderQZKV S; S.init(F.G, (int)blockIdx.x, GX_WGM);
        pg8::EpiStoreBf16<pg8::EpiQZKV> E{{(bf16_t*)(ws + WS_Q), (bf16_t*)(ws + WS_Z), (bf16_t*)(ws + WS_KV1)}, cs, sn, nullptr};
#if NAIVE_GEMM
        naive_gemm_bf16(F, (const bf16_t*)(ws + WS_HB), (const bf16_t*)(ws + WS_W3T), DM, S, E.e, cs, sn);
#else
        pg8::Gemm g{(const bf16_t*)(ws + WS_HB), (const bf16_t*)(ws + WS_W3T), 2 * M, N3 + NKV2, DM};
        pg8::gemm_phase<pg8::EpiStoreBf16<pg8::EpiQZKV>, pg8::OrderQZKV, G_ALIGN, G_SP2>(F.lds, g, S, E);
#endif
#endif
        }
        SEAM(6);
    }
    if (IN(7)) { MAKE_FRAME();
        REPS(7) {
#if NAIVE_SWA
        naive_attn<false>(F, P);
#else
        p7_swa(F, P, (LAS char*)F.lds);
#endif
        }
        SEAM(7);
    }
    if (IN(8)) { MAKE_FRAME();
        REPS(8) {
        pg8::StaticOrder S; S.init(M, DM, F.G, (int)blockIdx.x, GX_WGM);
        #ifndef RES_NT8
#define RES_NT8 0
#endif
        pg8::EpiResGate E{(const float*)(ws + WS_H1), P.out, mod + 2 * MOD + 2 * DM, MOD, RES_NT8 != 0, FP8_G4 ? 1.0f / (F8_WSCALE * F8_OSCALE) : 1.0f};
#if NAIVE_GEMM
        naive_gemm_resgate(F, (const bf16_t*)(ws + WS_OG), (const bf16_t*)(ws + WS_W4T), DM, S, E);
#else
        pg8::Gemm g{(const bf16_t*)(ws + WS_OG), (const bf16_t*)(ws + WS_W4T), M, DM, FP8_G4 ? DM / 2 : DM};
        pg8::gemm_phase<pg8::EpiResGate, pg8::StaticOrder, G_ALIGN, G_SP2, FP8_G4 != 0>(F.lds, g, S, E);
#endif
        }
        SEAM(8);
    }
    if (IN(9)) { MAKE_FRAME(); p9_final(F, P); }
#undef IN
#undef SEAM
#undef cs
#undef sn
#undef mod
}

extern "C" void kernel_launch(void* const* d_in, const int* in_sizes, int n_in, void* d_out, int out_size, void* d_ws, size_t ws_size, hipStream_t stream) {
    static int grid = 0;
    if (grid == 0) {
        if (n_in != 14 || out_size != M * DM || ws_size < WS_END) { fprintf(stderr, "kernel_launch: unexpected shapes (n_in %d, out %d, ws %zu)\n", n_in, out_size, ws_size); grid = -1; return; }
        int dev = 0, cus = 0, per_cu = 0;
        if (hipGetDevice(&dev) != hipSuccess || hipDeviceGetAttribute(&cus, hipDeviceAttributeMultiprocessorCount, dev) != hipSuccess) { grid = -1; return; }
        if (hipFuncSetAttribute((const void*)fwd, hipFuncAttributeMaxDynamicSharedMemorySize, LDS_BYTES) != hipSuccess) { fprintf(stderr, "kernel_launch: hipFuncSetAttribute failed\n"); grid = -1; return; }
        if (hipOccupancyMaxActiveBlocksPerMultiprocessor(&per_cu, (const void*)fwd, NTHR, LDS_BYTES) != hipSuccess || per_cu < 1) fprintf(stderr, "kernel_launch: occupancy query reports %d workgroups per CU\n", per_cu);
        (void)hipGetLastError();
        grid = cus;
        if (grid > 256) grid = 256;
    }
    if (grid < 0) return;
    (void)hipMemsetAsync((char*)d_ws + WS_CTL, 0, CTL_ZERO_BYTES, stream);
    Params p{};
    for (int i = 0; i < 14; ++i) p.in[i] = (const float*)d_in[i];
    p.out = (float*)d_out; p.ws = (unsigned char*)d_ws;
#if MK_N_LAUNCHES == 1
    p.ph_lo = 0; p.ph_hi = NPHASE;
    hipLaunchKernelGGL(fwd, dim3(grid), dim3(NTHR), LDS_BYTES, stream, p);
#else
    for (int k = 0; k < NPHASE; ++k) { p.ph_lo = k; p.ph_hi = k + 1; hipLaunchKernelGGL(fwd, dim3(grid), dim3(NTHR), LDS_BYTES, stream, p); }
#endif
    const hipError_t le = hipPeekAtLastError();
    if (le != hipSuccess) fprintf(stderr, "kernel_launch: launch failed: %s\n", hipGetErrorName(le));
}
```

```cpp
#include <hip/hip_runtime.h>
#include <cstdio>
#include <cstdint>

#ifndef MK_N_LAUNCHES
#define MK_N_LAUNCHES 1
#endif
#ifndef NT_OUT
#define NT_OUT 1
#endif
#ifndef P1_NT
#define P1_NT 1
#endif
#ifndef WSKIP_ON
#define WSKIP_ON 0
#endif
#ifndef FP8_G4
#define FP8_G4 1
#endif
#ifndef I8_G3
#define I8_G3 1
#endif
#ifndef I8_G1
#define I8_G1 1
#endif
#if I8_G3
#define FP8_G3 0
#endif
#ifndef FP8_G3
#define FP8_G3 1
#endif
#define F8_HSCALE 8.0f
#define F8_WSCALE 64.0f
#define F8_OSCALE 8.0f
#ifndef NAIVE_GEMM
#define NAIVE_GEMM 0
#endif
#ifndef NAIVE_FOX
#define NAIVE_FOX 0
#endif
#ifndef NAIVE_SWA
#define NAIVE_SWA 0
#endif

#define GAS __attribute__((address_space(1)))
#define LAS __attribute__((address_space(3)))
typedef float f32x16 __attribute__((ext_vector_type(16)));
typedef short s16x4 __attribute__((ext_vector_type(4)));
typedef unsigned u32x2 __attribute__((ext_vector_type(2)));

constexpr int DM = 4096, BATCH = 2, SEQ = 4096, M = BATCH * SEQ;
constexpr int NH = 32, HD = 128, NKV = 4, KVW = NKV * HD;
constexpr int N1 = 4 * DM;
constexpr int N1F = N1 + NH;
constexpr int N3 = 2 * DM, NKV2 = 2 * KVW;
constexpr int MOD = 3 * DM;
constexpr float EPS = 1e-6f;
constexpr float LOG2E = 1.4426950408889634f;
constexpr float SQRT_HD = 11.313708498984761f;

typedef unsigned short bf16_t;
typedef short bf16x8 __attribute__((ext_vector_type(8)));
typedef float f32x4 __attribute__((ext_vector_type(4)));
typedef unsigned u32x4 __attribute__((ext_vector_type(4)));

namespace pg8 {
#define PG8_LAS __attribute__((address_space(3)))
typedef unsigned short bf16_t;
typedef short bf16x8 __attribute__((ext_vector_type(8)));
typedef float f32x4 __attribute__((ext_vector_type(4)));
typedef unsigned u32x4 __attribute__((ext_vector_type(4)));
constexpr int BM = 256, BK = 64, HALF = 128, HTB = HALF * BK * 2  , STAGE_BYTES = 8 * HTB, NXCD = 8, WGM = 8;

__host__ __device__ __forceinline__ int lds_byte(int r, int c) { const int st = (r >> 4) * 2 + (c >> 5), rr = r & 15, cc = c & 31, ob = rr * 64 + cc * 2; return st * 1024 + (ob ^ (((ob >> 9) & 1) << 5)); }
__host__ __device__ __forceinline__ void stage_rc(int b, int& R, int& C) { const int st = b / 1024, sb = b % 1024, swz = sb ^ (((sb >> 9) & 1) << 5); R = (st >> 1) * 16 + swz / 64; C = (st & 1) * 32 + (swz % 64) / 2; }
__host__ __device__ __forceinline__ int perm32(int rho) { const int n = rho >> 4, i = rho & 15; return 8 * (i >> 2) + 4 * n + (i & 3); }

struct Unit { int pm, pn; };
struct Gemm { const bf16_t* A; const bf16_t* Bt; int M, N, K; };

struct StaticOrder {
    int nM, nN, nwg, G, c, wgm;
    __host__ __device__ void init(int M, int N, int G_, int c_, int wgm_ = WGM) { nM = M / BM; nN = N / BM; nwg = nM * nN; G = G_; c = c_; wgm = wgm_; }
    __host__ __device__ bool next(int i, Unit& u) const {
        const long L = (long)i * G + c; if (L >= nwg) return false;
        int wgid = (int)L; { const int q = nwg / NXCD, r = nwg % NXCD, xcd = wgid % NXCD, off = wgid / NXCD; wgid = (xcd < r ? xcd * (q + 1) : r * (q + 1) + (xcd - r) * q) + off; }
        const int nig = wgm * nN, gid = wgid / nig, fm = gid * wgm, gsz = (nM - fm) < wgm ? (nM - fm) : wgm;
        u.pm = fm + ((wgid % nig) % gsz); u.pn = (wgid % nig) / gsz; return true;
    }
    __device__ __forceinline__ void a_ready(const Unit&) const {}
    __device__ __forceinline__ void done(const Unit&) const {}
};

__device__ __forceinline__ unsigned cvt_pk_bf16(float lo, float hi) { unsigned r; asm volatile("v_cvt_pk_bf16_f32 %0, %1, %2" : "=v"(r) : "v"(lo), "v"(hi)); return r; }
__device__ __forceinline__ float silu_f(float v) { return v * __builtin_amdgcn_rcpf(1.0f + __builtin_amdgcn_exp2f(-1.4426950408889634f * v)); }
__device__ __forceinline__ f32x4 silu4(f32x4 v) { return (f32x4){silu_f(v[0]), silu_f(v[1]), silu_f(v[2]), silu_f(v[3])}; }

__device__ __forceinline__ void store16_wt(void* base, unsigned off, u32x4 v) {
    const __amdgpu_buffer_rsrc_t rs = __builtin_amdgcn_make_buffer_rsrc(base, 0, 0x7fffffff, 0x00020000);
    __builtin_amdgcn_raw_buffer_store_b128(v, rs, off, 0, 16);
}
struct Dest { bf16_t* p; int ld; int mode; };

struct EpiQKVZ {
    static constexpr bool PERM = true, AFTER_DRAIN = false;
    bf16_t* O; size_t split_stride; int t0;
    __device__ __forceinline__ Dest dest(const Unit& u) const { const int colt = u.pn * BM, t = (colt >> 12) + t0; Dest d; d.p = O + (size_t)t * split_stride + (colt & 4095); d.ld = 4096; d.mode = (t == 3) ? 1 : 0; return d; }
    __device__ __forceinline__ int row_of(const Unit& u) const { return u.pm * BM; }
};
struct EpiQZKV {
    static constexpr bool PERM = true, AFTER_DRAIN = false;
    bf16_t* Q1; bf16_t* Z1; bf16_t* KV1;
    __device__ __forceinline__ Dest dest(const Unit& u) const {
        Dest d;
        if (u.pn < 32) { const int colt = u.pn * BM; if (colt < 4096) { d.p = Q1 + colt; d.mode = 2; } else { d.p = Z1 + (colt - 4096); d.mode = 1; } d.ld = 4096; }
        else { const int colt = (u.pn - 32) * BM; d.p = KV1 + colt; d.ld = 1024; d.mode = (colt < 512) ? 2 : 0; }
        return d;
    }
    __device__ __forceinline__ int row_of(const Unit& u) const { return (u.pn < 32 ? u.pm : u.pm - 32) * BM; }
};
struct EpiQZ {
    bf16_t* Q1; bf16_t* Z1;
    __device__ __forceinline__ Dest dest(const Unit& u) const { Dest d; const int colt = u.pn * BM; if (colt < 4096) { d.p = Q1 + colt; d.mode = 2; } else { d.p = Z1 + (colt - 4096); d.mode = 1; } d.ld = 4096; return d; }
    __device__ __forceinline__ int row_of(const Unit& u) const { return u.pm * BM; }
};
struct EpiKV {
    bf16_t* KV1;
    __device__ __forceinline__ Dest dest(const Unit& u) const { Dest d; const int colt = u.pn * BM; d.p = KV1 + colt; d.ld = 1024; d.mode = (colt < 512) ? 2 : 0; return d; }
    __device__ __forceinline__ int row_of(const Unit& u) const { return u.pm * BM; }
};
typedef int i32x4e __attribute__((ext_vector_type(4)));
struct DqNone {};
struct DqI8 { const float* sa; const float* sw; };
template <class E, int OSC = 1, class DQ = DqNone> struct EpiStoreBf16 {
    static constexpr bool PERM = true, AFTER_DRAIN = false;
    E e; const float* cs; const float* sn; unsigned* nrm; DQ dq;
    __device__ __forceinline__ void operator()(const f32x4 (&acc)[2][2][4][2], const Unit& u, int wr, int wc, int fr, int fq) const {
        const Dest d = e.dest(u); const int row0 = e.row_of(u) + wr * 64 + fr; const int col0 = wc * 32 + 8 * fq;
        const int g4 = (4 * wc + fq) * 4;
        float nmax[2] = {0.f, 0.f};
        float rs_[2][4]; f32x4 cw_[2][2];
        if constexpr (sizeof(DQ) > 1) {
#pragma unroll
            for (int ai = 0; ai < 2; ++ai)
#pragma unroll
                for (int m = 0; m < 4; ++m) rs_[ai][m] = dq.sa[row0 + ai * HALF + m * 16];
#pragma unroll
            for (int bj = 0; bj < 2; ++bj) { const int gc = u.pn * BM + col0 + bj * HALF; cw_[bj][0] = *(const f32x4*)(dq.sw + gc); cw_[bj][1] = *(const f32x4*)(dq.sw + gc + 4); }
        }
#pragma unroll
        for (int ai = 0; ai < 2; ++ai)
#pragma unroll
            for (int m = 0; m < 4; ++m) { const int row = row0 + ai * HALF + m * 16; bf16_t* rowp = d.p + (size_t)row * d.ld + col0;
                f32x4 c4 = (f32x4){1.f, 1.f, 1.f, 1.f}, s4 = (f32x4){0.f, 0.f, 0.f, 0.f};
                if (d.mode == 2) { const int pos = row & 4095; c4 = *(const f32x4*)(cs + pos * 64 + g4); s4 = *(const f32x4*)(sn + pos * 64 + g4); }
#pragma unroll
                for (int bj = 0; bj < 2; ++bj) { f32x4 v0 = acc[ai][bj][m][0], v1 = acc[ai][bj][m][1];
                    if constexpr (OSC != 1) { v0 *= (1.0f / OSC); v1 *= (1.0f / OSC); }
                    if constexpr (sizeof(DQ) > 1) { const float rs = rs_[ai][m];
                        v0 = __builtin_convertvector(__builtin_bit_cast(i32x4e, v0), f32x4) * (cw_[bj][0] * rs); v1 = __builtin_convertvector(__builtin_bit_cast(i32x4e, v1), f32x4) * (cw_[bj][1] * rs); }
                    if (d.mode == 1) { v0 = silu4(v0); v1 = silu4(v1); }
                    if (d.mode == 2) { const f32x4 y1 = v0 * c4 - v1 * s4, y2 = v1 * c4 + v0 * s4; v0 = y1; v1 = y2; }
                    if (nrm) { float ss = (v0[0] * v0[0] + v0[1] * v0[1]) + (v0[2] * v0[2] + v0[3] * v0[3]) + (v1[0] * v1[0] + v1[1] * v1[1]) + (v1[2] * v1[2] + v1[3] * v1[3]);
                        ss += __shfl_xor(ss, 16); ss += __shfl_xor(ss, 32); nmax[bj] = fmaxf(nmax[bj], ss); }
                    u32x4 w; w.x = cvt_pk_bf16(v0[0], v0[1]); w.y = cvt_pk_bf16(v0[2], v0[3]); w.z = cvt_pk_bf16(v1[0], v1[1]); w.w = cvt_pk_bf16(v1[2], v1[3]);
#if defined(WT_OUT)
                    store16_wt(d.p, (unsigned)(((size_t)row * d.ld + col0 + bj * HALF) * 2), w); } }
#elif NT_OUT
                    __builtin_nontemporal_store(w, (u32x4*)(rowp + bj * HALF)); } }
#else
                    *(u32x4*)(rowp + bj * HALF) = w; } }
#endif
        if (nrm) { const int colt = u.pn * BM, t = colt >> 12;
            if (t < 2) {
#pragma unroll
                for (int bj = 0; bj < 2; ++bj) { float mx = nmax[bj];
#pragma unroll
                    for (int o = 1; o < 16; o <<= 1) mx = fmaxf(mx, __shfl_xor(mx, o));
                    if (fr == 0 && fq == 0) atomicMax(nrm + ((((t * 2 + ((u.pm * BM) >> 12)) * 32) + ((colt & 4095) >> 7) + bj) * 4 + wc), __float_as_uint(mx)); } } }
    }
};
#ifndef RES_NT
#define RES_NT 0
#endif
#if RES_NT
#define RES_LOAD(p) __builtin_nontemporal_load(p)
#else
#define RES_LOAD(p) (*(p))
#endif
struct EpiResGate {
    static constexpr bool PERM = false, AFTER_DRAIN = false;
    const float* base; float* out; const float* gate; int gate_ld; bool nt_base; float osc;
    __device__ __forceinline__ void operator()(const f32x4 (&acc)[2][2][4][2], const Unit& u, int wr, int wc, int fr, int fq) const {
        const int row0 = u.pm * BM + wr * 64 + fr, col0 = u.pn * BM + wc * 32 + 4 * fq; const float* gp = gate + (size_t)((u.pm * BM) >> 12) * gate_ld + col0;
        f32x4 gv[2][2];
#pragma unroll
        for (int bj = 0; bj < 2; ++bj)
#pragma unroll
            for (int n = 0; n < 2; ++n) gv[bj][n] = *(const f32x4*)(gp + bj * HALF + n * 16) * osc;
#pragma unroll
        for (int ai = 0; ai < 2; ++ai)
#pragma unroll
            for (int m = 0; m < 4; ++m) { const size_t off = (size_t)(row0 + ai * HALF + m * 16) * 4096 + col0;
#pragma unroll
                for (int bj = 0; bj < 2; ++bj)
#pragma unroll
                    for (int n = 0; n < 2; ++n) { const f32x4 bs = nt_base ? __builtin_nontemporal_load((const f32x4*)(base + off + bj * HALF + n * 16)) : *(const f32x4*)(base + off + bj * HALF + n * 16); const f32x4 r_ = bs + gv[bj][n] * acc[ai][bj][m][n];
#if defined(WT_OUT)
                        store16_wt(out, (unsigned)((off + bj * HALF + n * 16) * 4), __builtin_bit_cast(u32x4, r_)); } }
#else
                        *(f32x4*)(out + off + bj * HALF + n * 16) = r_; } }
#endif
    }
};
struct EpiNull {
    static constexpr bool PERM = true, AFTER_DRAIN = false;
    __device__ __forceinline__ void operator()(const f32x4 (&acc)[2][2][4][2], const Unit&, int, int, int, int) const {
#pragma unroll
        for (int ai = 0; ai < 2; ++ai)
#pragma unroll
            for (int bj = 0; bj < 2; ++bj)
#pragma unroll
                for (int m = 0; m < 4; ++m) asm volatile("" :: "v"(acc[ai][bj][m][0]), "v"(acc[ai][bj][m][1]));
    }
};
struct OrderQZ8 {
    StaticOrder so; bool custom; int xcd, slot;
    __device__ void init(int G_, int c_, int wgm_) { so.init(8192, 8192, G_, c_, wgm_); custom = (G_ == 256); xcd = c_ & 7; slot = c_ >> 3; }
    __device__ bool next(int i, Unit& u) const {
        if (!custom) return so.next(i, u);
        int off; if (i < 3) off = i * 32 + slot; else { if (!(slot & 1) || i >= 5) return false; off = 96 + (i - 3) * 16 + (slot >> 1); }
        u.pm = 4 * xcd + (off & 3); u.pn = off >> 2; return true;
    }
    __device__ __forceinline__ void a_ready(const Unit&) const {}
    __device__ __forceinline__ void done(const Unit&) const {}
};
struct OrderKV {
    StaticOrder so; bool custom; int xcd, slot;
    __device__ void init(int G_, int c_, int wgm_) { so.init(8192, 1024, G_, c_, wgm_); custom = (G_ == 256); xcd = c_ & 7; slot = c_ >> 3; }
    __device__ bool next(int i, Unit& u) const {
        if (!custom) return so.next(i, u);
        if (i > 0 || (slot & 1)) return false;
        const int r = slot >> 1; u.pm = 4 * xcd + (r & 3); u.pn = r >> 2; return true;
    }
    __device__ __forceinline__ void a_ready(const Unit&) const {}
    __device__ __forceinline__ void done(const Unit&) const {}
};
struct OrderQZKV {
    StaticOrder so; int G, c;
    __device__ void init(int G_, int c_, int wgm_) { so.init(8192, 8192, G_, c_, wgm_); G = G_; c = c_; }
    __device__ bool next(int i, Unit& u) const {
        if (so.next(i, u)) return true;
        const long L = (long)i * G + c - 1024; if (L < 0 || L >= 128) return false;
        u.pm = 32 + (int)(L >> 2); u.pn = 32 + (int)(L & 3); return true;
    }
    __device__ __forceinline__ void a_ready(const Unit&) const {}
    __device__ __forceinline__ void done(const Unit&) const {}
};

#ifndef F8_ASM
#define F8_ASM 1
#endif
typedef int i32x4_ __attribute__((ext_vector_type(4)));
typedef int i32x8_ __attribute__((ext_vector_type(8)));
__device__ __forceinline__ i32x8_ cat8(bf16x8 a, bf16x8 b) { const i32x4_ x = __builtin_bit_cast(i32x4_, a), y = __builtin_bit_cast(i32x4_, b); return __builtin_shufflevector(x, y, 0, 1, 2, 3, 4, 5, 6, 7); }
template <class Epi, class Sched, bool ALIGN_EPI = false, bool SP2 = false, bool F8 = false, bool I8 = false>
__device__ __forceinline__ void gemm_phase(PG8_LAS unsigned char* lds, const Gemm g, const Sched& S, const Epi& E) {
    const int tid = threadIdx.x, wid = __builtin_amdgcn_readfirstlane(tid >> 6), lane = tid & 63, wr = wid >> 2, wc = wid & 3, fr = lane & 15, fq = lane >> 4;
    const int K = g.K, nt = K / BK;
    unsigned voffA[2], voffB[2];
#pragma unroll
    for (int i = 0; i < 2; ++i) { int R, C; stage_rc(tid * 16 + i * 8192, R, C); const int Rb = Epi::PERM ? ((R & ~31) + perm32(R & 31)) : R;
        voffA[i] = (unsigned)(R * K + C) * 2u; voffB[i] = (unsigned)(Rb * K + C) * 2u; }
    const size_t kstep = (size_t)(BK * 2);
    const size_t hstep = (size_t)HALF * K * 2;
    const size_t tstep = 2 * hstep;
    const unsigned ldsw = (unsigned)wid * 1024u;
    const int aoff = lds_byte(wr * 64 + fr, fq * 8), boff = lds_byte(wc * 32 + fr, fq * 8);
#define PG8_SA(b, h) (((b) * 2 + (h)) * HTB)
#define PG8_SB(b, h) ((4 + (b) * 2 + (h)) * HTB)
#define PG8_STAGE(bufoff, gbase, voff) do { _Pragma("unroll") for (int _i = 0; _i < 2; ++_i) \
        __builtin_amdgcn_global_load_lds((const unsigned*)((const char*)(gbase) + (voff)[_i]), (PG8_LAS unsigned*)(lds + (bufoff) + ldsw + _i * 8192), 16, 0, 0); } while (0)
#define PG8_LDA(dst, b, h) do { _Pragma("unroll") for (int m = 0; m < 4; ++m) _Pragma("unroll") for (int k = 0; k < 2; ++k) dst[m][k] = *(const PG8_LAS bf16x8*)(lds + PG8_SA(b, h) + aoff + m * 2048 + k * 1024); } while (0)
#define PG8_LDB(dst, b, h) do { _Pragma("unroll") for (int n = 0; n < 2; ++n) _Pragma("unroll") for (int k = 0; k < 2; ++k) dst[n][k] = *(const PG8_LAS bf16x8*)(lds + PG8_SB(b, h) + boff + n * 2048 + k * 1024); } while (0)
#define PG8_MMA(ai, bj, At, Bt) do { __builtin_amdgcn_s_setprio(1); _Pragma("unroll") for (int m = 0; m < 4; ++m) _Pragma("unroll") for (int n = 0; n < 2; ++n) { \
        if constexpr (F8) { if (F8_ASM) asm volatile("v_mfma_scale_f32_16x16x128_f8f6f4 %0, %1, %2, %0, %3, %3 op_sel_hi:[0,0,0]" : "+v"(acc[ai][bj][m][n]) : "v"(cat8(Bt[n][0], Bt[n][1])), "v"(cat8(At[m][0], At[m][1])), "v"(f8sc)); \
            else acc[ai][bj][m][n] = __builtin_amdgcn_mfma_scale_f32_16x16x128_f8f6f4(cat8(Bt[n][0], Bt[n][1]), cat8(At[m][0], At[m][1]), acc[ai][bj][m][n], 0, 0, 0, 0x7f7f7f7f, 0, 0x7f7f7f7f); } \
        else if constexpr (I8) { _Pragma("unroll") for (int k = 0; k < 2; ++k) acc[ai][bj][m][n] = __builtin_bit_cast(f32x4, __builtin_amdgcn_mfma_i32_16x16x64_i8(__builtin_bit_cast(i32x4_, Bt[n][k]), __builtin_bit_cast(i32x4_, At[m][k]), __builtin_bit_cast(i32x4_, acc[ai][bj][m][n]), 0, 0, 0)); } \
        else { _Pragma("unroll") for (int k = 0; k < 2; ++k) acc[ai][bj][m][n] = __builtin_amdgcn_mfma_f32_16x16x32_bf16(Bt[n][k], At[m][k], acc[ai][bj][m][n], 0, 0, 0); } } __builtin_amdgcn_s_setprio(0); } while (0)
#define PG8_WAIT_V(n) asm volatile("s_waitcnt vmcnt(" #n ")" ::: "memory")
#define PG8_WAIT_L(n) asm volatile("s_waitcnt lgkmcnt(" #n ")" ::: "memory")
#define PG8_BAR __builtin_amdgcn_s_barrier()
#define PG8_SCHED __builtin_amdgcn_sched_barrier(0)
    Unit cur, nxt; int ui = 0;
    if (!S.next(0, cur)) return;
    const int f8sc = 0x7f7f7f7f; (void)f8sc;
    f32x4 acc[2][2][4][2];
#pragma unroll
    for (int a = 0; a < 2; ++a)
#pragma unroll
        for (int b = 0; b < 2; ++b)
#pragma unroll
            for (int m = 0; m < 4; ++m)
#pragma unroll
                for (int n = 0; n < 2; ++n) acc[a][b][m][n] = (f32x4){0.f, 0.f, 0.f, 0.f};
    bf16x8 At[4][2], B0[2][2], B1[2][2];
    const char* cA = (const char*)g.A + (size_t)cur.pm * tstep; const char* cB = (const char*)g.Bt + (size_t)cur.pn * tstep;
    S.a_ready(cur);
    if constexpr (SP2) {
        PG8_STAGE(PG8_SB(0, 0), cB, voffB); PG8_STAGE(PG8_SB(0, 1), cB + hstep, voffB); PG8_STAGE(PG8_SA(0, 0), cA, voffA); PG8_STAGE(PG8_SA(0, 1), cA + hstep, voffA);
        if (wr == 1) PG8_BAR;
        PG8_WAIT_V(2); PG8_BAR;
        PG8_STAGE(PG8_SB(1, 0), cB + kstep, voffB); PG8_STAGE(PG8_SA(1, 0), cA + kstep, voffA); PG8_STAGE(PG8_SB(1, 1), cB + hstep + kstep, voffB);
        PG8_WAIT_V(6); PG8_BAR;
    } else {
        PG8_STAGE(PG8_SB(0, 0), cB, voffB); PG8_STAGE(PG8_SA(0, 0), cA, voffA); PG8_STAGE(PG8_SB(0, 1), cB + hstep, voffB); PG8_STAGE(PG8_SA(0, 1), cA + hstep, voffA);
        if (wr == 1) PG8_BAR;
        PG8_WAIT_V(4); PG8_BAR;
        PG8_STAGE(PG8_SB(1, 0), cB + kstep, voffB); PG8_STAGE(PG8_SA(1, 0), cA + kstep, voffA); PG8_STAGE(PG8_SB(1, 1), cB + hstep + kstep, voffB);
        PG8_WAIT_V(6); PG8_BAR;
    }
    for (;;) {
        const bool has_next = S.next(ui + 1, nxt);
        const char* nA = has_next ? (const char*)g.A + (size_t)nxt.pm * tstep : cA; const char* nB = has_next ? (const char*)g.Bt + (size_t)nxt.pn * tstep : cB;
        for (int t = 0; t < nt; t += 2) {
            const bool last = (t == nt - 2);
            const char* a1 = cA + (size_t)(t + 1) * kstep;
            const char* a2 = last ? nA : cA + (size_t)(t + 2) * kstep; const char* b2 = last ? nB : cB + (size_t)(t + 2) * kstep;
            const char* a3 = a2 + kstep; const char* b3 = b2 + kstep;
            if (last && has_next) S.a_ready(nxt);
            if constexpr (SP2) {
            PG8_LDB(B0, 0, 0); PG8_LDB(B1, 0, 1); PG8_SCHED; PG8_LDA(At, 0, 0); PG8_STAGE(PG8_SA(1, 1), a1 + hstep, voffA);
            PG8_WAIT_V(8); PG8_WAIT_L(0); PG8_BAR; PG8_MMA(0, 0, At, B0); PG8_MMA(0, 1, At, B1); PG8_BAR; PG8_SCHED;
            PG8_LDA(At, 0, 1); PG8_STAGE(PG8_SB(0, 0), b2, voffB); PG8_STAGE(PG8_SB(0, 1), b2 + hstep, voffB); PG8_STAGE(PG8_SA(0, 0), a2, voffA);
            PG8_WAIT_V(8); PG8_WAIT_L(0); PG8_BAR; PG8_MMA(1, 0, At, B0); PG8_MMA(1, 1, At, B1); PG8_BAR; PG8_SCHED;
            PG8_LDB(B0, 1, 0); PG8_LDB(B1, 1, 1); PG8_SCHED; PG8_LDA(At, 1, 0); PG8_STAGE(PG8_SA(0, 1), a2 + hstep, voffA);
            PG8_WAIT_V(8); PG8_WAIT_L(0); PG8_BAR; PG8_MMA(0, 0, At, B0); PG8_MMA(0, 1, At, B1); PG8_BAR; PG8_SCHED;
            PG8_LDA(At, 1, 1); PG8_STAGE(PG8_SB(1, 0), b3, voffB); PG8_STAGE(PG8_SB(1, 1), b3 + hstep, voffB); PG8_STAGE(PG8_SA(1, 0), a3, voffA);
            PG8_WAIT_V(8); PG8_WAIT_L(0); PG8_BAR; PG8_MMA(1, 0, At, B0); PG8_MMA(1, 1, At, B1); PG8_BAR; PG8_SCHED;
            } else {
            PG8_LDB(B0, 0, 0); PG8_SCHED; PG8_LDA(At, 0, 0); PG8_STAGE(PG8_SA(1, 1), a1 + hstep, voffA);
            PG8_WAIT_L(8); PG8_BAR; PG8_WAIT_L(0); PG8_MMA(0, 0, At, B0); PG8_BAR; PG8_SCHED;
            PG8_LDB(B1, 0, 1); PG8_STAGE(PG8_SB(0, 0), b2, voffB);
            PG8_BAR; PG8_WAIT_L(0); PG8_MMA(0, 1, At, B1); PG8_BAR;
            PG8_LDA(At, 0, 1); PG8_STAGE(PG8_SA(0, 0), a2, voffA);
            PG8_BAR; PG8_WAIT_L(0); PG8_MMA(1, 0, At, B0); PG8_BAR; PG8_SCHED;
            PG8_STAGE(PG8_SB(0, 1), b2 + hstep, voffB);
            PG8_WAIT_V(6); PG8_BAR; PG8_MMA(1, 1, At, B1); PG8_BAR;
            PG8_LDB(B0, 1, 0); PG8_SCHED; PG8_LDA(At, 1, 0); PG8_STAGE(PG8_SA(0, 1), a2 + hstep, voffA);
            PG8_WAIT_L(8); PG8_BAR; PG8_WAIT_L(0); PG8_MMA(0, 0, At, B0); PG8_BAR; PG8_SCHED;
            PG8_LDB(B1, 1, 1); PG8_STAGE(PG8_SB(1, 0), b3, voffB);
            PG8_BAR; PG8_WAIT_L(0); PG8_MMA(0, 1, At, B1); PG8_BAR;
            PG8_LDA(At, 1, 1); PG8_STAGE(PG8_SA(1, 0), a3, voffA);
            PG8_BAR; PG8_WAIT_L(0); PG8_MMA(1, 0, At, B0); PG8_BAR; PG8_SCHED;
            PG8_STAGE(PG8_SB(1, 1), b3 + hstep, voffB);
            PG8_WAIT_V(6); PG8_BAR; PG8_MMA(1, 1, At, B1); PG8_BAR;
            }
        }
        if constexpr (F8) { if (F8_ASM) asm volatile("s_nop 15\n\ts_nop 15" ::: "memory"); }
        if constexpr (ALIGN_EPI) { if (wr == 0) PG8_BAR; }
#if defined(EPI_TWICE)
        if constexpr (!Epi::AFTER_DRAIN) { _Pragma("unroll 1") for (int rep_ = 0; rep_ < 2; ++rep_) { E(acc, cur, wr, wc, fr, fq); asm volatile("" ::: "memory"); } S.done(cur); }
#else
        if constexpr (!Epi::AFTER_DRAIN) { E(acc, cur, wr, wc, fr, fq); S.done(cur); }
#endif
        if (!has_next) break;
#pragma unroll
        for (int a = 0; a < 2; ++a)
#pragma unroll
            for (int b = 0; b < 2; ++b)
#pragma unroll
                for (int m = 0; m < 4; ++m)
#pragma unroll
                    for (int n = 0; n < 2; ++n) acc[a][b][m][n] = (f32x4){0.f, 0.f, 0.f, 0.f};
        cur = nxt; cA = nA; cB = nB; ++ui;
        if constexpr (ALIGN_EPI) { if (wr == 1) PG8_BAR; }
    }
    PG8_WAIT_V(0);
    if constexpr (!ALIGN_EPI) { if (wr == 0) PG8_BAR; }
    PG8_BAR;
    if constexpr (Epi::AFTER_DRAIN) { E.fused(acc, cur, wr, wc, fr, fq, lds, wid, lane); S.done(cur); }
#undef PG8_SA
#undef PG8_SB
#undef PG8_STAGE
#undef PG8_LDA
#undef PG8_LDB
#undef PG8_MMA
#undef PG8_WAIT_V
#undef PG8_WAIT_L
#undef PG8_BAR
#undef PG8_SCHED
}
}

#ifndef ATT_NTQ
#define ATT_NTQ 0
#endif
#ifndef ATT_PRIO
#define ATT_PRIO 0
#endif
namespace att {
typedef unsigned short bf16;
typedef short bf16x8 __attribute__((ext_vector_type(8)));
constexpr int D = 128, NW = 8, QBLK = 32, KVBLK = 64, QB = NW * QBLK;
constexpr int SHM_V = KVBLK * D * 2, SHM_K = KVBLK * D * 2;
constexpr int LDS_WS = 2 * SHM_V + 2 * SHM_K;
constexpr int LDS_F = LDS_WS + NW * 64 * 4;
constexpr int LDS_OST = LDS_F + 4096 * 4;
constexpr int LDS_BYTES = LDS_OST + NW * 32 * 64 * 4;
constexpr float SCALE = 0.08838834764831845f;
constexpr float THR = 8.f;

#define KSWZ(row, colB) ((row) * 256 + ((colB) ^ (((row) & 7) << 4)))
#define SBAR() __builtin_amdgcn_sched_barrier(0)
__device__ __forceinline__ int v_st(int k, int c) { const int kk = (k & ~0xC) | ((k & 4) << 1) | ((k & 8) >> 1); return ((kk >> 3) * 4 + (c >> 5)) * 512 + ((kk & 7) * 32 + (c & 31)) * 2; }
__device__ __forceinline__ int v_rd_base(int lane) { return ((lane & 3) << 3) | (((lane >> 2) & 3) << 6) | (((lane >> 4) & 1) << 5) | (((lane >> 5) & 1) << 8); }
constexpr int v_rd_off(int d0, int ks, int half) { return d0 * 512 + ks * 4096 + half * 2048; }
__device__ __forceinline__ int crow(int r, int hi) { return (r & 3) + 8 * (r >> 2) + 4 * hi; }
__device__ __forceinline__ unsigned cvtpk(float lo, float hi) { unsigned r; asm volatile("v_cvt_pk_bf16_f32 %0, %1, %2" : "=v"(r) : "v"(lo), "v"(hi)); return r; }
__device__ __forceinline__ bf16x8 load8(const bf16* p) { return *reinterpret_cast<const bf16x8*>(p); }
__device__ __forceinline__ void mask_tile(f32x16& p0, f32x16& p1, int dq, unsigned W) {
    const float NEG = -__builtin_inff();
#pragma unroll
    for (int r = 0; r < 16; ++r) {
        const int c = (r & 3) + 8 * (r >> 2);
        if ((unsigned)(dq - c) >= W) p0[r] = NEG;
        if ((unsigned)(dq - c - 32) >= W) p1[r] = NEG;
    }
}
__device__ __forceinline__ void partialSM(f32x16& p0, f32x16& p1, float& m_reg, float& mn, float& alpha, bool& dead) {
    float pmax = p0[0]; for (int r = 1; r < 16; ++r) pmax = fmaxf(pmax, p0[r]); for (int r = 0; r < 16; ++r) pmax = fmaxf(pmax, p1[r]);
    { auto rr = __builtin_amdgcn_permlane32_swap(__float_as_uint(pmax), __float_as_uint(pmax), false, false);
      pmax = fmaxf(__uint_as_float(rr[0]), __uint_as_float(rr[1])); }
    constexpr float C2 = 1.4426950408889634f * SCALE;
    dead = __all((pmax - m_reg) * C2 < -40.0f);
    if (dead) { mn = m_reg; alpha = 1.f; return; }
    if (__builtin_expect(__all((pmax - m_reg) * SCALE <= THR), 1)) { mn = m_reg; alpha = 1.f; }
    else { mn = fmaxf(m_reg, pmax); alpha = __builtin_amdgcn_exp2f((m_reg - mn) * C2); m_reg = mn; }
    const float mnL = -mn * C2;
    for (int r = 0; r < 16; ++r) p0[r] = fmaf(p0[r], C2, mnL); for (int r = 0; r < 16; ++r) p1[r] = fmaf(p1[r], C2, mnL);
    for (int r = 0; r < 16; ++r) p0[r] = __builtin_amdgcn_exp2f(p0[r]);
}
__device__ __forceinline__ void finishSM(f32x16& p0, f32x16& p1, float alpha, float& l_reg, bf16x8& pa0, bf16x8& pa1, bf16x8& pa2, bf16x8& pa3) {
    for (int r = 0; r < 16; ++r) p1[r] = __builtin_amdgcn_exp2f(p1[r]);
    float ps = 0; for (int r = 0; r < 16; ++r) ps += p0[r]; for (int r = 0; r < 16; ++r) ps += p1[r];
    { auto rr = __builtin_amdgcn_permlane32_swap(__float_as_uint(ps), __float_as_uint(ps), false, false);
      ps = __uint_as_float(rr[0]) + __uint_as_float(rr[1]); }
    l_reg = l_reg * alpha + ps;
#define PK4(P, B_, OUT) do { unsigned a0 = cvtpk(P[B_+0], P[B_+1]), a1 = cvtpk(P[B_+2], P[B_+3]);                          \
        unsigned b0 = cvtpk(P[B_+4], P[B_+5]), b1 = cvtpk(P[B_+6], P[B_+7]);                                             \
        auto r0 = __builtin_amdgcn_permlane32_swap(a0, b0, false, false); auto r1 = __builtin_amdgcn_permlane32_swap(a1, b1, false, false); \
        u32x4 w = {r0[0], r1[0], r0[1], r1[1]}; OUT = *reinterpret_cast<bf16x8*>(&w); } while (0)
    PK4(p0, 0, pa0); PK4(p0, 8, pa1); PK4(p1, 0, pa2); PK4(p1, 8, pa3);
#undef PK4
}
template <int KB, bool SK, bool FOX>
__device__ __forceinline__ void qkt(f32x16& p0, f32x16& p1, const LAS char* K_lds, int r32, int hi, const bf16x8* qr, bool act, const LAS float* fs  ) {
    if (SK && !act) { const float NEG = -__builtin_inff();
#pragma unroll
        for (int r = 0; r < 16; ++r) { p0[r] = NEG; p1[r] = NEG; } return; }
    if constexpr (FOX) {
#pragma unroll
        for (int g = 0; g < 4; ++g) { const f32x4 a = *(const LAS f32x4*)(fs + 8 * g), b = *(const LAS f32x4*)(fs + 32 + 8 * g);
            p0[4 * g] = a[0]; p0[4 * g + 1] = a[1]; p0[4 * g + 2] = a[2]; p0[4 * g + 3] = a[3];
            p1[4 * g] = b[0]; p1[4 * g + 1] = b[1]; p1[4 * g + 2] = b[2]; p1[4 * g + 3] = b[3]; }
    } else { p0 = f32x16{}; p1 = f32x16{}; }
    const LAS char* kb[4];
#pragma unroll
    for (int dd = 0; dd < 4; ++dd) kb[dd] = K_lds + KB * SHM_K + KSWZ(r32, (dd * 16 + hi * 8) * 2);
#pragma unroll
    for (int d0 = 0; d0 < 8; ++d0) { const LAS char* a = kb[d0 & 3] + (d0 >> 2) * 128;
        bf16x8 b0 = *(const LAS bf16x8*)(a);
        bf16x8 b1 = *(const LAS bf16x8*)(a + 32 * 256);
        if (ATT_PRIO) __builtin_amdgcn_s_setprio(1);
        p0 = __builtin_amdgcn_mfma_f32_32x32x16_bf16(b0, qr[d0], p0, 0, 0, 0);
        p1 = __builtin_amdgcn_mfma_f32_32x32x16_bf16(b1, qr[d0], p1, 0, 0, 0);
        if (ATT_PRIO) __builtin_amdgcn_s_setprio(0); }
}
template <int VB, bool SK>
__device__ __forceinline__ void pv_tile(f32x16* o, int vb0, bf16x8 pa0, bf16x8 pa1, bf16x8 pa2, bf16x8 pa3, bool act) {
    if (SK && !act) return;
#define TRRD(dst, off) asm volatile("ds_read_b64_tr_b16 %0, %1 offset:%2" : "=&v"(dst) : "v"(vb0), "i"(off) : "memory")
#define PV_D0(d0) do { s16x4 l0, l1, l2, l3, h0, h1, h2, h3; constexpr int b_ = VB * SHM_V + v_rd_off(d0, 0, 0);   \
        TRRD(l0, b_); TRRD(h0, b_ + 2048); TRRD(l1, b_ + 4096); TRRD(h1, b_ + 6144); TRRD(l2, b_ + 8192); TRRD(h2, b_ + 10240); TRRD(l3, b_ + 12288); TRRD(h3, b_ + 14336); \
        asm volatile("s_waitcnt lgkmcnt(0)" ::: "memory"); SBAR(); if (ATT_PRIO) __builtin_amdgcn_s_setprio(1);   \
        o[d0] = __builtin_amdgcn_mfma_f32_32x32x16_bf16(pa0, (bf16x8){l0[0], l0[1], l0[2], l0[3], h0[0], h0[1], h0[2], h0[3]}, o[d0], 0, 0, 0);   \
        o[d0] = __builtin_amdgcn_mfma_f32_32x32x16_bf16(pa1, (bf16x8){l1[0], l1[1], l1[2], l1[3], h1[0], h1[1], h1[2], h1[3]}, o[d0], 0, 0, 0);   \
        o[d0] = __builtin_amdgcn_mfma_f32_32x32x16_bf16(pa2, (bf16x8){l2[0], l2[1], l2[2], l2[3], h2[0], h2[1], h2[2], h2[3]}, o[d0], 0, 0, 0);   \
        o[d0] = __builtin_amdgcn_mfma_f32_32x32x16_bf16(pa3, (bf16x8){l3[0], l3[1], l3[2], l3[3], h3[0], h3[1], h3[2], h3[3]}, o[d0], 0, 0, 0); if (ATT_PRIO) __builtin_amdgcn_s_setprio(0); } while (0)
    PV_D0(0); PV_D0(1); PV_D0(2); PV_D0(3);
#undef PV_D0
#undef TRRD
}

template <size_t OQ, size_t OK, size_t OV, size_t OZ, size_t OO> struct Bases { const unsigned char* ws;
    __device__ __forceinline__ const bf16* Q() const { return (const bf16*)(ws + OQ); } __device__ __forceinline__ const bf16* K() const { return (const bf16*)(ws + OK); }
    __device__ __forceinline__ const bf16* V() const { return (const bf16*)(ws + OV); } __device__ __forceinline__ const bf16* Z() const { return (const bf16*)(ws + OZ); }
    __device__ __forceinline__ bf16* O() const { return (bf16*)(ws + OO); } };
struct BlockRef { unsigned qoff; unsigned kvoff; int P0; int jlo; const float* sinks; float qk; };
struct Seam { bf16x8 qr[8]; bf16x8 st_v0, st_v1, st_k0, st_k1; };
__device__ __forceinline__ int swa_jlo(int P0, int W) { const int lowk = P0 - W + 1; return lowk > 0 ? lowk / KVBLK : 0; }
#define UROW(p, k0) ((const char*)(p) + (size_t)((k0) + wid * 4) * (LDKV * 2))
#define VMW() asm volatile("s_waitcnt vmcnt(0)" ::: "memory")
#define VMWN(n) asm volatile("s_waitcnt vmcnt(%0)" :: "i"(n) : "memory")
#define SLOAD_H(Kp, Vp, k0) do { const char* vu_ = UROW(Vp, k0); const char* ku_ = UROW(Kp, k0);                                   \
                         S.st_v0 = *(const bf16x8*)(vu_ + kvlane); S.st_v1 = *(const bf16x8*)(vu_ + 32 * LDKV * 2 + kvlane);              \
                         S.st_k0 = *(const bf16x8*)(ku_ + kvlane); S.st_k1 = *(const bf16x8*)(ku_ + 32 * LDKV * 2 + kvlane); } while (0)
#define SWRITE_HK(bf) do { *(LAS bf16x8*)(K_lds + (bf) * SHM_K + kws) = S.st_k0; *(LAS bf16x8*)(K_lds + (bf) * SHM_K + kws + 32 * 256) = S.st_k1; } while (0)
#define SWRITE_HV(bf) do { *(LAS bf16x8*)(V_lds + (bf) * SHM_V + vst0) = S.st_v0; *(LAS bf16x8*)(V_lds + (bf) * SHM_V + vst1) = S.st_v1; } while (0)
#define SWRITE_H(bf) do { SWRITE_HV(bf); SWRITE_HK(bf); } while (0)
template <bool FOX, int LDQ, int LDKV, class BasesT>
__device__ __forceinline__ void attn_prime(const BasesT& T, const BlockRef& cur, int W, LAS char* lds, Seam& S) {
    const int tid = threadIdx.x, wid = __builtin_amdgcn_readfirstlane(tid >> 6), lane = tid & 63, r32 = lane & 31, hi = lane >> 5;
    const int sr = tid >> 4, sc = (tid & 15) * 8, kws = KSWZ(sr, sc * 2); LAS char* K_lds = lds + 2 * SHM_V;
    const unsigned kvlane = (unsigned)((lane >> 4) * LDKV + sc) * 2u, qlane = (unsigned)(r32 * LDQ + hi * 8) * 2u;
    const int kb0 = FOX ? ((cur.P0 + QB - 1) / KVBLK) * KVBLK : swa_jlo(cur.P0, W) * KVBLK;
    { const char* qu = (const char*)(T.Q() + cur.qoff) + (size_t)wid * (FOX ? QBLK * LDQ * 2 : D * 2);
      for (int d0 = 0; d0 < 8; ++d0) S.qr[d0] = ATT_NTQ ? __builtin_nontemporal_load((const bf16x8*)(qu + d0 * 32 + qlane)) : *(const bf16x8*)(qu + d0 * 32 + qlane); }
    SLOAD_H(T.K() + cur.kvoff, T.V() + cur.kvoff, kb0); VMW(); SWRITE_HK(0);
    __syncthreads();
}
template <bool FOX, int LDQ, int LDKV, int LDO, class BasesT>
__device__ __forceinline__ void attn_block(const BasesT& T, const BlockRef& cur, const BlockRef& nxt, int skv, int W, LAS char* lds, Seam& S) {
    constexpr bool SK = WSKIP_ON && !FOX;
    const int tid = threadIdx.x, wid = __builtin_amdgcn_readfirstlane(tid >> 6), lane = tid & 63, r32 = lane & 31, hi = lane >> 5;
    const int j_lo = FOX ? cur.jlo : swa_jlo(cur.P0, W);
    int j_hi = (cur.P0 + (FOX ? QB : QBLK) - 1) / KVBLK + 1; if (j_hi > skv / KVBLK) j_hi = skv / KVBLK;
    int NT = j_hi - j_lo;
    const int kbn = FOX ? ((nxt.P0 + QB - 1) / KVBLK) * KVBLK : swa_jlo(nxt.P0, W) * KVBLK;
    const int qlo = cur.P0 + (FOX ? wid * QBLK : 0), qm = qlo + r32 - 4 * hi;
    LAS char* V_lds = lds; LAS char* K_lds = lds + 2 * SHM_V;
    LAS float* ws = (LAS float*)(lds + LDS_WS) + wid * 64; LAS float* li_l = ws; LAS float* al_l = ws + 32;
    const LAS float* Fs = (const LAS float*)(lds + LDS_F) + 4 * hi;
    float m_reg = -1e30f, l_reg = 0; f32x16 o[4] = {};
    const int sr = tid >> 4, sc = (tid & 15) * 8, vst0 = v_st(sr, sc), vst1 = v_st(32 + sr, sc), kws = KSWZ(sr, sc * 2);
    const unsigned kvlane = (unsigned)((lane >> 4) * LDKV + sc) * 2u, qlane = (unsigned)(r32 * LDQ + hi * 8) * 2u;
    const int vb0 = (int)(uintptr_t)V_lds + v_rd_base(lane);
    const unsigned kvo = cur.kvoff;
#define Kh (T.K() + kvo)
#define Vh (T.V() + kvo)
#define RESC(a) do { if (__any((a) < 1.f)) { if (hi == 0) al_l[r32] = (a); asm volatile("s_waitcnt lgkmcnt(0)" ::: "memory");              \
                     for (int d_ = 0; d_ < 4; ++d_) for (int r = 0; r < 16; ++r) o[d_][r] *= al_l[crow(r, hi)]; } } while (0)
#define KBASE(t) ((FOX ? (j_hi - 1 - (t)) : (j_lo + (t))) * KVBLK)
#define ACT(t) (KBASE(t) <= qlo + QBLK - 1 && KBASE(t) + KVBLK - 1 >= qlo - W + 1)
#define MASKT(P0_, P1_, t) do { const int kb_ = KBASE(t); if ((!SK || ACT(t)) && (kb_ + KVBLK - 1 > qlo || kb_ <= qlo + QBLK - 1 - W)) mask_tile(P0_, P1_, qm - kb_, (unsigned)W); } while (0)
    constexpr int NQL = 8;
#define SEAM_K0() do { VMWN(NQL); SWRITE_HK(0); SBAR(); } while (0)
    f32x16 pA0, pA1, pB0, pB1; float mnA, mnB, alA, alB; bf16x8 pa0, pa1, pa2, pa3;
    SWRITE_HV(0); SBAR();
    if (NT > 1) { SLOAD_H(Kh, Vh, KBASE(1)); }
    SBAR(); qkt<0, SK, FOX>(pA0, pA1, K_lds, r32, hi, S.qr, ACT(0), Fs + KBASE(0));
    bool deadA = false, deadB = false;
    MASKT(pA0, pA1, 0); partialSM(pA0, pA1, m_reg, mnA, alA, deadA);
    if (NT > 1) { VMW(); SWRITE_H(1); }
    __syncthreads();
#define HALF_STEP(PX0, PX1, mnX, alX, deadX, PY0, PY1, alY, deadY, t, KB, VB, SB) do {                                                      \
        SBAR(); qkt<KB, SK, FOX>(PX0, PX1, K_lds, r32, hi, S.qr, ACT(t), Fs + KBASE(t));                                     \
        if (!deadY) finishSM(PY0, PY1, alY, l_reg, pa0, pa1, pa2, pa3); SBAR();                                               \
        if ((t) + 1 < NT) { SLOAD_H(Kh, Vh, KBASE((t) + 1)); SBAR(); }                                                        \
        if (!deadY) pv_tile<VB, SK>(o, vb0, pa0, pa1, pa2, pa3, ACT((t) - 1)); MASKT(PX0, PX1, (t)); partialSM(PX0, PX1, m_reg, mnX, alX, deadX);  \
        __syncthreads();                                                                                                      \
        if ((t) + 1 < NT) { VMW(); SWRITE_H(SB); }                                                                            \
        RESC(alX); __syncthreads(); } while (0)
    for (int t = 1; t + 1 < NT; t += 2) {
        HALF_STEP(pB0, pB1, mnB, alB, deadB, pA0, pA1, alA, deadA, t, 1, 0, 0);
        HALF_STEP(pA0, pA1, mnA, alA, deadA, pB0, pB1, alB, deadB, t + 1, 0, 1, 1);
        if constexpr (FOX) { if (t == 3 && NT > 6) {
            float mw = m_reg;
#pragma unroll
            for (int o_ = 1; o_ < 32; o_ <<= 1) mw = fminf(mw, __shfl_xor(mw, o_));
            if (lane == 0) li_l[0] = mw;
            asm volatile("s_waitcnt lgkmcnt(0)" ::: "memory"); __syncthreads();
            const LAS float* slot = (const LAS float*)(lds + LDS_WS); float mb = slot[0];
#pragma unroll
            for (int w_ = 1; w_ < NW; ++w_) mb = fminf(mb, slot[w_ * 64]);
            const LAS float* Fb = (const LAS float*)(lds + LDS_F);
            const unsigned long long alive = __ballot(Fb[64 * lane + 63] + cur.qk > mb - (40.0f / (1.4426950408889634f * SCALE) + 16.0f));
            int jd = alive ? (int)__builtin_ctzll(alive) : 63; if (jd < j_lo) jd = j_lo;
            int nt2 = j_hi - jd; if (nt2 < 6) nt2 = 6;
            if (nt2 < NT) NT = nt2;
        } }
    }
    const bool even = (NT & 1) == 0;
    if (even) { SBAR(); qkt<1, SK, FOX>(pB0, pB1, K_lds, r32, hi, S.qr, ACT(NT - 1), Fs + KBASE(NT - 1)); SBAR(); }
    SLOAD_H(T.K() + nxt.kvoff, T.V() + nxt.kvoff, kbn); SBAR();
    { const char* qu = (const char*)(T.Q() + nxt.qoff) + (size_t)wid * (FOX ? QBLK * LDQ * 2 : D * 2);
#pragma unroll
      for (int d0 = 0; d0 < 8; ++d0) S.qr[d0] = ATT_NTQ ? __builtin_nontemporal_load((const bf16x8*)(qu + d0 * 32 + qlane)) : *(const bf16x8*)(qu + d0 * 32 + qlane); }
    SBAR();
    if (!deadA) finishSM(pA0, pA1, alA, l_reg, pa0, pa1, pa2, pa3); SBAR();
    if (!deadA) pv_tile<0, SK>(o, vb0, pa0, pa1, pa2, pa3, ACT(even ? NT - 2 : NT - 1));
    if (even) { MASKT(pB0, pB1, NT - 1); partialSM(pB0, pB1, m_reg, mnB, alB, deadB); __syncthreads(); RESC(alB);
        if (!deadB) { finishSM(pB0, pB1, alB, l_reg, pa0, pa1, pa2, pa3); SBAR(); pv_tile<1, SK>(o, vb0, pa0, pa1, pa2, pa3, ACT(NT - 1)); } }
    SBAR(); SEAM_K0();
    const int c8 = lane & 7, rr = lane >> 3;
    u32x4 zq[2][4];
    { const char* Zu = (const char*)(T.Z() + cur.qoff) + (size_t)wid * (FOX ? QBLK * LDO * 2 : D * 2) + (unsigned)(rr * LDO + c8 * 8) * 2u;
#pragma unroll
      for (int h2 = 0; h2 < 2; ++h2)
#pragma unroll
          for (int j = 0; j < 4; ++j) zq[h2][j] = ATT_NTQ ? __builtin_nontemporal_load((const u32x4*)(Zu + j * (8 * LDO * 2) + h2 * 128)) : *(const u32x4*)(Zu + j * (8 * LDO * 2) + h2 * 128); }
    if constexpr (!FOX) l_reg += __builtin_amdgcn_exp2f(cur.sinks[wid] * 1.4426950408889634f - m_reg * (1.4426950408889634f * SCALE));
    if (hi == 0) li_l[r32] = l_reg; asm volatile("s_waitcnt lgkmcnt(0)" ::: "memory");
    float rli[16];
#pragma unroll
    for (int r = 0; r < 16; ++r) rli[r] = __builtin_amdgcn_rcpf(li_l[crow(r, hi)]) * ((!FOX && FP8_G4) ? F8_OSCALE : 1.0f);
    LAS float* ost = (LAS float*)(lds + LDS_OST) + wid * (32 * 64);
    char* Ou = (char*)(T.O() + cur.qoff) + (size_t)wid * (FOX ? QBLK * LDO * 2 : D * 2) + (unsigned)(rr * LDO + c8 * 8) * 2u;
    char* Ou8 = (char*)T.O() + cur.qoff + (size_t)wid * D + (unsigned)(rr * LDO + c8 * 8); (void)Ou8;
#pragma unroll
    for (int h2 = 0; h2 < 2; ++h2) {
#pragma unroll
        for (int r = 0; r < 16; ++r) { const int row = crow(r, hi); ost[row * 64 + r32] = o[2 * h2][r] * rli[r]; ost[row * 64 + 32 + r32] = o[2 * h2 + 1][r] * rli[r]; }
        asm volatile("s_waitcnt lgkmcnt(0)" ::: "memory");
#pragma unroll
        for (int j = 0; j < 4; ++j) { const LAS float* sp = ost + (rr + 8 * j) * 64 + c8 * 8; const f32x4 a = *(const LAS f32x4*)sp, bq = *(const LAS f32x4*)(sp + 4); const u32x4 z = zq[h2][j];
            u32x4 w; w.x = cvtpk(a[0] * __uint_as_float(z.x << 16), a[1] * __uint_as_float(z.x & 0xffff0000u)); w.y = cvtpk(a[2] * __uint_as_float(z.y << 16), a[3] * __uint_as_float(z.y & 0xffff0000u));
            w.z = cvtpk(bq[0] * __uint_as_float(z.z << 16), bq[1] * __uint_as_float(z.z & 0xffff0000u)); w.w = cvtpk(bq[2] * __uint_as_float(z.w << 16), bq[3] * __uint_as_float(z.w & 0xffff0000u));
            if constexpr (!FOX && FP8_G4) {
#define C8_(v) __builtin_amdgcn_fmed3f((v), -448.0f, 448.0f)
                u32x2 w8; { int t_ = __builtin_amdgcn_cvt_pk_fp8_f32(C8_(a[0] * __uint_as_float(z.x << 16)), C8_(a[1] * __uint_as_float(z.x & 0xffff0000u)), 0, false);
                            t_ = __builtin_amdgcn_cvt_pk_fp8_f32(C8_(a[2] * __uint_as_float(z.y << 16)), C8_(a[3] * __uint_as_float(z.y & 0xffff0000u)), t_, true); w8.x = (unsigned)t_; }
                          { int t_ = __builtin_amdgcn_cvt_pk_fp8_f32(C8_(bq[0] * __uint_as_float(z.z << 16)), C8_(bq[1] * __uint_as_float(z.z & 0xffff0000u)), 0, false);
                            t_ = __builtin_amdgcn_cvt_pk_fp8_f32(C8_(bq[2] * __uint_as_float(z.w << 16)), C8_(bq[3] * __uint_as_float(z.w & 0xffff0000u)), t_, true); w8.y = (unsigned)t_; }
#undef C8_
                *(u32x2*)(Ou8 + j * (8 * LDO) + h2 * 64) = w8;
            } else
            *(u32x4*)(Ou + j * (8 * LDO * 2) + h2 * 128) = w; }
        asm volatile("s_waitcnt lgkmcnt(0)" ::: "memory");
    }
    __syncthreads();
#undef Kh
#undef Vh
#undef RESC
#undef KBASE
#undef ACT
#undef MASKT
#undef SEAM_K0
#undef HALF_STEP
}
#undef UROW
#undef VMW
#undef VMWN
#undef SLOAD_H
#undef SWRITE_HK
#undef SWRITE_HV
#undef SWRITE_H
#undef SBAR
#undef KSWZ
}

#define XB_TMO      128
#define XB_XCNT(j)  (256  + 64 * (j))
#define XB_XSUB(j)  (1280 + 64 * (j))
#define XB_XGEN(j)  (2304 + 64 * (j))
#define XB_TOP      3328
#define XB_TOPGEN   3392
#define XCD_BAR_WORDS 3456
#define XB_SPIN_CAP (1u << 18)
#ifndef BAR_FLAT
#define BAR_FLAT 0
#endif

__device__ __forceinline__ unsigned xb_ld(unsigned* p)              { return __hip_atomic_load(p, __ATOMIC_RELAXED, __HIP_MEMORY_SCOPE_AGENT); }
__device__ __forceinline__ unsigned xb_add(unsigned* p, unsigned v) { return __hip_atomic_fetch_add(p, v, __ATOMIC_RELAXED, __HIP_MEMORY_SCOPE_AGENT); }
__device__ __forceinline__ unsigned xb_xcc_id() { return (unsigned)__builtin_amdgcn_s_getreg((3 << 11) | 20) & 0xFu; }
#define XB_SPIN(cond, bar) do { unsigned _sp = 0; while (cond) { __builtin_amdgcn_s_sleep(1); \
    if ((++_sp & 255u) == 0u) { if (xb_ld(&(bar)[XB_TMO])) break; if (_sp > XB_SPIN_CAP) { atomicAdd(&(bar)[XB_TMO], 1u); break; } } } } while (0)

struct XcdBarrier {
    unsigned* bar; unsigned x;
    volatile LAS unsigned* st;
};

__device__ __forceinline__ XcdBarrier xcd_barrier_post(unsigned* bar, volatile LAS unsigned* st) {
    XcdBarrier b; b.bar = bar; b.x = xb_xcc_id(); b.st = st;
    if (threadIdx.x == 0) (void)xb_add(&bar[XB_XCNT(b.x)], 1u);
    return b;
}
__device__ __forceinline__ void xcd_barrier_complete(unsigned* bar, unsigned x, unsigned& nloc, unsigned& nx) {
    const unsigned G = gridDim.x * gridDim.y * gridDim.z;
    unsigned sum, cnt, mine, sp = 0u;
    for (;;) {
        sum = 0u; cnt = 0u; mine = 0u;
#pragma unroll
        for (unsigned j = 0; j < 16; ++j) { const unsigned c = xb_ld(&bar[XB_XCNT(j)]); sum += c; cnt += (c > 0u) ? 1u : 0u; mine = (j == x) ? c : mine; }
        if (sum == G) break;
        __builtin_amdgcn_s_sleep(1);
        if ((++sp & 255u) == 0u) { if (xb_ld(&bar[XB_TMO])) break; if (sp > XB_SPIN_CAP) { atomicAdd(&bar[XB_TMO], 1u); break; } }
    }
    nloc = mine > 0u ? mine : 1u; nx = cnt > 0u ? cnt : 1u;
}

__device__ __forceinline__ void xcd_barrier(const XcdBarrier& b) {
    asm volatile("s_waitcnt vmcnt(0)" ::: "memory");
    __syncthreads();
    if (threadIdx.x == 0) {
        unsigned* bar = b.bar;
        __builtin_amdgcn_s_waitcnt(0);
        unsigned nloc = b.st[0], nx = b.st[1];
        if (nloc == 0u) { xcd_barrier_complete(bar, b.x, nloc, nx); b.st[0] = nloc; b.st[1] = nx; }
        const unsigned old = xb_add(&bar[XB_XSUB(b.x)], 1u);
        const unsigned gen = old / nloc;
        if (old + 1u == (gen + 1u) * nloc) {
            __builtin_amdgcn_fence(__ATOMIC_RELEASE, "agent");
            asm volatile("s_waitcnt vmcnt(0)" ::: "memory");
            const unsigned og = xb_add(&bar[XB_TOP], 1u);
            const unsigned tg = og / nx;
            if (og + 1u == (tg + 1u) * nx) xb_add(&bar[XB_TOPGEN], 1u);
            else XB_SPIN(xb_ld(&bar[XB_TOPGEN]) == tg, bar);
            __builtin_amdgcn_fence(__ATOMIC_ACQUIRE, "agent");
            if (!BAR_FLAT) xb_add(&bar[XB_XGEN(b.x)], 1u);
            asm volatile("s_waitcnt vmcnt(0)" ::: "memory");
        } else {
            if (BAR_FLAT) XB_SPIN(xb_ld(&bar[XB_TOPGEN]) == gen, bar);
            else XB_SPIN(xb_ld(&bar[XB_XGEN(b.x)]) == gen, bar);
            __builtin_amdgcn_fence(__ATOMIC_ACQUIRE, "agent");
            asm volatile("s_waitcnt vmcnt(0)" ::: "memory");
        }
    }
    __syncthreads();
}


constexpr size_t MiB = 1u << 20;
constexpr size_t WS_CTL = 0, CTL_ZERO_BYTES = 1 * MiB;
constexpr size_t WS_SLAB = 1 * MiB;
constexpr size_t WS_MOD = 3 * MiB;
constexpr size_t WS_ROPE = 4 * MiB;
constexpr size_t WS_LOGF = 6 * MiB;
constexpr size_t WS_WFT = 7 * MiB;
constexpr size_t WS_W1T = 8 * MiB;
constexpr size_t WS_W2T = 136 * MiB;
constexpr size_t WS_W3T = 168 * MiB;
constexpr size_t WS_WKVT = 232 * MiB;
constexpr size_t WS_W4T = 240 * MiB;
constexpr size_t WS_HB = 272 * MiB;
constexpr size_t WS_KVN = 336 * MiB;
constexpr size_t WS_Q = 400 * MiB, WS_K = 464 * MiB, WS_V = 528 * MiB, WS_Z = 592 * MiB;
constexpr size_t WS_OG = 656 * MiB;
constexpr size_t WS_H1 = 720 * MiB;
constexpr size_t WS_KV1 = 848 * MiB;
constexpr size_t WS_FDBG = 864 * MiB;
constexpr size_t WS_W3I = 866 * MiB;
constexpr size_t WS_W1I = 898 * MiB;
constexpr size_t WS_H0I = 930 * MiB;
constexpr size_t WS_END = 962 * MiB;
constexpr size_t WS_SW = 256 * 1024;
constexpr size_t WS_SA1 = 384 * 1024;
constexpr size_t WS_SA0 = 448 * 1024;
constexpr int CW_BAR = 4096;
constexpr int CW_QUEUE = 8192;
constexpr int CW_NORM = 8448;

constexpr int LDS_BYTES = 155648;
constexpr int MISC_OFF = LDS_BYTES - 256;
constexpr int NWAVES = 8, NTHR = 512;
static_assert(att::LDS_BYTES <= MISC_OFF && 131072 <= MISC_OFF, "LDS map");

struct Params { const float* in[14]; float* out; unsigned char* ws; int ph_lo, ph_hi; };
enum { I_X = 0, I_C, I_NORMG, I_ADAW, I_ADAB, I_AWIN, I_ABF, I_AWOUT, I_KVG, I_KVW, I_BWIN, I_SINK, I_BWOUT, I_FING };

struct Frame { LAS unsigned char* lds; int tid, lane, wave, vcu, G; };

__device__ __forceinline__ float wave_sum(float v) {
#pragma unroll
    for (int o = 1; o < 64; o <<= 1) v += __shfl_xor(v, o);
    return v;
}
__device__ __forceinline__ unsigned f2bf(float f) { unsigned u = __builtin_bit_cast(unsigned, f); return (u + 0x7fffu + ((u >> 16) & 1u)) >> 16; }
__device__ __forceinline__ unsigned pk2(float lo, float hi) { return f2bf(lo) | (f2bf(hi) << 16); }
__device__ __forceinline__ float bf2f(unsigned short b) { return __uint_as_float((unsigned)b << 16); }

#ifndef EMUI8_G1
#define EMUI8_G1 0
#endif
#ifndef EMUI8_SMOOTH
#define EMUI8_SMOOTH 0
#endif
#ifndef EMUI8_C1
#define EMUI8_C1 (1 << 30)
#endif
#ifndef EMUI8_C0
#define EMUI8_C0 0
#endif
#ifndef EMUI8_G3
#define EMUI8_G3 0
#endif
#ifndef EMU8_G3
#define EMU8_G3 0
#endif
typedef float f32x2_ __attribute__((ext_vector_type(2)));
__device__ __forceinline__ void rnd8_2(float& a, float& b, float sc) { const int w = __builtin_amdgcn_cvt_pk_fp8_f32(a * sc, b * sc, 0, false); const f32x2_ r = __builtin_amdgcn_cvt_pk_f32_fp8(w, false); a = r[0] / sc; b = r[1] / sc; }
#ifndef P0_NT
#define P0_NT 1
#endif
#ifndef P0_NTS
#define P0_NTS 0
#endif
#if P0_NT
#define P0_LOAD(p) __builtin_nontemporal_load(p)
#else
#define P0_LOAD(p) (*(p))
#endif
#if P0_NTS
#define P0_STORE(p, v) __builtin_nontemporal_store(v, p)
#else
#define P0_STORE(p, v) (*(p) = (v))
#endif
#if defined(TR128)
template <class RowMap>
__device__ __forceinline__ void transpose_item(const float* W, int ldw, int K, int k0, int c0, bf16_t* WT, RowMap rowmap, LAS float* scr, int lane) {
    const int kk = lane >> 3, nn = (lane & 7) * 4;
    f32x4 v[16];
#pragma unroll
    for (int i = 0; i < 16; ++i) v[i] = *(const GAS f32x4*)(W + (size_t)(k0 + 8 * i + kk) * ldw + c0 + nn);
#pragma unroll
    for (int i = 0; i < 16; ++i) { LAS float* s = scr + (8 * i + kk) * 33 + nn; s[0] = v[i][0]; s[1] = v[i][1]; s[2] = v[i][2]; s[3] = v[i][3]; }
    asm volatile("s_waitcnt lgkmcnt(0)" ::: "memory");
    const int c = lane & 15, nr = lane >> 4;
#pragma unroll
    for (int j = 0; j < 8; ++j) { const int n = nr + 4 * j; const LAS float* s = scr + (8 * c) * 33 + n;
        u32x4 o; o.x = pk2(s[0 * 33], s[1 * 33]); o.y = pk2(s[2 * 33], s[3 * 33]); o.z = pk2(s[4 * 33], s[5 * 33]); o.w = pk2(s[6 * 33], s[7 * 33]);
        *(GAS u32x4*)(WT + (size_t)rowmap(c0 + n) * K + k0 + 8 * c) = o; }
    asm volatile("s_waitcnt lgkmcnt(0)" ::: "memory");
}
#define TR_KB 128
#define TR_NB 32
#define TR_SCR (128 * 33)
#else
template <class RowMap, bool EMU8 = false, bool EMUI8 = false>
__device__ __forceinline__ void transpose_item(const float* W, int ldw, int K, int k0, int c0, bf16_t* WT, RowMap rowmap, LAS float* scr, int lane) {
    const int kk = lane >> 4, nn = (lane & 15) * 4;
    f32x4 v[16];
#pragma unroll
    for (int i = 0; i < 16; ++i) v[i] = P0_LOAD((const GAS f32x4*)(W + (size_t)(k0 + 4 * i + kk) * ldw + c0 + nn));
#pragma unroll
    for (int i = 0; i < 16; ++i) { LAS float* s = scr + (4 * i + kk) * 65 + nn; s[0] = v[i][0]; s[1] = v[i][1]; s[2] = v[i][2]; s[3] = v[i][3]; }
    asm volatile("s_waitcnt lgkmcnt(0)" ::: "memory");
    const int c = lane & 7, nr = lane >> 3;
#pragma unroll
    for (int j = 0; j < 8; ++j) { const int n = nr + 8 * j; const LAS float* s = scr + (8 * c) * 65 + n;
        float e_[8];
#pragma unroll
        for (int q_ = 0; q_ < 8; ++q_) e_[q_] = s[q_ * 65];
        if (EMU8) { rnd8_2(e_[0], e_[1], 64.f); rnd8_2(e_[2], e_[3], 64.f); rnd8_2(e_[4], e_[5], 64.f); rnd8_2(e_[6], e_[7], 64.f); }
#if EMUI8_G1 || EMUI8_G3
        if (EMUI8 && (c0 + n) >= EMUI8_C0 && (c0 + n) < EMUI8_C1) {
#pragma unroll
            for (int q_ = 0; q_ < 8; ++q_) e_[q_] = rintf(__builtin_amdgcn_fmed3f(e_[q_] * (127.0f * 64.0f / 4.2f), -127.0f, 127.0f)) * (4.2f / (127.0f * 64.0f)); }
#endif
        u32x4 o; o.x = pk2(e_[0], e_[1]); o.y = pk2(e_[2], e_[3]); o.z = pk2(e_[4], e_[5]); o.w = pk2(e_[6], e_[7]);
        P0_STORE((GAS u32x4*)(WT + (size_t)rowmap(c0 + n) * K + k0 + 8 * c), o); }
    asm volatile("s_waitcnt lgkmcnt(0)" ::: "memory");
}
__device__ __forceinline__ unsigned pk4_fp8(float a, float b, float c, float d) { a = __builtin_amdgcn_fmed3f(a, -448.0f, 448.0f); b = __builtin_amdgcn_fmed3f(b, -448.0f, 448.0f); c = __builtin_amdgcn_fmed3f(c, -448.0f, 448.0f); d = __builtin_amdgcn_fmed3f(d, -448.0f, 448.0f);
    int w = __builtin_amdgcn_cvt_pk_fp8_f32(a, b, 0, false); w = __builtin_amdgcn_cvt_pk_fp8_f32(c, d, w, true); return (unsigned)w; }
template <class RowMap>
__device__ __forceinline__ void transpose_item8(const float* W, int ldw, int K, int k0, int c0, unsigned char* WT8, RowMap rowmap, float sc, LAS float* scr, int lane) {
    const int kk = lane >> 4, nn = (lane & 15) * 4;
    f32x4 v[16];
#pragma unroll
    for (int i = 0; i < 16; ++i) v[i] = P0_LOAD((const GAS f32x4*)(W + (size_t)(k0 + 4 * i + kk) * ldw + c0 + nn));
#pragma unroll
    for (int i = 0; i < 16; ++i) { LAS float* s = scr + (4 * i + kk) * 65 + nn; s[0] = v[i][0]; s[1] = v[i][1]; s[2] = v[i][2]; s[3] = v[i][3]; }
    asm volatile("s_waitcnt lgkmcnt(0)" ::: "memory");
    const int c = lane & 7, nr = lane >> 3;
#pragma unroll
    for (int j = 0; j < 8; ++j) { const int n = nr + 8 * j; const LAS float* s = scr + (8 * c) * 65 + n;
        u32x2 o; o.x = pk4_fp8(s[0 * 65] * sc, s[1 * 65] * sc, s[2 * 65] * sc, s[3 * 65] * sc); o.y = pk4_fp8(s[4 * 65] * sc, s[5 * 65] * sc, s[6 * 65] * sc, s[7 * 65] * sc);
        *(GAS u32x2*)(WT8 + (size_t)rowmap(c0 + n) * K + k0 + 8 * c) = o; }
    asm volatile("s_waitcnt lgkmcnt(0)" ::: "memory");
}
#define TR_KB 64
#define TR_NB 64
#define TR_SCR (64 * 65)
#endif
__device__ __forceinline__ unsigned pk4_i8(float a, float b, float c, float d) {
    const int ia = (int)rintf(__builtin_amdgcn_fmed3f(a, -127.f, 127.f)), ib = (int)rintf(__builtin_amdgcn_fmed3f(b, -127.f, 127.f)), ic = (int)rintf(__builtin_amdgcn_fmed3f(c, -127.f, 127.f)), id = (int)rintf(__builtin_amdgcn_fmed3f(d, -127.f, 127.f));
    return (unsigned)(ia & 255) | ((unsigned)(ib & 255) << 8) | ((unsigned)(ic & 255) << 16) | ((unsigned)id << 24);
}
#ifndef RQ_ROWS
#define RQ_ROWS 4
#endif
__device__ __forceinline__ void requant_rows(const Frame& F, const bf16_t* src, unsigned char* dst, float* sw, int nrows) {
    const int gw = F.vcu * NWAVES + F.wave, NGW = F.G * NWAVES;
#pragma unroll 1
    for (int row = gw; row < nrows; row += RQ_ROWS * NGW) {
        u32x4 v[RQ_ROWS][8];
#pragma unroll
        for (int r = 0; r < RQ_ROWS; ++r) { const int rl_ = row + r * NGW < nrows ? row + r * NGW : nrows - 1; const GAS u32x4* sp = (const GAS u32x4*)(src + (size_t)rl_ * DM) + F.lane;
#pragma unroll
            for (int j = 0; j < 8; ++j) v[r][j] = __builtin_nontemporal_load(sp + 64 * j); }
#pragma unroll
        for (int r = 0; r < RQ_ROWS; ++r) { unsigned am = 0u;
#pragma unroll
            for (int j = 0; j < 8; ++j)
#pragma unroll
                for (int e = 0; e < 4; ++e) { const unsigned w_ = v[r][j][e]; const unsigned a_ = (w_ << 16) & 0x7fffffffu, b_ = w_ & 0x7fff0000u; am = am > a_ ? am : a_; am = am > b_ ? am : b_; }
#pragma unroll
            for (int o = 1; o < 64; o <<= 1) { const unsigned n_ = (unsigned)__shfl_xor((int)am, o); am = am > n_ ? am : n_; }
            const float mx = __uint_as_float(am); const float qs = mx > 0.f ? 127.0f / mx : 0.f;
            if (row + r * NGW >= nrows) break;
            if (F.lane == 0) sw[row + r * NGW] = mx * (1.0f / 127.0f);
            GAS u32x2* dp = (GAS u32x2*)(dst + (size_t)(row + r * NGW) * DM) + F.lane;
#pragma unroll
            for (int j = 0; j < 8; ++j) { u32x2 o;
                o.x = pk4_i8(__uint_as_float(v[r][j].x << 16) * qs, __uint_as_float(v[r][j].x & 0xffff0000u) * qs, __uint_as_float(v[r][j].y << 16) * qs, __uint_as_float(v[r][j].y & 0xffff0000u) * qs);
                o.y = pk4_i8(__uint_as_float(v[r][j].z << 16) * qs, __uint_as_float(v[r][j].z & 0xffff0000u) * qs, __uint_as_float(v[r][j].w << 16) * qs, __uint_as_float(v[r][j].w & 0xffff0000u) * qs);
                dp[64 * j] = o; } }
    }
}
struct RowId { __device__ __forceinline__ int operator()(int c) const { return c; } };
struct RowRope { int lim; __device__ __forceinline__ int operator()(int c) const { if (c >= lim) return c; const int j = c & 127, jj = j & 63; return (c & ~127) + 8 * (jj >> 2) + ((j >> 6) << 2) + (jj & 3); } };

__device__ __forceinline__ void p0_prologue(const Frame& F, const Params& P) {
    unsigned char* ws = P.ws;
#ifndef P0A_REP
#define P0A_REP 1
#endif
    _Pragma("unroll 1") for (int repa_ = 0; repa_ < P0A_REP; ++repa_)
    {
        LAS float* sc = (LAS float*)F.lds;
        LAS float* red = (LAS float*)(F.lds + 32768);
        const float* c = P.in[I_C];
        for (int i = F.tid; i < 2 * DM; i += NTHR) { const float v = c[i]; sc[i] = v / (1.0f + __expf(-v)); }
        __syncthreads();
        float* slab = (float*)(ws + WS_SLAB);
        for (int t = F.vcu; t < 768; t += F.G) {
            const int cg = t % 96, ks = t / 96, l = cg / 48, n0 = (cg % 48) * 256;
            const float* Wp = P.in[I_ADAW] + (size_t)l * DM * MOD + (size_t)(ks * 512 + F.wave * 64) * MOD + n0 + 4 * F.lane;
            const LAS float* s0 = sc + ks * 512 + F.wave * 64; const LAS float* s1 = s0 + DM;
            f32x4 a0 = (f32x4){0.f, 0.f, 0.f, 0.f}, a1 = a0;
#ifndef ADA_UNROLL
#define ADA_UNROLL 16
#endif
#if defined(ADA_DMA)
            { LAS unsigned char* dbuf = F.lds + 49152 + F.wave * 8192;
              const char* gsrc = (const char*)Wp;
#define ADA_ISSUE(c_) do { _Pragma("unroll") for (int r_ = 0; r_ < 4; ++r_) \
                __builtin_amdgcn_global_load_lds((const unsigned*)(gsrc + (size_t)((c_) * 4 + r_) * (MOD * 4)), (LAS unsigned*)(dbuf + ((c_) & 1) * 4096 + r_ * 1024), 16, 0, 0); } while (0)
              ADA_ISSUE(0); ADA_ISSUE(1);
#pragma unroll 1
              for (int c_ = 0; c_ < 16; ++c_) {
                  if (c_ < 15) asm volatile("s_waitcnt vmcnt(4)" ::: "memory"); else asm volatile("s_waitcnt vmcnt(0)" ::: "memory");
                  const LAS unsigned char* bb = dbuf + (c_ & 1) * 4096 + F.lane * 16;
#pragma unroll
                  for (int r_ = 0; r_ < 4; ++r_) { const f32x4 w = *(const LAS f32x4*)(bb + r_ * 1024); a0 += w * s0[c_ * 4 + r_]; a1 += w * s1[c_ * 4 + r_]; }
                  asm volatile("s_waitcnt lgkmcnt(0)" ::: "memory");
                  if (c_ + 2 < 16) ADA_ISSUE(c_ + 2);
              }
#undef ADA_ISSUE
            }
#else
#pragma unroll ADA_UNROLL
            for (int kk = 0; kk < 64; ++kk) { const f32x4 w = P0_LOAD((const GAS f32x4*)(Wp + (size_t)kk * MOD)); a0 += w * s0[kk]; a1 += w * s1[kk]; }
#endif
            *(LAS f32x4*)(red + (F.wave * 2 + 0) * 256 + 4 * F.lane) = a0; *(LAS f32x4*)(red + (F.wave * 2 + 1) * 256 + 4 * F.lane) = a1;
            __syncthreads();
            { const int b = F.tid >> 8, col = F.tid & 255; float s = 0.f;
#pragma unroll
              for (int w = 0; w < 8; ++w) s += red[(w * 2 + b) * 256 + col];
              slab[(size_t)((ks * 2 + l) * 2 + b) * MOD + n0 + col] = s; }
            __syncthreads();
        }
    }
    {
        LAS float* scr = (LAS float*)F.lds + F.wave * TR_SCR;
        const int gw = F.vcu * NWAVES + F.wave, NGW = F.G * NWAVES;
        constexpr int KBL = DM / TR_KB;
        constexpr int I1 = KBL * (N1 / TR_NB), I2 = KBL * (DM / TR_NB), IKV = KBL * (NKV2 / TR_NB), I3 = KBL * (N3 / TR_NB), I4 = I2;
        constexpr int NIT = I1 + I2 + IKV + I3 + I4;
        for (int it = gw; it < NIT; it += NGW) {
            int r = it;
            if (r < I2) { transpose_item(P.in[I_AWOUT], DM, DM, (r % KBL) * TR_KB, (r / KBL) * TR_NB, (bf16_t*)(ws + WS_W2T), RowId{}, scr, F.lane); continue; } r -= I2;
            if (r < IKV) { transpose_item(P.in[I_KVW], NKV2, DM, (r % KBL) * TR_KB, (r / KBL) * TR_NB, (bf16_t*)(ws + WS_WKVT), RowRope{KVW}, scr, F.lane); continue; } r -= IKV;
#if I8_G3
            if (r < I3) { transpose_item(P.in[I_BWIN], N3, DM, (r % KBL) * TR_KB, (r / KBL) * TR_NB, (bf16_t*)(ws + WS_W3T), RowRope{DM}, scr, F.lane); continue; } r -= I3;
#elif FP8_G3
            if (r < I3) { transpose_item8(P.in[I_BWIN], N3, DM, (r % KBL) * TR_KB, (r / KBL) * TR_NB, ws + WS_W3T, RowRope{DM}, F8_WSCALE, scr, F.lane); continue; } r -= I3;
#else
            if (r < I3) { transpose_item<RowRope, EMU8_G3 != 0, EMUI8_G3 != 0>(P.in[I_BWIN], N3, DM, (r % KBL) * TR_KB, (r / KBL) * TR_NB, (bf16_t*)(ws + WS_W3T), RowRope{DM}, scr, F.lane); continue; } r -= I3;
#endif
#if FP8_G4
            if (r < I4) { transpose_item8(P.in[I_BWOUT], DM, DM, (r % KBL) * TR_KB, (r / KBL) * TR_NB, ws + WS_W4T, RowId{}, F8_WSCALE, scr, F.lane); continue; } r -= I4;
#else
            if (r < I4) { transpose_item(P.in[I_BWOUT], DM, DM, (r % KBL) * TR_KB, (r / KBL) * TR_NB, (bf16_t*)(ws + WS_W4T), RowId{}, scr, F.lane); continue; } r -= I4;
#endif
            transpose_item<RowId, false, EMUI8_G1 != 0>(P.in[I_AWIN], N1F, DM, (r % KBL) * TR_KB, (r / KBL) * TR_NB, (bf16_t*)(ws + WS_W1T), RowId{}, scr, F.lane);
        }
    }
    {
        const int gt = F.vcu * NTHR + F.tid, NGT = F.G * NTHR;
        bf16_t* wft = (bf16_t*)(ws + WS_WFT); const float* W = P.in[I_AWIN];
        for (int i = gt; i < NH * DM; i += NGT) { const int k = i >> 5, n = i & 31; wft[(size_t)n * DM + k] = (bf16_t)f2bf(W[(size_t)k * N1F + N1 + n]); }
        float* cs = (float*)(ws + WS_ROPE); float* sn = cs + SEQ * 64;
        for (int i = gt; i < SEQ * 64; i += NGT) {
            const int pos = i >> 6, j = i & 63;
            double th = 1.0; for (int q = 0; q < j; ++q) th *= 0.8659643233600653523531691834202299819398;
            const double t2 = th * th; double cc = 1.0, ss = th, tc = 1.0, ts = th;
#pragma unroll
            for (int q = 1; q <= 11; ++q) { tc *= t2 * (-1.0 / (double)((2 * q - 1) * (2 * q))); ts *= t2 * (-1.0 / (double)((2 * q) * (2 * q + 1))); cc += tc; ss += ts; }
            double rc = 1.0, rs = 0.0;
            for (int mbit = 0; mbit < 12; ++mbit) {
                if ((pos >> mbit) & 1) { const double nc = rc * cc - rs * ss, ns = rs * cc + rc * ss; rc = nc; rs = ns; }
                const double c2 = cc * cc - ss * ss, s2 = 2.0 * ss * cc; cc = c2; ss = s2;
            }
            cs[i] = (float)rc; sn[i] = (float)rs;
        }
    }
}

__device__ __forceinline__ void p1_norm0(const Frame& F, const Params& P) {
    unsigned char* ws = P.ws;
    const float* slab = (const float*)(ws + WS_SLAB); float* mod = (float*)(ws + WS_MOD);
    for (int i = F.vcu * NTHR + F.tid; i < 2 * 2 * MOD; i += F.G * NTHR) {
        const int n = i % MOD, lb = i / MOD, l = lb >> 1; float s = P.in[I_ADAB][l * MOD + n];
#pragma unroll
        for (int ks = 0; ks < 8; ++ks) s += slab[(size_t)(ks * 4 + lb) * MOD + n];
        mod[i] = s;
    }
    LAS float* gs = (LAS float*)F.lds; LAS float* sh = gs + DM;
    LAS float* red = sh + DM;
    bf16_t* h0 = (bf16_t*)(ws + WS_HB); const bf16_t* wft = (const bf16_t*)(ws + WS_WFT); float* logf = (float*)(ws + WS_LOGF);
    for (int rb = F.vcu; rb < M / 32; rb += F.G) {
        const int row0 = rb * 32, b = row0 / SEQ;
        __syncthreads();
        for (int k = F.tid; k < DM; k += NTHR) {
            float s_sh = P.in[I_ADAB][k], s_sc = P.in[I_ADAB][DM + k];
#pragma unroll
            for (int ks = 0; ks < 8; ++ks) { const float* sl = slab + (size_t)(ks * 4 + b) * MOD; s_sh += sl[k]; s_sc += sl[DM + k]; }
            gs[k] = P.in[I_NORMG][k] * (1.0f + s_sc); sh[k] = s_sh;
#if EMUI8_G1 && EMUI8_SMOOTH
            { float o_sc = P.in[I_ADAB][DM + k];
#pragma unroll
              for (int ks = 0; ks < 8; ++ks) o_sc += (slab + (size_t)(ks * 4 + (1 - b)) * MOD)[DM + k];
              ((LAS float*)F.lds + 16384)[k] = fmaxf(fmaxf(fabsf(P.in[I_NORMG][k] * (1.0f + s_sc)), fabsf(P.in[I_NORMG][k] * (1.0f + o_sc))), 1e-3f); }
#endif
        }
        __syncthreads();
#pragma unroll 1
        for (int rr = 0; rr < 4; ++rr) {
            const int row = row0 + F.wave * 4 + rr;
            const GAS f32x4* xr = (const GAS f32x4*)(P.in[I_X] + (size_t)row * DM) + F.lane;
            f32x4 v[16]; float ss = 0.f;
#pragma unroll
            for (int j = 0; j < 16; ++j) { v[j] = P1_NT ? __builtin_nontemporal_load(xr + 64 * j) : xr[64 * j]; ss += (v[j].x * v[j].x + v[j].y * v[j].y) + (v[j].z * v[j].z + v[j].w * v[j].w); }
            const float rstd = 1.0f / sqrtf(wave_sum(ss) * (1.0f / DM) + EPS);
            GAS u32x2* o8 = (GAS u32x2*)(h0 + (size_t)row * DM) + F.lane;
#if EMUI8_G1 && !defined(EMUI8_NOA)
            float amax_ = 0.f;
#pragma unroll
            for (int j = 0; j < 16; ++j) { const f32x4 g = *(const LAS f32x4*)(gs + 256 * j + 4 * F.lane), s = *(const LAS f32x4*)(sh + 256 * j + 4 * F.lane);
                f32x4 y = v[j] * rstd * g + s;
#if EMUI8_SMOOTH
                y = y / *(const LAS f32x4*)((LAS float*)F.lds + 16384 + 256 * j + 4 * F.lane);
#endif
                amax_ = fmaxf(fmaxf(amax_, fmaxf(fabsf(y.x), fabsf(y.y))), fmaxf(fabsf(y.z), fabsf(y.w))); asm volatile("" ::: "memory"); }
#pragma unroll
            for (int o_ = 1; o_ < 64; o_ <<= 1) amax_ = fmaxf(amax_, __shfl_xor(amax_, o_));
            const float qs_ = 127.0f / amax_, iq_ = amax_ / 127.0f;
#pragma unroll
            for (int j = 0; j < 16; ++j) { const f32x4 g = *(const LAS f32x4*)(gs + 256 * j + 4 * F.lane), s = *(const LAS f32x4*)(sh + 256 * j + 4 * F.lane);
#if EMUI8_SMOOTH
                const f32x4 ck_ = *(const LAS f32x4*)((LAS float*)F.lds + 16384 + 256 * j + 4 * F.lane);
#else
                const f32x4 ck_ = (f32x4){1.f, 1.f, 1.f, 1.f};
#endif
                const f32x4 y0_ = (v[j] * rstd * g + s) / ck_ * qs_;
                const f32x4 y = (f32x4){rintf(y0_.x), rintf(y0_.y), rintf(y0_.z), rintf(y0_.w)} * iq_ * ck_; u32x2 w; w.x = pk2(y.x, y.y); w.y = pk2(y.z, y.w); o8[64 * j] = w; asm volatile("" ::: "memory"); }
#elif I8_G1
            float amax_ = 0.f;
#pragma unroll
            for (int j = 0; j < 16; ++j) { const f32x4 g = *(const LAS f32x4*)(gs + 256 * j + 4 * F.lane), s = *(const LAS f32x4*)(sh + 256 * j + 4 * F.lane);
                const f32x4 y = v[j] * rstd * g + s; amax_ = fmaxf(fmaxf(amax_, fmaxf(fabsf(y.x), fabsf(y.y))), fmaxf(fabsf(y.z), fabsf(y.w))); asm volatile("" ::: "memory"); }
#pragma unroll
            for (int o_ = 1; o_ < 64; o_ <<= 1) amax_ = fmaxf(amax_, __shfl_xor(amax_, o_));
            const float qs_ = amax_ > 0.f ? 127.0f / amax_ : 0.f;
            if (F.lane == 0) ((float*)(ws + WS_SA0))[row] = amax_ * (1.0f / 127.0f);
            GAS unsigned* o4 = (GAS unsigned*)(ws + WS_H0I + (size_t)row * DM) + F.lane;
#pragma unroll
            for (int j = 0; j < 16; ++j) { const f32x4 g = *(const LAS f32x4*)(gs + 256 * j + 4 * F.lane), s = *(const LAS f32x4*)(sh + 256 * j + 4 * F.lane);
                const f32x4 y = v[j] * rstd * g + s; u32x2 w; w.x = pk2(y.x, y.y); w.y = pk2(y.z, y.w); o8[64 * j] = w; o4[64 * j] = pk4_i8(y.x * qs_, y.y * qs_, y.z * qs_, y.w * qs_); asm volatile("" ::: "memory"); }
#else
#pragma unroll
            for (int j = 0; j < 16; ++j) { const f32x4 g = *(const LAS f32x4*)(gs + 256 * j + 4 * F.lane), s = *(const LAS f32x4*)(sh + 256 * j + 4 * F.lane);
                const f32x4 y = v[j] * rstd * g + s; u32x2 w; w.x = pk2(y.x, y.y); w.y = pk2(y.z, y.w); o8[64 * j] = w; }
#endif
        }
        asm volatile("s_waitcnt vmcnt(0)" ::: "memory");
        __syncthreads();
        {
            const int r = F.lane & 31, hh = F.lane >> 5;
            const bf16_t* ap = wft + (size_t)r * DM + F.wave * 512 + 8 * hh;
            const bf16_t* bp = h0 + (size_t)(row0 + r) * DM + F.wave * 512 + 8 * hh;
            f32x16 acc = {};
#pragma unroll 8
            for (int k = 0; k < 512; k += 16) { const bf16x8 a = *(const GAS bf16x8*)(ap + k), bb = *(const GAS bf16x8*)(bp + k); acc = __builtin_amdgcn_mfma_f32_32x32x16_bf16(a, bb, acc, 0, 0, 0); }
#pragma unroll
            for (int q = 0; q < 16; ++q) red[(F.wave * 16 + q) * 64 + F.lane] = acc[q];
            __syncthreads();
#pragma unroll
            for (int qq = 0; qq < 2; ++qq) { const int q = 2 * F.wave + qq; float s = 0.f;
#pragma unroll
                for (int w = 0; w < 8; ++w) s += red[(w * 16 + q) * 64 + F.lane];
                const int n = (q & 3) + 8 * (q >> 2) + 4 * hh;
                const float xg = s + P.in[I_ABF][n];
                const float lf = fminf(xg, 0.f) - log1pf(__expf(-fabsf(xg)));
                logf[(size_t)(b * NH + n) * SEQ + (row0 % SEQ) + r] = lf; }
        }
    }
#if I8_G3
    requant_rows(F, (const bf16_t*)(ws + WS_W3T), ws + WS_W3I, (float*)(ws + WS_SW), 8192);
#endif
#if I8_G1
    requant_rows(F, (const bf16_t*)(ws + WS_W1T), ws + WS_W1I, (float*)(ws + WS_SW) + 8192, 8192);
#endif
}

template <class DstPtr>
__device__ __forceinline__ void scan_logf(const Frame& F, const float* lf, DstPtr dst, float scale, LAS float* wsum) {
    unsigned lo_ = 32u * (unsigned)F.tid; asm volatile("" : "+v"(lo_));
    const f32x4 a = *(const GAS f32x4*)((const char*)lf + lo_), b = *(const GAS f32x4*)((const char*)lf + lo_ + 16);
    float v[8] = {a.x, a.y, a.z, a.w, b.x, b.y, b.z, b.w};
#pragma unroll
    for (int e = 1; e < 8; ++e) v[e] += v[e - 1];
    const float total = v[7]; float incl = total; int ln_ = (int)(lo_ >> 5) & 63;
#pragma unroll
    for (int o = 1; o < 64; o <<= 1) { const float n = __int_as_float(__builtin_amdgcn_ds_bpermute((ln_ - o) << 2, __float_as_int(incl))); if (ln_ >= o) incl += n; }
    if (ln_ == 63) wsum[F.wave] = incl;
    __syncthreads();
    float off = incl - total;
    for (int w = 0; w < F.wave; ++w) off += wsum[w];
#pragma unroll
    for (int e = 0; e < 8; ++e) dst[8 * F.tid + e] = scale * (off + v[e]);
    __syncthreads();
}

#ifndef FOX_ORDER
#define FOX_ORDER 0
#endif
__device__ __forceinline__ int fox_qb(int n) { return FOX_ORDER ? 15 - (((n >> 8) << 2) | (n & 3)) : 15 - (n >> 6); }
__device__ __forceinline__ int fox_bh(int n) { return FOX_ORDER ? (n & 255) >> 2 : n & 63; }
__device__ __forceinline__ att::BlockRef fox_ref(int n, int jlo, float qk) {
    const int qb = fox_qb(n), bh = fox_bh(n), b = bh >> 5, h = bh & 31; att::BlockRef r;
    r.kvoff = (unsigned)b * (SEQ * DM) + h * HD; r.qoff = r.kvoff + (unsigned)qb * (256u * DM); r.P0 = qb * 256; r.jlo = jlo; r.sinks = nullptr; r.qk = qk; return r;
}
__device__ __forceinline__ int fox_jlo(const Frame& F, int n, const unsigned* nrm, float& qk) {
    const int qb = fox_qb(n), bh = fox_bh(n), b = bh >> 5, h = bh & 31;
    const float* nq = (const float*)nrm + ((0 * 2 + b) * 32 + h) * 4; const float* nk = (const float*)nrm + ((1 * 2 + b) * 32 + h) * 4;
    const float q2 = (nq[0] + nq[1]) + (nq[2] + nq[3]), k2 = (nk[0] + nk[1]) + (nk[2] + nk[3]);
    qk = 1.03f * sqrtf(q2 * k2);
    const float X = 40.0f / (LOG2E * att::SCALE) + att::THR / att::SCALE + 2.0f * qk + 16.0f;
#if defined(PROBE_X)
    const float Xp = (float)(PROBE_X);
#define X Xp
#endif
    const LAS float* Fs = (const LAS float*)(F.lds + att::LDS_F);
    const float thresh = Fs[qb * 256] - X;
    const unsigned long long m = __ballot(Fs[64 * F.lane + 63] > thresh);
    return m ? __builtin_ctzll(m) : 63;
#if defined(PROBE_X)
#undef X
#endif
}
__device__ __forceinline__ void p3_fox(const Frame& F, const Params& P, LAS char* lds, volatile LAS unsigned* MISC) {
    unsigned char* ws = P.ws;
#define logf ((const float*)(ws + WS_LOGF))
#define qhead ((unsigned*)(ws + WS_CTL) + CW_QUEUE)
#define nrm ((const unsigned*)(ws + WS_CTL) + CW_NORM)
    att::Bases<WS_Q, WS_K, WS_V, WS_Z, WS_OG> T; T.ws = ws;
    int n_cur = F.vcu;
    if (F.tid == 0) MISC[16] = 256u + __hip_atomic_fetch_add(qhead, 1u, __ATOMIC_RELAXED, __HIP_MEMORY_SCOPE_AGENT);
    scan_logf(F, logf + (size_t)fox_bh(n_cur) * SEQ, (LAS float*)(F.lds + att::LDS_F), -SQRT_HD, (LAS float*)(F.lds + att::LDS_WS));
    int n_nxt = (int)MISC[16];
    att::Seam S;
    float qk_ = 0.f; const int jl0_ = fox_jlo(F, n_cur, nrm, qk_);
    att::BlockRef cur = fox_ref(n_cur, jl0_, qk_);
    att::attn_prime<true, DM, DM>(T, cur, 1 << 28, lds, S);
#pragma unroll 1
    for (;;) {
        const bool has_next = n_nxt < 1024;
        const att::BlockRef nxt = has_next ? fox_ref(n_nxt, 0, 0.f) : cur;
        att::attn_block<true, DM, DM, DM>(T, cur, nxt, SEQ, 1 << 28, lds, S);
        if (!has_next) break;
        unsigned n_nn = 0u;
        if (F.tid == 0) n_nn = 256u + __hip_atomic_fetch_add(qhead, 1u, __ATOMIC_RELAXED, __HIP_MEMORY_SCOPE_AGENT);
        if (fox_bh(n_nxt) != fox_bh(n_cur)) scan_logf(F, logf + (size_t)fox_bh(n_nxt) * SEQ, (LAS float*)(F.lds + att::LDS_F), -SQRT_HD, (LAS float*)(F.lds + att::LDS_WS));
        { float qk2_ = 0.f; const int jl_ = fox_jlo(F, n_nxt, nrm, qk2_); cur = fox_ref(n_nxt, jl_, qk2_); }
        if (F.tid == 0) MISC[16] = n_nn;
        __syncthreads();
        n_cur = n_nxt; n_nxt = (int)MISC[16];
        __syncthreads();
    }
#undef logf
#undef qhead
#undef nrm
}
__device__ __forceinline__ att::BlockRef swa_ref(int rb, int b, int kvh, const float* sinks) {
    att::BlockRef r; r.qoff = ((unsigned)b * SEQ + (unsigned)rb * 32u) * DM + kvh * 8 * HD; r.kvoff = (unsigned)b * (SEQ * NKV2) + kvh * HD; r.P0 = rb * 32; r.jlo = 0; r.qk = 0.f; r.sinks = sinks + kvh * 8; return r;
}
__device__ __forceinline__ void p7_swa(const Frame& F, const Params& P, LAS char* lds) {
    unsigned char* ws = P.ws;
    { const int it = F.vcu;
        const int g8 = it >> 5, b = g8 >> 2, kvh = g8 & 3, i0 = (it & 31) * 4;
        att::Bases<WS_Q, WS_KV1, WS_KV1 + (size_t)KVW * 2, WS_Z, WS_OG> T; T.ws = ws;
        att::Seam S;
        att::BlockRef cur = swa_ref(i0, b, kvh, P.in[I_SINK]);
        att::attn_prime<false, DM, NKV2>(T, cur, 128, lds, S);
#pragma unroll 1
        for (int t = 0; t < 4; ++t) { const att::BlockRef nxt = (t < 3) ? swa_ref(i0 + t + 1, b, kvh, P.in[I_SINK]) : cur; att::attn_block<false, DM, NKV2, DM>(T, cur, nxt, SEQ, 128, lds, S); cur = nxt; }
    }
}

__device__ __forceinline__ void p5_norm1(const Frame& F, const Params& P) {
    unsigned char* ws = P.ws;
    const float* mod = (const float*)(ws + WS_MOD); const float* h1 = (const float*)(ws + WS_H1);
    bf16_t* hb = (bf16_t*)(ws + WS_HB); bf16_t* kvn = (bf16_t*)(ws + WS_KVN);
    LAS float* gs = (LAS float*)F.lds; LAS float* sh = gs + DM; LAS float* gk = sh + DM;
    for (int rb = F.vcu; rb < M / 32; rb += F.G) {
        const int row0 = rb * 32, b = row0 / SEQ;
        __syncthreads();
        for (int k = F.tid; k < DM; k += NTHR) { const float* m1 = mod + (size_t)(2 + b) * MOD; gs[k] = P.in[I_NORMG][DM + k] * (1.0f + m1[DM + k]); sh[k] = m1[k]; gk[k] = P.in[I_KVG][k]; }
        __syncthreads();
#pragma unroll 1
        for (int rr = 0; rr < 4; ++rr) {
            const int row = row0 + F.wave * 4 + rr;
            const GAS f32x4* xr = (const GAS f32x4*)(h1 + (size_t)row * DM) + F.lane;
            f32x4 v[16]; float ss = 0.f;
#pragma unroll
            for (int j = 0; j < 16; ++j) { v[j] = xr[64 * j]; ss += (v[j].x * v[j].x + v[j].y * v[j].y) + (v[j].z * v[j].z + v[j].w * v[j].w); }
            const float rstd = 1.0f / sqrtf(wave_sum(ss) * (1.0f / DM) + EPS);
            GAS u32x2* o1 = (GAS u32x2*)(hb + (size_t)row * DM) + F.lane; GAS u32x2* o2 = (GAS u32x2*)(kvn + (size_t)row * DM) + F.lane;
#if EMUI8_G3 || I8_G3
            float am5_ = 0.f;
#pragma unroll
            for (int j = 0; j < 16; ++j) { const int kx = 256 * j + 4 * F.lane; const f32x4 g = *(const LAS f32x4*)(gs + kx), s = *(const LAS f32x4*)(sh + kx); const f32x4 y = v[j] * rstd * g + s;
                am5_ = fmaxf(fmaxf(am5_, fmaxf(fabsf(y.x), fabsf(y.y))), fmaxf(fabsf(y.z), fabsf(y.w))); asm volatile("" ::: "memory"); }
#pragma unroll
            for (int o_ = 1; o_ < 64; o_ <<= 1) am5_ = fmaxf(am5_, __shfl_xor(am5_, o_));
            const float qs5_ = am5_ > 0.f ? 127.0f / am5_ : 0.f, iq5_ = am5_ / 127.0f; (void)iq5_;
#if I8_G3
            if (F.lane == 0) ((float*)(ws + WS_SA1))[row] = iq5_;
#endif
#endif
#pragma unroll
            for (int j = 0; j < 16; ++j) { const int kx = 256 * j + 4 * F.lane; const f32x4 g = *(const LAS f32x4*)(gs + kx), s = *(const LAS f32x4*)(sh + kx), k4 = *(const LAS f32x4*)(gk + kx);
                const f32x4 xn = v[j] * rstd, z = xn * k4; f32x4 y = xn * g + s; u32x2 w;
#if I8_G3
                { ((GAS unsigned*)((unsigned char*)hb + (size_t)row * DM))[64 * j + F.lane] = pk4_i8(y.x * qs5_, y.y * qs5_, y.z * qs5_, y.w * qs5_); w.x = pk2(z.x, z.y); w.y = pk2(z.z, z.w); o2[64 * j] = w; asm volatile("" ::: "memory"); continue; }
#elif FP8_G3
                { ((GAS unsigned*)((unsigned char*)hb + (size_t)row * DM))[64 * j + F.lane] = pk4_fp8(y.x * F8_HSCALE, y.y * F8_HSCALE, y.z * F8_HSCALE, y.w * F8_HSCALE); w.x = pk2(z.x, z.y); w.y = pk2(z.z, z.w); o2[64 * j] = w; asm volatile("" ::: "memory"); continue; }
#endif
#if EMUI8_G3
                { const f32x4 yq_ = y * qs5_; y = (f32x4){rintf(yq_.x), rintf(yq_.y), rintf(yq_.z), rintf(yq_.w)} * iq5_; }
#endif
                if (EMU8_G3) { float y0_ = y.x, y1_ = y.y, y2_ = y.z, y3_ = y.w; rnd8_2(y0_, y1_, 8.f); rnd8_2(y2_, y3_, 8.f); y = (f32x4){y0_, y1_, y2_, y3_}; } w.x = pk2(y.x, y.y); w.y = pk2(y.z, y.w); o1[64 * j] = w; w.x = pk2(z.x, z.y); w.y = pk2(z.z, z.w); o2[64 * j] = w;
                asm volatile("" ::: "memory"); }
        }
    }
}
#ifndef OUT_NT
#define OUT_NT 0
#endif
__device__ __forceinline__ void p9_final(const Frame& F, const Params& P) {
    LAS float* gf = (LAS float*)F.lds;
    __syncthreads();
    for (int k = F.tid; k < DM; k += NTHR) gf[k] = P.in[I_FING][k];
    __syncthreads();
    const int gw = F.vcu * NWAVES + F.wave, NGW = F.G * NWAVES;
    for (int row = gw; row < M; row += NGW) {
        GAS f32x4* xr = (GAS f32x4*)(P.out + (size_t)row * DM) + F.lane;
        f32x4 v[16]; float ss = 0.f;
#pragma unroll
        for (int j = 0; j < 16; ++j) { v[j] = xr[64 * j]; ss += (v[j].x * v[j].x + v[j].y * v[j].y) + (v[j].z * v[j].z + v[j].w * v[j].w); }
        const float rstd = 1.0f / sqrtf(wave_sum(ss) * (1.0f / DM) + EPS);
#pragma unroll
        for (int j = 0; j < 16; ++j) { const f32x4 y_ = v[j] * rstd * *(const LAS f32x4*)(gf + 256 * j + 4 * F.lane);
#if OUT_NT
            __builtin_nontemporal_store(y_, xr + 64 * j); }
#else
            xr[64 * j] = y_; }
#endif
    }
}


template <class E, class Sched>
__device__ __forceinline__ void naive_gemm_bf16(const Frame& F, const bf16_t* A, const bf16_t* Bt, int K, const Sched& S, const E& e, const float* cs, const float* sn) {
    const int r = F.lane & 31, hh = F.lane >> 5; pg8::Unit u;
    for (int i = 0; S.next(i, u); ++i) {
        const pg8::Dest d = e.dest(u); const int rowu = e.row_of(u);
        for (int t = F.wave; t < 64; t += NWAVES) {
            const int tr = t >> 3, tc = t & 7;
            const bf16_t* ap = A + ((size_t)u.pm * 256 + tr * 32 + r) * K + 8 * hh; const bf16_t* bp = Bt + ((size_t)u.pn * 256 + tc * 32 + r) * K + 8 * hh;
            f32x16 acc = {};
#pragma unroll 4
            for (int k = 0; k < K; k += 16) { const bf16x8 a = *(const GAS bf16x8*)(ap + k), b = *(const GAS bf16x8*)(bp + k); acc = __builtin_amdgcn_mfma_f32_32x32x16_bf16(a, b, acc, 0, 0, 0); }
#pragma unroll
            for (int q = 0; q < 16; ++q) {
                const int row = rowu + tr * 32 + (q & 3) + 8 * (q >> 2) + 4 * hh, p = tc * 32 + r; float v = acc[q];
                if (d.mode == 1) v = pg8::silu_f(v);
                const float partner = __shfl_xor(v, 4);
                if (d.mode == 2) { const int pos = row & 4095, j = 4 * ((p & 127) >> 3) + (p & 3); const float c = cs[pos * 64 + j], s = sn[pos * 64 + j]; v = (p & 4) ? (v * c + partner * s) : (v * c - partner * s); }
                d.p[(size_t)row * d.ld + p] = (bf16_t)f2bf(v);
            }
        }
    }
}
template <class Sched>
__device__ __forceinline__ void naive_gemm_resgate(const Frame& F, const bf16_t* A, const bf16_t* Bt, int K, const Sched& S, const pg8::EpiResGate& e) {
    const int r = F.lane & 31, hh = F.lane >> 5; pg8::Unit u;
    for (int i = 0; S.next(i, u); ++i)
        for (int t = F.wave; t < 64; t += NWAVES) {
            const int tr = t >> 3, tc = t & 7;
            const bf16_t* ap = A + ((size_t)u.pm * 256 + tr * 32 + r) * K + 8 * hh; const bf16_t* bp = Bt + ((size_t)u.pn * 256 + tc * 32 + r) * K + 8 * hh;
            f32x16 acc = {};
#pragma unroll 4
            for (int k = 0; k < K; k += 16) { const bf16x8 a = *(const GAS bf16x8*)(ap + k), b = *(const GAS bf16x8*)(bp + k); acc = __builtin_amdgcn_mfma_f32_32x32x16_bf16(a, b, acc, 0, 0, 0); }
#pragma unroll
            for (int q = 0; q < 16; ++q) { const int row = u.pm * 256 + tr * 32 + (q & 3) + 8 * (q >> 2) + 4 * hh, col = u.pn * 256 + tc * 32 + r; const size_t off = (size_t)row * 4096 + col;
                e.out[off] = e.base[off] + e.gate[(size_t)(row >> 12) * e.gate_ld + col] * acc[q]; }
        }
}
template <bool FOX>
__device__ __forceinline__ void naive_attn(const Frame& F, const Params& P) {
    unsigned char* ws = P.ws;
    const bf16_t* Q = (const bf16_t*)(ws + WS_Q); const bf16_t* Z = (const bf16_t*)(ws + WS_Z); bf16_t* OG = (bf16_t*)(ws + WS_OG);
    LAS float* Fl = (LAS float*)F.lds; LAS float* qs = Fl + 4096 + F.wave * 128; LAS float* wsum = Fl + 4096 + 8 * 128;
    for (int it = F.vcu; it < 256; it += F.G) {
        const int bh = it >> 2, s4 = it & 3, b = bh >> 5, h = bh & 31;
        __syncthreads();
        if (FOX) scan_logf(F, (const float*)(ws + WS_LOGF) + (size_t)bh * SEQ, Fl, 1.0f, wsum);
        const bf16_t* Kp; const bf16_t* Vp; int ldkv;
        if (FOX) { Kp = (const bf16_t*)(ws + WS_K) + (size_t)b * SEQ * DM + h * HD; Vp = (const bf16_t*)(ws + WS_V) + (size_t)b * SEQ * DM + h * HD; ldkv = DM; }
        else { Kp = (const bf16_t*)(ws + WS_KV1) + (size_t)b * SEQ * NKV2 + (h >> 3) * HD; Vp = Kp + KVW; ldkv = NKV2; }
        const float sink = FOX ? 0.f : P.in[I_SINK][h];
        for (int t = F.wave; t < SEQ / 4; t += NWAVES) {
            const int i = 4 * t + s4; const size_t qo = ((size_t)b * SEQ + i) * DM + h * HD;
            { const unsigned qq = *(const GAS unsigned*)(Q + qo + 2 * F.lane); qs[2 * F.lane] = __uint_as_float(qq << 16) * att::SCALE; qs[2 * F.lane + 1] = __uint_as_float(qq & 0xffff0000u) * att::SCALE; }
            asm volatile("s_waitcnt lgkmcnt(0)" ::: "memory");
            float m = -1e30f, l = 0.f, o0 = 0.f, o1 = 0.f;
            const int jst = FOX ? 0 : (i > 127 ? i - 127 : 0);
            for (int jc = jst; jc <= i; jc += 64) {
                const int j = jc + F.lane; const bool valid = j <= i; const int jl = valid ? j : i;
                const bf16_t* kr = Kp + (size_t)jl * ldkv; float dot = 0.f;
#pragma unroll 4
                for (int d = 0; d < 128; d += 8) { const u32x4 kk = *(const GAS u32x4*)(kr + d); const LAS float* qd = qs + d;
                    dot += __uint_as_float(kk.x << 16) * qd[0] + __uint_as_float(kk.x & 0xffff0000u) * qd[1] + __uint_as_float(kk.y << 16) * qd[2] + __uint_as_float(kk.y & 0xffff0000u) * qd[3]
                         + __uint_as_float(kk.z << 16) * qd[4] + __uint_as_float(kk.z & 0xffff0000u) * qd[5] + __uint_as_float(kk.w << 16) * qd[6] + __uint_as_float(kk.w & 0xffff0000u) * qd[7]; }
                float sv = dot; if (FOX) sv += Fl[i] - Fl[jl];
                if (!valid) sv = -__builtin_inff();
                float cm = sv;
#pragma unroll
                for (int o = 1; o < 64; o <<= 1) cm = fmaxf(cm, __shfl_xor(cm, o));
                const float mn = fmaxf(m, cm), alpha = __expf(m - mn), p = valid ? __expf(sv - mn) : 0.f;
                l = l * alpha + wave_sum(p); o0 *= alpha; o1 *= alpha; m = mn;
                const int nj = (i - jc + 1) < 64 ? (i - jc + 1) : 64;
                for (int jj = 0; jj < nj; ++jj) { const float pj = __shfl(p, jj); const bf16_t* vr = Vp + (size_t)(jc + jj) * ldkv; o0 += pj * bf2f(vr[F.lane]); o1 += pj * bf2f(vr[F.lane + 64]); }
            }
            if (!FOX) l += __expf(sink - m);
            const float rl = 1.0f / l;
            OG[qo + F.lane] = (bf16_t)f2bf(o0 * rl * bf2f(Z[qo + F.lane])); OG[qo + F.lane + 64] = (bf16_t)f2bf(o1 * rl * bf2f(Z[qo + F.lane + 64]));
        }
    }
}

constexpr int NPHASE = 10;
__global__ void __launch_bounds__(NTHR, 2) fwd(Params P) {
    extern __shared__ __attribute__((aligned(16))) unsigned char lds[];
#define MAKE_FRAME() Frame F; { unsigned t_ = threadIdx.x; asm volatile("" : "+v"(t_)); F.lds = (LAS unsigned char*)lds; F.tid = (int)t_; F.lane = F.tid & 63; F.wave = __builtin_amdgcn_readfirstlane(F.tid >> 6); \
        F.G = gridDim.x; const int bx_ = blockIdx.x; F.vcu = (F.G % 8 == 0) ? (bx_ % 8) * (F.G / 8) + bx_ / 8 : bx_; }
    volatile LAS unsigned* MISC = (volatile LAS unsigned*)((LAS unsigned char*)lds + MISC_OFF);
    for (int u = threadIdx.x; u < (LDS_BYTES - MISC_OFF) / 4; u += NTHR) MISC[u] = 0u;
    __syncthreads();
    unsigned char* ws = P.ws;
    const int lo = P.ph_lo, hi = P.ph_hi;
    if (hi - lo > 1) (void)xcd_barrier_post((unsigned*)(ws + WS_CTL) + CW_BAR, MISC + 8);
#ifndef PH_MASK
#define PH_MASK 0x3ff
#endif
#define IN(k) (((PH_MASK >> (k)) & 1) && lo <= (k) && (k) < hi)
#ifndef SEAM_TWICE
#define SEAM_TWICE 0
#endif
#define SEAM(k) do { if (IN(k) && IN((k) + 1)) { XcdBarrier bar_; bar_.bar = (unsigned*)(ws + WS_CTL) + CW_BAR; bar_.x = xb_xcc_id(); bar_.st = MISC + 8; xcd_barrier(bar_); if (SEAM_TWICE) xcd_barrier(bar_); } } while (0)
#ifndef REP_MASK
#define REP_MASK 0
#endif
#define REPS(k) _Pragma("unroll 1") for (int rep_ = 0; rep_ < (((REP_MASK >> (k)) & 1) ? 2 : 1); ++rep_)
#define cs ((const float*)(ws + WS_ROPE))
#define sn ((const float*)(ws + WS_ROPE) + SEQ * 64)
#define mod ((const float*)(ws + WS_MOD))

    if (IN(0)) { MAKE_FRAME(); REPS(0) { p0_prologue(F, P); } SEAM(0); }
    if (IN(1)) { MAKE_FRAME(); REPS(1) { p1_norm0(F, P); } SEAM(1); }
    if (IN(2)) { MAKE_FRAME();
        REPS(2) {
#ifndef G_ALIGN
#define G_ALIGN true
#endif
#ifndef G_SP2
#define G_SP2 true
#endif
#ifndef GX_WGM
#define GX_WGM 4
#endif
#ifndef G1_WGM
#define G1_WGM 4
#endif
#ifndef STAGGER_TICKS
#define STAGGER_TICKS 0
#endif
        if (STAGGER_TICKS) { const unsigned long long t0_ = __builtin_amdgcn_s_memrealtime(), w_ = (unsigned long long)((F.vcu >> 5) * STAGGER_TICKS); while (__builtin_amdgcn_s_memrealtime() - t0_ < w_) __builtin_amdgcn_s_sleep(2); }
        pg8::StaticOrder S; S.init(M, N1, F.G, (int)blockIdx.x, G1_WGM);
        pg8::EpiStoreBf16<pg8::EpiQKVZ> E{{(bf16_t*)(ws + WS_Q), (WS_K - WS_Q) / 2, 0}, cs, sn, (unsigned*)(ws + WS_CTL) + CW_NORM};
#if NAIVE_GEMM
        naive_gemm_bf16(F, (const bf16_t*)(ws + WS_HB), (const bf16_t*)(ws + WS_W1T), DM, S, E.e, cs, sn);
        if (blockIdx.x == 0) for (int i = F.tid; i < 512; i += NTHR) E.nrm[i] = __float_as_uint(1e12f);
#else
        pg8::Gemm g{(const bf16_t*)(ws + WS_HB), (const bf16_t*)(ws + WS_W1T), M, N1, DM};
#if defined(PROBE_NULL_EPI)
        { pg8::EpiNull EN; pg8::gemm_phase<pg8::EpiNull, pg8::StaticOrder, G_ALIGN, G_SP2>(F.lds, g, S, EN); }
#endif
#if I8_G1
        { pg8::StaticOrder S8; S8.init(M, 2 * DM, F.G, (int)blockIdx.x, G1_WGM);
          pg8::EpiStoreBf16<pg8::EpiQKVZ, 1, pg8::DqI8> E8{{(bf16_t*)(ws + WS_Q), (WS_K - WS_Q) / 2, 0}, cs, sn, (unsigned*)(ws + WS_CTL) + CW_NORM, {(const float*)(ws + WS_SA0), (const float*)(ws + WS_SW) + 8192}};
          pg8::Gemm g8{(const bf16_t*)(ws + WS_H0I), (const bf16_t*)(ws + WS_W1I), M, 2 * DM, DM / 2};
          pg8::gemm_phase<pg8::EpiStoreBf16<pg8::EpiQKVZ, 1, pg8::DqI8>, pg8::StaticOrder, G_ALIGN, G_SP2, false, true>(F.lds, g8, S8, E8);
          pg8::EpiStoreBf16<pg8::EpiQKVZ> Ev{{(bf16_t*)(ws + WS_Q), (WS_K - WS_Q) / 2, 2}, cs, sn, nullptr};
          pg8::Gemm gv{(const bf16_t*)(ws + WS_HB), (const bf16_t*)(ws + WS_W1T) + (size_t)(2 * DM) * DM, M, 2 * DM, DM};
          pg8::gemm_phase<pg8::EpiStoreBf16<pg8::EpiQKVZ>, pg8::StaticOrder, G_ALIGN, G_SP2>(F.lds, gv, S8, Ev); }
#else
        pg8::gemm_phase<pg8::EpiStoreBf16<pg8::EpiQKVZ>, pg8::StaticOrder, G_ALIGN, G_SP2>(F.lds, g, S, E);
#endif
#endif
        }
        SEAM(2);
    }
    if (IN(3)) { MAKE_FRAME();
        REPS(3) {
#if NAIVE_FOX
        naive_attn<true>(F, P);
#else
        p3_fox(F, P, (LAS char*)F.lds, MISC);
#endif
        }
        SEAM(3);
    }
    if (IN(4)) { MAKE_FRAME();
        REPS(4) {
        pg8::StaticOrder S; S.init(M, DM, F.G, (int)blockIdx.x, GX_WGM);
        #ifndef RES_NT4
#define RES_NT4 0
#endif
        pg8::EpiResGate E{P.in[I_X], (float*)(ws + WS_H1), mod + 2 * DM, MOD, RES_NT4 != 0, 1.0f};
#if NAIVE_GEMM
        naive_gemm_resgate(F, (const bf16_t*)(ws + WS_OG), (const bf16_t*)(ws + WS_W2T), DM, S, E);
#else
        pg8::Gemm g{(const bf16_t*)(ws + WS_OG), (const bf16_t*)(ws + WS_W2T), M, DM, DM};
#if defined(PROBE_NULL_EPI4)
        { pg8::EpiNull EN; pg8::gemm_phase<pg8::EpiNull, pg8::StaticOrder, G_ALIGN, G_SP2>(F.lds, g, S, EN); }
#endif
        pg8::gemm_phase<pg8::EpiResGate, pg8::StaticOrder, G_ALIGN, G_SP2>(F.lds, g, S, E);
#endif
        }
        SEAM(4);
    }
    if (IN(5)) { MAKE_FRAME(); REPS(5) { p5_norm1(F, P); } SEAM(5); }
    if (IN(6)) { MAKE_FRAME();
        REPS(6) {
#if I8_G3 && !NAIVE_GEMM
        { pg8::OrderQZ8 S; S.init(F.G, (int)blockIdx.x, GX_WGM);
          pg8::EpiStoreBf16<pg8::EpiQZ, 1, pg8::DqI8> E{{(bf16_t*)(ws + WS_Q), (bf16_t*)(ws + WS_Z)}, cs, sn, nullptr, {(const float*)(ws + WS_SA1), (const float*)(ws + WS_SW)}};
          pg8::Gemm g{(const bf16_t*)(ws + WS_HB), (const bf16_t*)(ws + WS_W3I), M, N3, DM / 2};
          pg8::gemm_phase<pg8::EpiStoreBf16<pg8::EpiQZ, 1, pg8::DqI8>, pg8::OrderQZ8, G_ALIGN, G_SP2, false, true>(F.lds, g, S, E); }
        { pg8::OrderKV S; S.init(F.G, (int)blockIdx.x, GX_WGM);
          pg8::EpiStoreBf16<pg8::EpiKV> E{{(bf16_t*)(ws + WS_KV1)}, cs, sn, nullptr};
          pg8::Gemm g{(const bf16_t*)(ws + WS_KVN), (const bf16_t*)(ws + WS_WKVT), M, NKV2, DM};
          pg8::gemm_phase<pg8::EpiStoreBf16<pg8::EpiKV>, pg8::OrderKV, G_ALIGN, G_SP2>(F.lds, g, S, E); }
#elif FP8_G3 && !NAIVE_GEMM
        { pg8::OrderQZ8 S; S.init(F.G, (int)blockIdx.x, GX_WGM);
          pg8::EpiStoreBf16<pg8::EpiQZ, (int)(F8_HSCALE * F8_WSCALE)> E{{(bf16_t*)(ws + WS_Q), (bf16_t*)(ws + WS_Z)}, cs, sn, nullptr};
          pg8::Gemm g{(const bf16_t*)(ws + WS_HB), (const bf16_t*)(ws + WS_W3T), M, N3, DM / 2};
          pg8::gemm_phase<pg8::EpiStoreBf16<pg8::EpiQZ, (int)(F8_HSCALE * F8_WSCALE)>, pg8::OrderQZ8, G_ALIGN, G_SP2, true>(F.lds, g, S, E); }
        { pg8::OrderKV S; S.init(F.G, (int)blockIdx.x, GX_WGM);
          pg8::EpiStoreBf16<pg8::EpiKV> E{{(bf16_t*)(ws + WS_KV1)}, cs, sn, nullptr};
          pg8::Gemm g{(const bf16_t*)(ws + WS_KVN), (const bf16_t*)(ws + WS_WKVT), M, NKV2, DM};
          pg8::gemm_phase<pg8::EpiStoreBf16<pg8::EpiKV>, pg8::OrderKV, G_ALIGN, G_SP2>(F.lds, g, S, E); }
#else
        pg8::OrderQZKV S; S.init(F.G, (int)blockIdx.x, GX_WGM);
        pg8::EpiStoreBf16<pg8::EpiQZKV> E{{(bf16_t*)(ws + WS_Q), (bf16_t*)(ws + WS_Z), (bf16_t*)(ws + WS_KV1)}, cs, sn, nullptr};
#if NAIVE_GEMM
        naive_gemm_bf16(F, (const bf16_t*)(ws + WS_HB), (const bf16_t*)(ws + WS_W3T), DM, S, E.e, cs, sn);
#else
        pg8::Gemm g{(const bf16_t*)(ws + WS_HB), (const bf16_t*)(ws + WS_W3T), 2 * M, N3 + NKV2, DM};
        pg8::gemm_phase<pg8::EpiStoreBf16<pg8::EpiQZKV>, pg8::OrderQZKV, G_ALIGN, G_SP2>(F.lds, g, S, E);
#endif
#endif
        }
        SEAM(6);
    }
    if (IN(7)) { MAKE_FRAME();
        REPS(7) {
#if NAIVE_SWA
        naive_attn<false>(F, P);
#else
        p7_swa(F, P, (LAS char*)F.lds);
#endif
        }
        SEAM(7);
    }
    if (IN(8)) { MAKE_FRAME();
        REPS(8) {
        pg8::StaticOrder S; S.init(M, DM, F.G, (int)blockIdx.x, GX_WGM);
        #ifndef RES_NT8
#define RES_NT8 0
#endif
        pg8::EpiResGate E{(const float*)(ws + WS_H1), P.out, mod + 2 * MOD + 2 * DM, MOD, RES_NT8 != 0, FP8_G4 ? 1.0f / (F8_WSCALE * F8_OSCALE) : 1.0f};
#if NAIVE_GEMM
        naive_gemm_resgate(F, (const bf16_t*)(ws + WS_OG), (const bf16_t*)(ws + WS_W4T), DM, S, E);
#else
        pg8::Gemm g{(const bf16_t*)(ws + WS_OG), (const bf16_t*)(ws + WS_W4T), M, DM, FP8_G4 ? DM / 2 : DM};
        pg8::gemm_phase<pg8::EpiResGate, pg8::StaticOrder, G_ALIGN, G_SP2, FP8_G4 != 0>(F.lds, g, S, E);
#endif
        }
        SEAM(8);
    }
    if (IN(9)) { MAKE_FRAME(); p9_final(F, P); }
#undef IN
#undef SEAM
#undef cs
#undef sn
#undef mod
}

extern "C" void kernel_launch(void* const* d_in, const int* in_sizes, int n_in, void* d_out, int out_size, void* d_ws, size_t ws_size, hipStream_t stream) {
    static int grid = 0;
    if (grid == 0) {
        if (n_in != 14 || out_size != M * DM || ws_size < WS_END) { fprintf(stderr, "kernel_launch: unexpected shapes (n_in %d, out %d, ws %zu)\n", n_in, out_size, ws_size); grid = -1; return; }
        int dev = 0, cus = 0, per_cu = 0;
        if (hipGetDevice(&dev) != hipSuccess || hipDeviceGetAttribute(&cus, hipDeviceAttributeMultiprocessorCount, dev) != hipSuccess) { grid = -1; return; }
        if (hipFuncSetAttribute((const void*)fwd, hipFuncAttributeMaxDynamicSharedMemorySize, LDS_BYTES) != hipSuccess) { fprintf(stderr, "kernel_launch: hipFuncSetAttribute failed\n"); grid = -1; return; }
        if (hipOccupancyMaxActiveBlocksPerMultiprocessor(&per_cu, (const void*)fwd, NTHR, LDS_BYTES) != hipSuccess || per_cu < 1) fprintf(stderr, "kernel_launch: occupancy query reports %d workgroups per CU\n", per_cu);
        (void)hipGetLastError();
        grid = cus;
        if (grid > 256) grid = 256;
    }
    if (grid < 0) return;
    (void)hipMemsetAsync((char*)d_ws + WS_CTL, 0, CTL_ZERO_BYTES, stream);
    Params p{};
    for (int i = 0; i < 14; ++i) p.in[i] = (const float*)d_in[i];
    p.out = (float*)d_out; p.ws = (unsigned char*)d_ws;
#if MK_N_LAUNCHES == 1
    p.ph_lo = 0; p.ph_hi = NPHASE;
    hipLaunchKernelGGL(fwd, dim3(grid), dim3(NTHR), LDS_BYTES, stream, p);
#else
    for (int k = 0; k < NPHASE; ++k) { p.ph_lo = k; p.ph_hi = k + 1; hipLaunchKernelGGL(fwd, dim3(grid), dim3(NTHR), LDS_BYTES, stream, p); }
#endif
    const hipError_t le = hipPeekAtLastError();
    if (le != hipSuccess) fprintf(stderr, "kernel_launch: launch failed: %s\n", hipGetErrorName(le));
}
```
